# Optimizing an MI355X kernel written in HIP

```python
import jax
import jax.numpy as jnp
from jax import lax
import numpy as np

D_MODEL = 1024
BATCH = 2
SEQ = 16384
DEPTH = 2

EPS = 1e-6
CONV_WIDTH = 4
LRU_WIDTH = D_MODEL // 2
LRU_BLOCKS = 8
LRU_BLOCK = LRU_WIDTH // LRU_BLOCKS
LRU_C = 8.0
ATT_HEAD_DIM = 64
ATT_Q_HEADS = (D_MODEL // 2) // ATT_HEAD_DIM
ATT_KV_HEADS = 2
ATT_GROUPS = ATT_Q_HEADS // ATT_KV_HEADS
ATT_Q_WIDTH = ATT_Q_HEADS * ATT_HEAD_DIM
ATT_KV_WIDTH = ATT_KV_HEADS * ATT_HEAD_DIM
WINDOW = 128
ROPE_THETA = 10000.0
EVEN_IN_COLS = 2 * LRU_WIDTH + ATT_Q_WIDTH + 2 * ATT_KV_WIDTH
EVEN_MIX_WIDTH = LRU_WIDTH + ATT_Q_WIDTH
D_FF_DENSE = 2816
GDN_HEADS = 8
GDN_HEAD_DIM = 128
GDN_WIDTH = GDN_HEADS * GDN_HEAD_DIM
GDN_CHUNK = 64
ODD_IN_COLS = 4 * GDN_WIDTH + 2 * GDN_HEADS
N_EXPERTS = 8
TOP_K = 2
D_FF_EXPERT = 3584
N_EVEN = (DEPTH + 1) // 2
N_ODD = DEPTH // 2

kernel_name = "hybrid_rglru_swa_gdn_moe"


def rms_norm(x, g):
    xf = x.astype(jnp.float32)
    y = xf * lax.rsqrt(jnp.mean(xf * xf, axis=-1, keepdims=True) + EPS)
    return (y * g.astype(jnp.float32)).astype(x.dtype)


def l2_norm(x):
    return x * lax.rsqrt(jnp.sum(x * x, axis=-1, keepdims=True) + EPS)


def causal_depthwise_conv(x, w):
    seq = x.shape[1]
    xp = jnp.pad(x, ((0, 0), (CONV_WIDTH - 1, 0), (0, 0)))
    return sum(w[j] * xp[:, j:j + seq] for j in range(CONV_WIDTH))


def rope(x, pos):
    half = x.shape[-1] // 2
    inv_freq = ROPE_THETA ** (-jnp.arange(half, dtype=jnp.float32) / half)
    ang = pos.astype(jnp.float32)[:, None] * inv_freq[None, :]
    cos = jnp.cos(ang)[None, :, None, :]
    sin = jnp.sin(ang)[None, :, None, :]
    xf = x.astype(jnp.float32)
    x1, x2 = xf[..., :half], xf[..., half:]
    return jnp.concatenate([x1 * cos - x2 * sin, x2 * cos + x1 * sin], axis=-1)


def swiglu(h, w_gate, w_up, w_down):
    return (jax.nn.silu(h @ w_gate) * (h @ w_up)) @ w_down


def rg_lru(xb, conv_w, conv_b, w_a, b_a, w_i, b_i, lam):
    bsz, seq, _ = xb.shape
    xc = causal_depthwise_conv(xb, conv_w) + conv_b
    xh = xc.reshape(bsz, seq, LRU_BLOCKS, LRU_BLOCK)
    r = jax.nn.sigmoid(jnp.einsum('bshi,hij->bshj', xh, w_a).reshape(bsz, seq, LRU_WIDTH) + b_a)
    gi = jax.nn.sigmoid(jnp.einsum('bshi,hij->bshj', xh, w_i).reshape(bsz, seq, LRU_WIDTH) + b_i)
    log_a = -LRU_C * r * jax.nn.softplus(-lam)
    a = jnp.exp(log_a)
    u = jnp.sqrt(-jnp.expm1(2.0 * log_a)) * (gi * xc)

    def combine(c1, c2):
        a1, b1 = c1
        a2, b2 = c2
        return a1 * a2, a2 * b1 + b2

    _, h = lax.associative_scan(combine, (a, u), axis=1)
    return h


def sliding_window_attention(q, k, v, sinks):
    bsz, seq = q.shape[:2]
    nb = seq // WINDOW
    qb = q.astype(jnp.float32).reshape(bsz, nb, WINDOW, ATT_KV_HEADS, ATT_GROUPS, ATT_HEAD_DIM)

    def with_prev(t):
        tb = t.astype(jnp.float32).reshape(bsz, nb, WINDOW, ATT_KV_HEADS, ATT_HEAD_DIM)
        prev = jnp.pad(tb, ((0, 0), (1, 0), (0, 0), (0, 0), (0, 0)))[:, :-1]
        return jnp.concatenate([prev, tb], axis=2)

    kb, vb = with_prev(k), with_prev(v)
    s = jnp.einsum('bnqhgd,bnkhd->bnhgqk', qb, kb) * (ATT_HEAD_DIM ** -0.5)
    qi = jnp.arange(WINDOW)[:, None] + WINDOW
    kj = jnp.arange(2 * WINDOW)[None, :]
    rel = qi - kj
    band = (rel >= 0) & (rel < WINDOW)
    valid = band[None] & ((jnp.arange(nb)[:, None, None] > 0) | (kj >= WINDOW)[None])
    s = jnp.where(valid[None, :, None, None], s, -1e30)
    sink = sinks.astype(jnp.float32).reshape(ATT_KV_HEADS, ATT_GROUPS)[None, None, :, :, None, None]
    m = jnp.maximum(jnp.max(s, axis=-1, keepdims=True), sink)
    p = jnp.exp(s - m)
    denom = jnp.sum(p, axis=-1, keepdims=True) + jnp.exp(sink - m)
    o = jnp.einsum('bnhgqk,bnkhd->bnqhgd', p / denom, vb)
    return o.reshape(bsz, seq, ATT_Q_WIDTH)


def even_mixer(h, pos, w_in, conv_w, conv_b, w_a, b_a, w_i, b_i, lam, q_norm, k_norm, sinks, w_out):
    bsz, seq, _ = h.shape
    proj = h @ w_in
    cuts = np.cumsum([LRU_WIDTH, LRU_WIDTH, ATT_Q_WIDTH, ATT_KV_WIDTH]).tolist()
    xb, gate, q, k, v = jnp.split(proj, cuts, axis=-1)
    y_lru = rg_lru(xb.astype(jnp.float32), conv_w, conv_b, w_a, b_a, w_i, b_i, lam) \
        * jax.nn.gelu(gate.astype(jnp.float32))
    q = rope(rms_norm(q.reshape(bsz, seq, ATT_Q_HEADS, ATT_HEAD_DIM), q_norm), pos)
    k = rope(rms_norm(k.reshape(bsz, seq, ATT_KV_HEADS, ATT_HEAD_DIM), k_norm), pos)
    v = v.reshape(bsz, seq, ATT_KV_HEADS, ATT_HEAD_DIM)
    y_att = sliding_window_attention(q, k, v, sinks)
    y = jnp.concatenate([y_lru.astype(h.dtype), y_att.astype(h.dtype)], axis=-1)
    return y @ w_out


def gated_deltanet(h, w_in, conv_w, a_log, dt_bias, out_norm, w_out):
    bsz, seq, _ = h.shape
    nc = seq // GDN_CHUNK
    C = GDN_CHUNK
    proj = (h @ w_in).astype(jnp.float32)
    cuts = [3 * GDN_WIDTH, 4 * GDN_WIDTH, 4 * GDN_WIDTH + GDN_HEADS]
    qkv, gate, a_in, b_in = jnp.split(proj, cuts, axis=-1)
    qkv = jax.nn.silu(causal_depthwise_conv(qkv, conv_w.astype(jnp.float32)))
    q, k, v = jnp.split(qkv, 3, axis=-1)
    q = l2_norm(q.reshape(bsz, seq, GDN_HEADS, GDN_HEAD_DIM)) * (GDN_HEAD_DIM ** -0.5)
    k = l2_norm(k.reshape(bsz, seq, GDN_HEADS, GDN_HEAD_DIM))
    v = v.reshape(bsz, seq, GDN_HEADS, GDN_HEAD_DIM)
    beta = jax.nn.sigmoid(b_in)
    g = -jnp.exp(a_log.astype(jnp.float32)) * jax.nn.softplus(a_in + dt_bias.astype(jnp.float32))

    def to_chunks(t):
        return t.reshape(bsz, nc, C, GDN_HEADS, -1).transpose(0, 3, 1, 2, 4)

    qc, kc, vc = to_chunks(q), to_chunks(k), to_chunks(v)
    gc = g.reshape(bsz, nc, C, GDN_HEADS).transpose(0, 3, 1, 2)
    bc = beta.reshape(bsz, nc, C, GDN_HEADS).transpose(0, 3, 1, 2)
    G = jnp.cumsum(gc, axis=-1)
    tri = jnp.tril(jnp.ones((C, C), dtype=bool))
    strict = jnp.tril(jnp.ones((C, C), dtype=bool), -1)
    diff = G[..., :, None] - G[..., None, :]
    decay = jnp.where(tri, jnp.exp(jnp.where(tri, diff, 0.0)), 0.0)
    kk = jnp.einsum('bhnid,bhnjd->bhnij', kc, kc)
    A = jnp.where(strict, bc[..., :, None] * kk * decay, 0.0) + jnp.eye(C, dtype=jnp.float32)
    u = lax.linalg.triangular_solve(A, bc[..., None] * vc, left_side=True, lower=True, unit_diagonal=True)
    w = lax.linalg.triangular_solve(A, bc[..., None] * jnp.exp(G)[..., None] * kc,
                                    left_side=True, lower=True, unit_diagonal=True)
    a_qk = jnp.where(tri, jnp.einsum('bhnid,bhnjd->bhnij', qc, kc) * decay, 0.0)
    q_dec = qc * jnp.exp(G)[..., None]
    k_dec = kc * jnp.exp(G[..., -1:] - G)[..., None]
    g_last = jnp.exp(G[..., -1])
    xs = (jnp.moveaxis(u, 2, 0), jnp.moveaxis(w, 2, 0), jnp.moveaxis(a_qk, 2, 0),
          jnp.moveaxis(q_dec, 2, 0), jnp.moveaxis(k_dec, 2, 0), jnp.moveaxis(g_last, 2, 0))

    def step(state, inp):
        u_c, w_c, a_c, qd_c, kd_c, gl_c = inp
        v_new = u_c - jnp.einsum('bhcd,bhde->bhce', w_c, state)
        o_c = jnp.einsum('bhcd,bhde->bhce', qd_c, state) + jnp.einsum('bhcj,bhje->bhce', a_c, v_new)
        state = state * gl_c[..., None, None] + jnp.einsum('bhcd,bhce->bhde', kd_c, v_new)
        return state, o_c

    s0 = jnp.zeros((bsz, GDN_HEADS, GDN_HEAD_DIM, GDN_HEAD_DIM), jnp.float32)
    _, o = lax.scan(step, s0, xs)
    o = o.transpose(1, 0, 3, 2, 4).reshape(bsz, seq, GDN_HEADS, GDN_HEAD_DIM)
    o = rms_norm(o, out_norm) * jax.nn.silu(gate.reshape(bsz, seq, GDN_HEADS, GDN_HEAD_DIM))
    return o.reshape(bsz, seq, GDN_WIDTH).astype(h.dtype) @ w_out


def moe_swiglu(h, router, w_gate, w_up, w_down):
    bsz, seq, d = h.shape
    t = h.reshape(-1, d)
    logits = (t @ router).astype(jnp.float32)
    top_v, top_i = lax.top_k(logits, TOP_K)
    top_w = jax.nn.softmax(top_v, axis=-1)
    gates = jnp.sum(jax.nn.one_hot(top_i, N_EXPERTS, dtype=jnp.float32) * top_w[..., None], axis=1)
    out = jnp.zeros(t.shape, jnp.float32)
    for e in range(N_EXPERTS):
        y_e = swiglu(t, w_gate[e], w_up[e], w_down[e]).astype(jnp.float32)
        out = out + gates[:, e:e + 1] * y_e
    return out.astype(h.dtype).reshape(bsz, seq, d)


def setup_inputs(seed: int = 0) -> dict:
    key = jax.random.key(seed)
    ks = jax.random.split(key, 32)
    f32 = jnp.float32
    D = D_MODEL

    def nrm(k, shape, scale):
        return scale * jax.random.normal(k, shape, f32)

    lru_u = jax.random.uniform(ks[10], (N_EVEN, LRU_WIDTH), f32, minval=0.9, maxval=0.999)
    lru_s = lru_u ** (1.0 / LRU_C)
    dt = jnp.exp(jax.random.uniform(ks[21], (N_ODD, GDN_HEADS), f32,
                                    minval=float(np.log(0.001)), maxval=float(np.log(0.1))))
    return {
        "x": nrm(ks[0], (BATCH, SEQ, D), 1.0),
        "ln_mix": 1.0 + nrm(ks[1], (DEPTH, D), 0.02),
        "ln_ffn": 1.0 + nrm(ks[2], (DEPTH, D), 0.02),
        "e_w_in": nrm(ks[3], (N_EVEN, D, EVEN_IN_COLS), D ** -0.5),
        "e_lru_conv_w": nrm(ks[4], (N_EVEN, CONV_WIDTH, LRU_WIDTH), CONV_WIDTH ** -0.5),
        "e_lru_conv_b": nrm(ks[5], (N_EVEN, LRU_WIDTH), 0.02),
        "e_lru_w_a": nrm(ks[6], (N_EVEN, LRU_BLOCKS, LRU_BLOCK, LRU_BLOCK), LRU_BLOCK ** -0.5),
        "e_lru_b_a": nrm(ks[7], (N_EVEN, LRU_WIDTH), 0.1),
        "e_lru_w_i": nrm(ks[8], (N_EVEN, LRU_BLOCKS, LRU_BLOCK, LRU_BLOCK), LRU_BLOCK ** -0.5),
        "e_lru_b_i": nrm(ks[9], (N_EVEN, LRU_WIDTH), 0.1),
        "e_lru_lambda": jnp.log(lru_s) - jnp.log1p(-lru_s),
        "e_q_norm": 1.0 + nrm(ks[11], (N_EVEN, ATT_HEAD_DIM), 0.02),
        "e_k_norm": 1.0 + nrm(ks[12], (N_EVEN, ATT_HEAD_DIM), 0.02),
        "e_sinks": nrm(ks[13], (N_EVEN, ATT_Q_HEADS), 1.0),
        "e_w_out": nrm(ks[14], (N_EVEN, EVEN_MIX_WIDTH, D), EVEN_MIX_WIDTH ** -0.5),
        "e_ffn_w_gate": nrm(ks[15], (N_EVEN, D, D_FF_DENSE), D ** -0.5),
        "e_ffn_w_up": nrm(ks[16], (N_EVEN, D, D_FF_DENSE), D ** -0.5),
        "e_ffn_w_down": nrm(ks[17], (N_EVEN, D_FF_DENSE, D), D_FF_DENSE ** -0.5),
        "o_w_in": nrm(ks[18], (N_ODD, D, ODD_IN_COLS), D ** -0.5),
        "o_conv_w": nrm(ks[19], (N_ODD, CONV_WIDTH, 3 * GDN_WIDTH), CONV_WIDTH ** -0.5),
        "o_a_log": jnp.log(jax.random.uniform(ks[20], (N_ODD, GDN_HEADS), f32, minval=1.0, maxval=16.0)),
        "o_dt_bias": dt + jnp.log(-jnp.expm1(-dt)),
        "o_out_norm": 1.0 + nrm(ks[22], (N_ODD, GDN_HEAD_DIM), 0.02),
        "o_w_out": nrm(ks[23], (N_ODD, GDN_WIDTH, D), GDN_WIDTH ** -0.5),
        "o_router": nrm(ks[24], (N_ODD, D, N_EXPERTS), D ** -0.5),
        "o_moe_w_gate": nrm(ks[25], (N_ODD, N_EXPERTS, D, D_FF_EXPERT), D ** -0.5),
        "o_moe_w_up": nrm(ks[26], (N_ODD, N_EXPERTS, D, D_FF_EXPERT), D ** -0.5),
        "o_moe_w_down": nrm(ks[27], (N_ODD, N_EXPERTS, D_FF_EXPERT, D), D_FF_EXPERT ** -0.5),
    }


def reference(x, ln_mix, ln_ffn,
              e_w_in, e_lru_conv_w, e_lru_conv_b, e_lru_w_a, e_lru_b_a, e_lru_w_i, e_lru_b_i,
              e_lru_lambda, e_q_norm, e_k_norm, e_sinks, e_w_out, e_ffn_w_gate, e_ffn_w_up, e_ffn_w_down,
              o_w_in, o_conv_w, o_a_log, o_dt_bias, o_out_norm, o_w_out, o_router,
              o_moe_w_gate, o_moe_w_up, o_moe_w_down):
    pos = jnp.arange(x.shape[1], dtype=jnp.int32)
    h = x
    for layer in range(DEPTH):
        j = layer // 2
        hn = rms_norm(h, ln_mix[layer])
        if layer % 2 == 0:
            h = h + even_mixer(hn, pos, e_w_in[j], e_lru_conv_w[j], e_lru_conv_b[j], e_lru_w_a[j],
                               e_lru_b_a[j], e_lru_w_i[j], e_lru_b_i[j], e_lru_lambda[j],
                               e_q_norm[j], e_k_norm[j], e_sinks[j], e_w_out[j]).astype(h.dtype)
            h = h + swiglu(rms_norm(h, ln_ffn[layer]), e_ffn_w_gate[j], e_ffn_w_up[j],
                           e_ffn_w_down[j]).astype(h.dtype)
        else:
            h = h + gated_deltanet(hn, o_w_in[j], o_conv_w[j], o_a_log[j], o_dt_bias[j],
                                   o_out_norm[j], o_w_out[j]).astype(h.dtype)
            h = h + moe_swiglu(rms_norm(h, ln_ffn[layer]), o_router[j], o_moe_w_gate[j],
                               o_moe_w_up[j], o_moe_w_down[j]).astype(h.dtype)
    return h
```

```cpp
#include <hip/hip_runtime.h>
#include <cstdio>
#include <cstdint>
#include <cmath>
namespace pg8 {
#define PG8_LAS __attribute__((address_space(3)))
typedef unsigned short bf16_t;
typedef short bf16x8 __attribute__((ext_vector_type(8)));
typedef float f32x4 __attribute__((ext_vector_type(4)));
typedef unsigned u32x4 __attribute__((ext_vector_type(4)));
constexpr int BM = 256, BK = 64, HALF = 128, HTB = HALF * BK * 2  , STAGE_BYTES = 8 * HTB, NXCD = 8, WGM = 8;

__host__ __device__ __forceinline__ int lds_byte(int r, int c) { const int st = (r >> 4) * 2 + (c >> 5), rr = r & 15, cc = c & 31, ob = rr * 64 + cc * 2; return st * 1024 + (ob ^ (((ob >> 9) & 1) << 5)); }
__host__ __device__ __forceinline__ void stage_rc(int b, int& R, int& C) { const int st = b / 1024, sb = b % 1024, swz = sb ^ (((sb >> 9) & 1) << 5); R = (st >> 1) * 16 + swz / 64; C = (st & 1) * 32 + (swz % 64) / 2; }
__host__ __device__ __forceinline__ int perm32(int rho) { const int n = rho >> 4, i = rho & 15; return 8 * (i >> 2) + 4 * n + (i & 3); }

struct Unit { int pm, pn; };
struct Gemm { const bf16_t* A; const bf16_t* Bt; int M, N, K; };

struct StaticOrder {
    int nM, nN, nwg, G, c;
    __host__ __device__ void init(int M, int N, int G_, int c_) { nM = M / BM; nN = N / BM; nwg = nM * nN; G = G_; c = c_; }
    __host__ __device__ bool next(int i, Unit& u) const {
        const long L = (long)i * G + c; if (L >= nwg) return false;
        int wgid = (int)L; { const int q = nwg / NXCD, r = nwg % NXCD, xcd = wgid % NXCD, off = wgid / NXCD; wgid = (xcd < r ? xcd * (q + 1) : r * (q + 1) + (xcd - r) * q) + off; }
        const int nig = WGM * nN, gid = wgid / nig, fm = gid * WGM, gsz = (nM - fm) < WGM ? (nM - fm) : WGM;
        u.pm = fm + ((wgid % nig) % gsz); u.pn = (wgid % nig) / gsz; return true;
    }
    __device__ __forceinline__ void a_ready(const Unit&) const {}
    __device__ __forceinline__ void done(const Unit&) const {}
};

__device__ __forceinline__ unsigned cvt_pk_bf16(float lo, float hi) { unsigned r; asm volatile("v_cvt_pk_bf16_f32 %0, %1, %2" : "=v"(r) : "v"(lo), "v"(hi)); return r; }
typedef float f32x2 __attribute__((ext_vector_type(2)));
__device__ __forceinline__ float rstd16(const float* st, int row) {
    const f32x4* p = (const f32x4*)(st + (size_t)row * 16); const f32x4 a = p[0], b = p[1], c = p[2], d = p[3];
    const float s = ((a[0] + a[1]) + (a[2] + a[3])) + ((b[0] + b[1]) + (b[2] + b[3])) + ((c[0] + c[1]) + (c[2] + c[3])) + ((d[0] + d[1]) + (d[2] + d[3]));
    return __builtin_amdgcn_rsqf(s * (1.0f / 1024.0f) + 1e-6f);
}
__device__ __forceinline__ u32x4 pack8(const f32x4 v0, const f32x4 v1) { u32x4 w; w.x = cvt_pk_bf16(v0[0], v0[1]); w.y = cvt_pk_bf16(v0[2], v0[3]); w.z = cvt_pk_bf16(v1[0], v1[1]); w.w = cvt_pk_bf16(v1[2], v1[3]); return w; }
__device__ __forceinline__ float silu_f(float x) { return x * __builtin_amdgcn_rcpf(1.0f + __expf(-x)); }

template <int MODE> struct EpiProj {
    static constexpr bool PERM = true, AFTER_DRAIN = false;
    bf16_t* O; int ldo; const float* stats; bf16_t* gate; bf16_t* halo;
    __device__ __forceinline__ void operator()(const f32x4 (&acc)[2][2][4][2], const Unit& u, int wr, int wc, int fr, int fq) const {
        const int row0 = u.pm * BM + wr * 64 + fr, col0 = u.pn * BM + wc * 32 + 8 * fq;
#pragma unroll
        for (int ai = 0; ai < 2; ++ai)
#pragma unroll
            for (int m = 0; m < 4; ++m) { const int row = row0 + ai * HALF + m * 16; const float rs = rstd16(stats, row);
#pragma unroll
                for (int bj = 0; bj < 2; ++bj) { const int col = col0 + bj * HALF; const u32x4 w = pack8(acc[ai][bj][m][0] * rs, acc[ai][bj][m][1] * rs);
                    if (MODE == 0) { *(u32x4*)(O + (size_t)row * ldo + col) = w; }
                    else { if (col < 3072) { *(u32x4*)(O + (size_t)row * 3072 + col) = w; const int t = row & 63; if (t >= 61) *(u32x4*)(halo + ((size_t)(row >> 6) * 3 + (t - 61)) * 3072 + col) = w; }
                           else *(u32x4*)(gate + (size_t)row * 1024 + (col - 3072)) = w; } } }
    }
};
struct EpiResid {
    static constexpr bool PERM = true, AFTER_DRAIN = false;
    const float* resid; float* out; bf16_t* hb; float* stats;
    __device__ __forceinline__ void operator()(const f32x4 (&acc)[2][2][4][2], const Unit& u, int wr, int wc, int fr, int fq) const {
        const int row0 = u.pm * BM + wr * 64 + fr, col0 = u.pn * BM + wc * 32 + 8 * fq;
#pragma unroll
        for (int ai = 0; ai < 2; ++ai)
#pragma unroll
            for (int m = 0; m < 4; ++m) { const int row = row0 + ai * HALF + m * 16; float ss = 0.f;
#pragma unroll
                for (int bj = 0; bj < 2; ++bj) { const size_t off = (size_t)row * 1024 + col0 + bj * HALF;
                    const f32x4 r0 = *(const f32x4*)(resid + off), r1 = *(const f32x4*)(resid + off + 4);
                    const f32x4 v0 = acc[ai][bj][m][0] + r0, v1 = acc[ai][bj][m][1] + r1;
                    *(f32x4*)(out + off) = v0; *(f32x4*)(out + off + 4) = v1; *(u32x4*)(hb + off) = pack8(v0, v1);
                    ss += ((v0[0] * v0[0] + v0[1] * v0[1]) + (v0[2] * v0[2] + v0[3] * v0[3])) + ((v1[0] * v1[0] + v1[1] * v1[1]) + (v1[2] * v1[2] + v1[3] * v1[3])); }
                ss += __shfl_xor(ss, 16); ss += __shfl_xor(ss, 32);
                if (fq == 0) stats[(size_t)row * 16 + (u.pn & 3) * 4 + wc] = ss; }
    }
};
template <bool MOE> struct EpiSwiGLU {
    static constexpr bool PERM = true, AFTER_DRAIN = false;
    bf16_t* O; int ldo; const float* stats; int ntn, pm_lo;
    __device__ __forceinline__ void operator()(const f32x4 (&acc)[2][2][4][2], const Unit& u, int wr, int wc, int fr, int fq) const {
        const int pnl = MOE ? (u.pn % ntn) : u.pn;
        const int row0 = u.pm * BM + wr * 64 + fr, col = pnl * HALF + wc * 32 + 8 * fq;
#pragma unroll
        for (int ai = 0; ai < 2; ++ai)
#pragma unroll
            for (int m = 0; m < 4; ++m) { const int row = row0 + ai * HALF + m * 16; const float rs = MOE ? stats[row] : rstd16(stats, row);
                const f32x4 g0 = acc[ai][0][m][0] * rs, g1 = acc[ai][0][m][1] * rs, u0 = acc[ai][1][m][0] * rs, u1 = acc[ai][1][m][1] * rs; f32x4 a0, a1;
#pragma unroll
                for (int i = 0; i < 4; ++i) { a0[i] = silu_f(g0[i]) * u0[i]; a1[i] = silu_f(g1[i]) * u1[i]; }
                *(u32x4*)(O + (size_t)(row - pm_lo * BM) * ldo + col) = pack8(a0, a1); }
    }
};
struct EpiPlain {
    static constexpr bool PERM = true, AFTER_DRAIN = false;
    bf16_t* O;
    __device__ __forceinline__ void operator()(const f32x4 (&acc)[2][2][4][2], const Unit& u, int wr, int wc, int fr, int fq) const {
        const int row0 = u.pm * BM + wr * 64 + fr, col0 = (u.pn & 3) * BM + wc * 32 + 8 * fq;
#pragma unroll
        for (int ai = 0; ai < 2; ++ai)
#pragma unroll
            for (int m = 0; m < 4; ++m) { const int row = row0 + ai * HALF + m * 16;
#pragma unroll
                for (int bj = 0; bj < 2; ++bj) *(u32x4*)(O + (size_t)row * 1024 + col0 + bj * HALF) = pack8(acc[ai][bj][m][0], acc[ai][bj][m][1]); }
    }
};
struct MoeOrder {
    int lo, hi, NT, G, c; const int* tile_e;
    __device__ __forceinline__ bool next(int i, Unit& u) const {
        const long L = (long)i * G + c; const int nt = hi - lo; if (L >= (long)nt * NT) return false;
        const int grp = (int)(L / (8 * NT)), fm = grp * 8, gsz = (nt - fm) < 8 ? (nt - fm) : 8, w = (int)(L - (long)grp * 8 * NT), rt = lo + fm + (w % gsz);
        u.pm = rt; u.pn = tile_e[rt] * NT + (w / gsz); return true;
    }
    __device__ __forceinline__ void a_ready(const Unit&) const {}
    __device__ __forceinline__ void done(const Unit&) const {}
};
template <class Epi, class Sched, bool ALIGN_EPI = false, bool SP2 = false>
__device__ __forceinline__ void gemm_phase(PG8_LAS unsigned char* lds, const Gemm g, const Sched& S, const Epi& E) {
    const int tid = threadIdx.x, wid = __builtin_amdgcn_readfirstlane(tid >> 6), lane = tid & 63, wr = wid >> 2, wc = wid & 3, fr = lane & 15, fq = lane >> 4;
    const int K = g.K, nt = K / BK;
    unsigned voffA[2], voffB[2];
#pragma unroll
    for (int i = 0; i < 2; ++i) { int R, C; stage_rc(tid * 16 + i * 8192, R, C); const int Rb = Epi::PERM ? ((R & ~31) + perm32(R & 31)) : R;
        voffA[i] = (unsigned)(R * K + C) * 2u; voffB[i] = (unsigned)(Rb * K + C) * 2u; }
    const size_t kstep = (size_t)(BK * 2);
    const size_t hstep = (size_t)HALF * K * 2;
    const size_t tstep = 2 * hstep;
    const unsigned ldsw = (unsigned)wid * 1024u;
    const int aoff = lds_byte(wr * 64 + fr, fq * 8), boff = lds_byte(wc * 32 + fr, fq * 8);
#define PG8_SA(b, h) (((b) * 2 + (h)) * HTB)
#define PG8_SB(b, h) ((4 + (b) * 2 + (h)) * HTB)
#define PG8_STAGE(bufoff, gbase, voff) do { _Pragma("unroll") for (int _i = 0; _i < 2; ++_i) \
        __builtin_amdgcn_global_load_lds((const unsigned*)((const char*)(gbase) + (voff)[_i]), (PG8_LAS unsigned*)(lds + (bufoff) + ldsw + _i * 8192), 16, 0, 0); } while (0)
#define PG8_LDA(dst, b, h) do { _Pragma("unroll") for (int m = 0; m < 4; ++m) _Pragma("unroll") for (int k = 0; k < 2; ++k) dst[m][k] = *(const PG8_LAS bf16x8*)(lds + PG8_SA(b, h) + aoff + m * 2048 + k * 1024); } while (0)
#define PG8_LDB(dst, b, h) do { _Pragma("unroll") for (int n = 0; n < 2; ++n) _Pragma("unroll") for (int k = 0; k < 2; ++k) dst[n][k] = *(const PG8_LAS bf16x8*)(lds + PG8_SB(b, h) + boff + n * 2048 + k * 1024); } while (0)
#define PG8_MMA(ai, bj, At, Bt) do { __builtin_amdgcn_s_setprio(1); _Pragma("unroll") for (int m = 0; m < 4; ++m) _Pragma("unroll") for (int n = 0; n < 2; ++n) _Pragma("unroll") for (int k = 0; k < 2; ++k) \
        acc[ai][bj][m][n] = __builtin_amdgcn_mfma_f32_16x16x32_bf16(Bt[n][k], At[m][k], acc[ai][bj][m][n], 0, 0, 0); __builtin_amdgcn_s_setprio(0); } while (0)
#define PG8_WAIT_V(n) asm volatile("s_waitcnt vmcnt(" #n ")" ::: "memory")
#define PG8_WAIT_L(n) asm volatile("s_waitcnt lgkmcnt(" #n ")" ::: "memory")
#define PG8_BAR __builtin_amdgcn_s_barrier()
#define PG8_SCHED __builtin_amdgcn_sched_barrier(0)
    Unit cur, nxt; int ui = 0;
    if (!S.next(0, cur)) return;
    f32x4 acc[2][2][4][2];
#pragma unroll
    for (int a = 0; a < 2; ++a)
#pragma unroll
        for (int b = 0; b < 2; ++b)
#pragma unroll
            for (int m = 0; m < 4; ++m)
#pragma unroll
                for (int n = 0; n < 2; ++n) acc[a][b][m][n] = (f32x4){0.f, 0.f, 0.f, 0.f};
    bf16x8 At[4][2], B0[2][2], B1[2][2];
    const char* cA = (const char*)g.A + (size_t)cur.pm * tstep; const char* cB = (const char*)g.Bt + (size_t)cur.pn * tstep;
    S.a_ready(cur);
    if constexpr (SP2) {
        PG8_STAGE(PG8_SB(0, 0), cB, voffB); PG8_STAGE(PG8_SB(0, 1), cB + hstep, voffB); PG8_STAGE(PG8_SA(0, 0), cA, voffA); PG8_STAGE(PG8_SA(0, 1), cA + hstep, voffA);
        if (wr == 1) PG8_BAR;
        PG8_WAIT_V(2); PG8_BAR;
        PG8_STAGE(PG8_SB(1, 0), cB + kstep, voffB); PG8_STAGE(PG8_SA(1, 0), cA + kstep, voffA); PG8_STAGE(PG8_SB(1, 1), cB + hstep + kstep, voffB);
        PG8_WAIT_V(6); PG8_BAR;
    } else {
        PG8_STAGE(PG8_SB(0, 0), cB, voffB); PG8_STAGE(PG8_SA(0, 0), cA, voffA); PG8_STAGE(PG8_SB(0, 1), cB + hstep, voffB); PG8_STAGE(PG8_SA(0, 1), cA + hstep, voffA);
        if (wr == 1) PG8_BAR;
        PG8_WAIT_V(4); PG8_BAR;
        PG8_STAGE(PG8_SB(1, 0), cB + kstep, voffB); PG8_STAGE(PG8_SA(1, 0), cA + kstep, voffA); PG8_STAGE(PG8_SB(1, 1), cB + hstep + kstep, voffB);
        PG8_WAIT_V(6); PG8_BAR;
    }
    for (;;) {
        const bool has_next = S.next(ui + 1, nxt);
        const char* nA = has_next ? (const char*)g.A + (size_t)nxt.pm * tstep : cA; const char* nB = has_next ? (const char*)g.Bt + (size_t)nxt.pn * tstep : cB;
        for (int t = 0; t < nt; t += 2) {
            const bool last = (t == nt - 2);
            const char* a1 = cA + (size_t)(t + 1) * kstep;
            const char* a2 = last ? nA : cA + (size_t)(t + 2) * kstep; const char* b2 = last ? nB : cB + (size_t)(t + 2) * kstep;
            const char* a3 = a2 + kstep; const char* b3 = b2 + kstep;
            if (last && has_next) S.a_ready(nxt);
            if constexpr (SP2) {
            PG8_LDB(B0, 0, 0); PG8_LDB(B1, 0, 1); PG8_SCHED; PG8_LDA(At, 0, 0); PG8_STAGE(PG8_SA(1, 1), a1 + hstep, voffA);
            PG8_WAIT_V(8); PG8_WAIT_L(0); PG8_BAR; PG8_MMA(0, 0, At, B0); PG8_MMA(0, 1, At, B1); PG8_BAR; PG8_SCHED;
            PG8_LDA(At, 0, 1); PG8_STAGE(PG8_SB(0, 0), b2, voffB); PG8_STAGE(PG8_SB(0, 1), b2 + hstep, voffB); PG8_STAGE(PG8_SA(0, 0), a2, voffA);
            PG8_WAIT_V(8); PG8_WAIT_L(0); PG8_BAR; PG8_MMA(1, 0, At, B0); PG8_MMA(1, 1, At, B1); PG8_BAR; PG8_SCHED;
            PG8_LDB(B0, 1, 0); PG8_LDB(B1, 1, 1); PG8_SCHED; PG8_LDA(At, 1, 0); PG8_STAGE(PG8_SA(0, 1), a2 + hstep, voffA);
            PG8_WAIT_V(8); PG8_WAIT_L(0); PG8_BAR; PG8_MMA(0, 0, At, B0); PG8_MMA(0, 1, At, B1); PG8_BAR; PG8_SCHED;
            PG8_LDA(At, 1, 1); PG8_STAGE(PG8_SB(1, 0), b3, voffB); PG8_STAGE(PG8_SB(1, 1), b3 + hstep, voffB); PG8_STAGE(PG8_SA(1, 0), a3, voffA);
            PG8_WAIT_V(8); PG8_WAIT_L(0); PG8_BAR; PG8_MMA(1, 0, At, B0); PG8_MMA(1, 1, At, B1); PG8_BAR; PG8_SCHED;
            } else {
            PG8_LDB(B0, 0, 0); PG8_SCHED; PG8_LDA(At, 0, 0); PG8_STAGE(PG8_SA(1, 1), a1 + hstep, voffA);
            PG8_WAIT_L(8); PG8_BAR; PG8_WAIT_L(0); PG8_MMA(0, 0, At, B0); PG8_BAR; PG8_SCHED;
            PG8_LDB(B1, 0, 1); PG8_STAGE(PG8_SB(0, 0), b2, voffB);
            PG8_BAR; PG8_WAIT_L(0); PG8_MMA(0, 1, At, B1); PG8_BAR;
            PG8_LDA(At, 0, 1); PG8_STAGE(PG8_SA(0, 0), a2, voffA);
            PG8_BAR; PG8_WAIT_L(0); PG8_MMA(1, 0, At, B0); PG8_BAR; PG8_SCHED;
            PG8_STAGE(PG8_SB(0, 1), b2 + hstep, voffB);
            PG8_WAIT_V(6); PG8_BAR; PG8_MMA(1, 1, At, B1); PG8_BAR;
            PG8_LDB(B0, 1, 0); PG8_SCHED; PG8_LDA(At, 1, 0); PG8_STAGE(PG8_SA(0, 1), a2 + hstep, voffA);
            PG8_WAIT_L(8); PG8_BAR; PG8_WAIT_L(0); PG8_MMA(0, 0, At, B0); PG8_BAR; PG8_SCHED;
            PG8_LDB(B1, 1, 1); PG8_STAGE(PG8_SB(1, 0), b3, voffB);
            PG8_BAR; PG8_WAIT_L(0); PG8_MMA(0, 1, At, B1); PG8_BAR;
            PG8_LDA(At, 1, 1); PG8_STAGE(PG8_SA(1, 0), a3, voffA);
            PG8_BAR; PG8_WAIT_L(0); PG8_MMA(1, 0, At, B0); PG8_BAR; PG8_SCHED;
            PG8_STAGE(PG8_SB(1, 1), b3 + hstep, voffB);
            PG8_WAIT_V(6); PG8_BAR; PG8_MMA(1, 1, At, B1); PG8_BAR;
            }
        }
        if constexpr (ALIGN_EPI) { if (wr == 0) PG8_BAR; }
        if constexpr (!Epi::AFTER_DRAIN) { E(acc, cur, wr, wc, fr, fq); S.done(cur); }
        if (!has_next) break;
#pragma unroll
        for (int a = 0; a < 2; ++a)
#pragma unroll
            for (int b = 0; b < 2; ++b)
#pragma unroll
                for (int m = 0; m < 4; ++m)
#pragma unroll
                    for (int n = 0; n < 2; ++n) acc[a][b][m][n] = (f32x4){0.f, 0.f, 0.f, 0.f};
        cur = nxt; cA = nA; cB = nB; ++ui;
        if constexpr (ALIGN_EPI) { if (wr == 1) PG8_BAR; }
    }
    PG8_WAIT_V(0);
    if constexpr (!ALIGN_EPI) { if (wr == 0) PG8_BAR; }
    PG8_BAR;
    if constexpr (Epi::AFTER_DRAIN) { E.fused(acc, cur, wr, wc, fr, fq, lds, wid, lane); S.done(cur); }
#undef PG8_SA
#undef PG8_SB
#undef PG8_STAGE
#undef PG8_LDA
#undef PG8_LDB
#undef PG8_MMA
#undef PG8_WAIT_V
#undef PG8_WAIT_L
#undef PG8_BAR
#undef PG8_SCHED
}
}
constexpr int NWAVES = 8, NTHREADS = 512;
constexpr int SEQ = 16384, NB = 2, T = NB * SEQ, D = 1024;
constexpr int E_IN = 1792, LRU_W = 512, FF0 = 2816;
constexpr int O_IN = 4112, GH = 8, GD = 128, GC = 64, NCH = SEQ / GC  , NUNIT = NB * GH * NCH  ;
constexpr int NE = 8, FFE = 3584;
constexpr int MAXTILES = 264, PASS_TILES = 64;
constexpr float EPS = 1e-6f;

constexpr size_t MiB = 1u << 20;
constexpr size_t WS_CTL = 0, CTL_ZERO_BYTES = 1 * MiB;
constexpr size_t WS_ROPE = 1 * MiB;
constexpr size_t WS_STA = 5 * MiB, WS_STB = 7 * MiB;
constexpr size_t WS_MISC = 9 * MiB;
constexpr size_t MS_LRU_A = WS_MISC, MS_LRU_H = WS_MISC + 512 * 1024;
constexpr size_t MS_TOKE = WS_MISC + 1 * MiB;
constexpr size_t MS_TOKW = MS_TOKE + 128 * 1024;
constexpr size_t MS_RANK = MS_TOKW + 256 * 1024;
constexpr size_t MS_DEST = MS_RANK + 256 * 1024;
constexpr size_t MS_CNT = MS_DEST + 256 * 1024;
constexpr size_t MS_TILEE = MS_CNT + 8 * 1024;
constexpr size_t MS_RG = MS_TILEE + 2 * 1024;
constexpr size_t MS_GLAST = WS_MISC + 3 * MiB;
constexpr size_t MS_WSK = MS_GLAST + 16 * 1024;
constexpr size_t MS_ROUT = MS_WSK + 32 * 1024;
constexpr size_t MS_AB = MS_ROUT + 32 * 1024;
constexpr size_t WS_W0 = 13 * MiB;
constexpr size_t W0_IN = WS_W0, W0_OUT = W0_IN + (size_t)E_IN * D * 2, W0_GU = W0_OUT + (size_t)D * D * 2, W0_DN = W0_GU + (size_t)2 * FF0 * D * 2;
constexpr size_t WS_W1 = 35 * MiB;
constexpr size_t W1_IN = WS_W1, W1_OUT = W1_IN + (size_t)4096 * D * 2;
constexpr size_t WS_AB = 46 * MiB;
constexpr size_t WS_HB = 48 * MiB;
constexpr size_t WS_WMD = 48 * MiB;
constexpr size_t WS_PROJ0 = 112 * MiB;
constexpr size_t WS_LRUH = 224 * MiB, WS_LRUP = 288 * MiB;
constexpr size_t WS_YMIX = 352 * MiB;
constexpr size_t WS_ACT0 = 112 * MiB;
constexpr size_t WS_QKV = 112 * MiB;
constexpr size_t WS_GATE = 304 * MiB;
constexpr size_t WS_HALO = 370 * MiB;
constexpr size_t WS_UT = 379 * MiB;
constexpr size_t WS_AQK = 443 * MiB;
constexpr size_t WS_WMGU = 112 * MiB;
constexpr size_t WS_ON = 224 * MiB;
constexpr size_t WS_HB3 = 304 * MiB;
constexpr size_t WS_XG = 380 * MiB;
constexpr size_t WS_ACT = 224 * MiB;
constexpr size_t WS_END = 512 * MiB;
static_assert(W0_DN + (size_t)D * FF0 * 2 <= WS_W1 && W1_OUT + (size_t)D * D * 2 <= WS_AB && MS_AB <= WS_W0, "ws map");
static_assert(WS_XG + (size_t)MAXTILES * 256 * 1024 * 2 <= WS_END && WS_ACT + (size_t)(PASS_TILES + 8) * 256 * FFE * 2 <= WS_XG, "ws map (MoE)");
constexpr int CW_TMO = 0, CW_BAR = 4096;

constexpr int RING_BYTES = 131072;
constexpr int LDSCTL_OFF = RING_BYTES, MISC_OFF = LDSCTL_OFF + 320;
constexpr int LDS_BYTES = 147456;

#define GAS __attribute__((address_space(1)))
#define LAS __attribute__((address_space(3)))
#define DI __device__ __forceinline__
typedef unsigned short bf16;
typedef unsigned v4u __attribute__((ext_vector_type(4)));
typedef unsigned v2u __attribute__((ext_vector_type(2)));
typedef float f32x4 __attribute__((ext_vector_type(4)));
typedef float f32x2 __attribute__((ext_vector_type(2)));
typedef short bf16x8 __attribute__((ext_vector_type(8)));
typedef short bf16x4 __attribute__((ext_vector_type(4)));
typedef GAS unsigned gu32;
#define LDS_WAIT() asm volatile("s_waitcnt lgkmcnt(0)" ::: "memory")
#define VM_WAIT() asm volatile("s_waitcnt vmcnt(0)" ::: "memory")
#define MFMA16(a, b, c) __builtin_amdgcn_mfma_f32_16x16x32_bf16((a), (b), (c), 0, 0, 0)
DI unsigned f2bf(float f) { unsigned u = __builtin_bit_cast(unsigned, f); return (u + 0x7fffu + ((u >> 16) & 1u)) >> 16; }
DI unsigned pk2(float lo, float hi) { return f2bf(lo) | (f2bf(hi) << 16); }
DI float bflo(unsigned w) { return __builtin_bit_cast(float, w << 16); }
DI float bfhi(unsigned w) { return __builtin_bit_cast(float, w & 0xffff0000u); }
DI float bf2f(bf16 v) { return __builtin_bit_cast(float, (unsigned)v << 16); }
DI float sigmoid_f(float x) { return __builtin_amdgcn_rcpf(1.0f + __expf(-x)); }
DI float silu_f(float x) { return x * sigmoid_f(x); }
DI float wave_sum(float v) {
#pragma unroll
    for (int o = 1; o < 64; o <<= 1) v += __shfl_xor(v, o);
    return v;
}
DI bf16x8 mk8(v2u lo, v2u hi) { v4u w; w.x = lo.x; w.y = lo.y; w.z = hi.x; w.w = hi.y; return __builtin_bit_cast(bf16x8, w); }
DI bf16x8 pack_acc2(const f32x4 a, const f32x4 b) { v4u w; w.x = pk2(a[0], a[1]); w.y = pk2(a[2], a[3]); w.z = pk2(b[0], b[1]); w.w = pk2(b[2], b[3]); return __builtin_bit_cast(bf16x8, w); }
#define XB_TMO      128
#define XB_XCNT(j)  (256  + 64 * (j))
#define XB_XSUB(j)  (1280 + 64 * (j))
#define XB_XGEN(j)  (2304 + 64 * (j))
#define XB_TOP      3328
#define XB_TOPGEN   3392
#define XCD_BAR_WORDS 3456
#define XB_SPIN_CAP (1u << 18)

__device__ __forceinline__ unsigned xb_ld(unsigned* p)              { return __hip_atomic_load(p, __ATOMIC_RELAXED, __HIP_MEMORY_SCOPE_AGENT); }
__device__ __forceinline__ unsigned xb_add(unsigned* p, unsigned v) { return __hip_atomic_fetch_add(p, v, __ATOMIC_RELAXED, __HIP_MEMORY_SCOPE_AGENT); }
__device__ __forceinline__ unsigned xb_xcc_id() { return (unsigned)__builtin_amdgcn_s_getreg((3 << 11) | 20) & 0xFu; }
#define XB_SPIN(cond, bar) do { unsigned _sp = 0; while (cond) { __builtin_amdgcn_s_sleep(1); \
    if ((++_sp & 255u) == 0u) { if (xb_ld(&(bar)[XB_TMO])) break; if (_sp > XB_SPIN_CAP) { atomicAdd(&(bar)[XB_TMO], 1u); break; } } } } while (0)

struct XcdBarrier {
    unsigned* bar; unsigned x;
    volatile LAS unsigned* st;
};

__device__ __forceinline__ XcdBarrier xcd_barrier_post(unsigned* bar, volatile LAS unsigned* st) {
    XcdBarrier b; b.bar = bar; b.x = xb_xcc_id(); b.st = st;
    if (threadIdx.x == 0) (void)xb_add(&bar[XB_XCNT(b.x)], 1u);
    return b;
}
__device__ __forceinline__ void xcd_barrier_complete(unsigned* bar, unsigned x, unsigned& nloc, unsigned& nx) {
    const unsigned G = gridDim.x * gridDim.y * gridDim.z;
    unsigned sum, cnt, mine, sp = 0u;
    for (;;) {
        sum = 0u; cnt = 0u; mine = 0u;
#pragma unroll
        for (unsigned j = 0; j < 16; ++j) { const unsigned c = xb_ld(&bar[XB_XCNT(j)]); sum += c; cnt += (c > 0u) ? 1u : 0u; mine = (j == x) ? c : mine; }
        if (sum == G) break;
        __builtin_amdgcn_s_sleep(1);
        if ((++sp & 255u) == 0u) { if (xb_ld(&bar[XB_TMO])) break; if (sp > XB_SPIN_CAP) { atomicAdd(&bar[XB_TMO], 1u); break; } }
    }
    nloc = mine > 0u ? mine : 1u; nx = cnt > 0u ? cnt : 1u;
}

__device__ __forceinline__ void xcd_barrier(const XcdBarrier& b) {
    asm volatile("s_waitcnt vmcnt(0)" ::: "memory");
    __syncthreads();
    if (threadIdx.x == 0) {
        unsigned* bar = b.bar;
        __builtin_amdgcn_s_waitcnt(0);
        unsigned nloc = b.st[0], nx = b.st[1];
        if (nloc == 0u) { xcd_barrier_complete(bar, b.x, nloc, nx); b.st[0] = nloc; b.st[1] = nx; }
        const unsigned old = xb_add(&bar[XB_XSUB(b.x)], 1u);
        const unsigned gen = old / nloc;
        if (old + 1u == (gen + 1u) * nloc) {
            __builtin_amdgcn_fence(__ATOMIC_RELEASE, "agent");
            asm volatile("s_waitcnt vmcnt(0)" ::: "memory");
            const unsigned og = xb_add(&bar[XB_TOP], 1u);
            const unsigned tg = og / nx;
            if (og + 1u == (tg + 1u) * nx) xb_add(&bar[XB_TOPGEN], 1u);
            else XB_SPIN(xb_ld(&bar[XB_TOPGEN]) == tg, bar);
            __builtin_amdgcn_fence(__ATOMIC_ACQUIRE, "agent");
            xb_add(&bar[XB_XGEN(b.x)], 1u);
            asm volatile("s_waitcnt vmcnt(0)" ::: "memory");
        } else {
            XB_SPIN(xb_ld(&bar[XB_XGEN(b.x)]) == gen, bar);
            __builtin_amdgcn_fence(__ATOMIC_ACQUIRE, "agent");
            asm volatile("s_waitcnt vmcnt(0)" ::: "memory");
        }
    }
    __syncthreads();
}
DI void cvt_item(const float* W, int ldw, int K, const float* gain, bf16* WT, int drow0, int k0, int n0, LAS float* scr, int lane) {
#pragma unroll 8
    for (int i = 0; i < 32; ++i) { const int kk = 2 * i + (lane >> 5); scr[kk * 33 + (lane & 31)] = W[(size_t)(k0 + kk) * ldw + n0 + (lane & 31)]; }
    LDS_WAIT();
    const int c = lane & 7;
    float gk[8];
#pragma unroll
    for (int e = 0; e < 8; ++e) gk[e] = gain ? gain[k0 + 8 * c + e] : 1.0f;
#pragma unroll
    for (int j = 0; j < 4; ++j) { const int n = (lane >> 3) + 8 * j; const LAS float* s = scr + (8 * c) * 33 + n;
        v4u o; o.x = pk2(s[0 * 33] * gk[0], s[1 * 33] * gk[1]); o.y = pk2(s[2 * 33] * gk[2], s[3 * 33] * gk[3]); o.z = pk2(s[4 * 33] * gk[4], s[5 * 33] * gk[5]); o.w = pk2(s[6 * 33] * gk[6], s[7 * 33] * gk[7]);
        *(v4u*)(WT + (size_t)(drow0 + n) * K + k0 + 8 * c) = o; }
    LDS_WAIT();
}
DI void cvt_plain(const float* W, int ldw, int K, int N, const float* gain, bf16* WT, int it, LAS float* scr, int lane) {
    const int nblk = N / 32, kb = it / nblk, nb = it % nblk; cvt_item(W, ldw, K, gain, WT, 32 * nb, 64 * kb, 32 * nb, scr, lane);
}
DI void cvt_gu(const float* W, int K, int N, const float* gain, bf16* WT, int up, int it, LAS float* scr, int lane) {
    const int nblk = N / 32, kb = it / nblk, nb = it % nblk, n0 = 32 * nb; cvt_item(W, N, K, gain, WT, (n0 >> 7) * 256 + up * 128 + (n0 & 127), 64 * kb, n0, scr, lane);
}
struct Args { const float* in[28]; float* out; unsigned char* ws; int ph_lo, ph_hi; };
enum { I_X = 0, I_LNMIX, I_LNFFN, I_EWIN, I_CONVW, I_CONVB, I_WA, I_BA, I_WI, I_BI, I_LAM, I_QN, I_KN, I_SINK, I_EWOUT, I_FG, I_FU, I_FD,
       I_OWIN, I_OCONV, I_ALOG, I_DTB, I_ONORM, I_OWOUT, I_ROUT, I_MG, I_MU, I_MD };

DI void phase_prologue(const Args& a, LAS unsigned char* lds, int gw, int NGW, int wave, int lane) {
    unsigned char* ws = a.ws;
    LAS float* scr = (LAS float*)(lds + wave * 16384);
    constexpr int I1 = 16 * 56, I2 = 16 * 32, I3 = 16 * 88, I5 = 44 * 32, I6 = 16 * 128, I7 = 16 * 32, NIT = I1 + I2 + 2 * I3 + I5 + I6 + I7;
    for (int it = gw; it < NIT; it += NGW) {
        int r = it;
        if (r < I1) { cvt_plain(a.in[I_EWIN], E_IN, D, E_IN, a.in[I_LNMIX], (bf16*)(ws + W0_IN), r, scr, lane); continue; } r -= I1;
        if (r < I2) { cvt_plain(a.in[I_EWOUT], D, D, D, nullptr, (bf16*)(ws + W0_OUT), r, scr, lane); continue; } r -= I2;
        if (r < I3) { cvt_gu(a.in[I_FG], D, FF0, a.in[I_LNFFN], (bf16*)(ws + W0_GU), 0, r, scr, lane); continue; } r -= I3;
        if (r < I3) { cvt_gu(a.in[I_FU], D, FF0, a.in[I_LNFFN], (bf16*)(ws + W0_GU), 1, r, scr, lane); continue; } r -= I3;
        if (r < I5) { cvt_plain(a.in[I_FD], D, FF0, D, nullptr, (bf16*)(ws + W0_DN), r, scr, lane); continue; } r -= I5;
        if (r < I6) { cvt_plain(a.in[I_OWIN], O_IN, D, 4096, a.in[I_LNMIX] + D, (bf16*)(ws + W1_IN), r, scr, lane); continue; } r -= I6;
        cvt_plain(a.in[I_OWOUT], D, D, D, nullptr, (bf16*)(ws + W1_OUT), r, scr, lane);
    }
    const int gt = gw * 64 + lane, NGT = NGW * 64;
    for (int i = gt; i < 16 * D; i += NGT) { const int c = i >> 10, k = i & 1023; ((bf16*)(ws + MS_WSK))[i] = (bf16)f2bf(a.in[I_OWIN][(size_t)k * O_IN + 4096 + c] * a.in[I_LNMIX][D + k]); }
    for (int i = gt; i < 8 * D; i += NGT) { const int k = i >> 3; ((float*)(ws + MS_ROUT))[i] = a.in[I_ROUT][i] * a.in[I_LNFFN][D + k]; }
    for (int i = gt; i < SEQ * 32; i += NGT) { const int pos = i >> 5, f = i & 31;
        const float inv = powf(10000.0f, -(float)f * (1.0f / 32.0f)); const float ang = (float)pos * inv;
        const double tt = (double)ang * 0.15915494309189535; const float fr = (float)(tt - rint(tt));
        f32x2 cs; cs.x = __builtin_amdgcn_cosf(fr); cs.y = __builtin_amdgcn_sinf(fr); ((f32x2*)(ws + WS_ROPE))[i] = cs; }
    for (int m = gw; m < T; m += NGW) {
        const f32x4* xr = (const f32x4*)(a.in[I_X] + (size_t)m * D) + lane; f32x4 v[4]; float s = 0.f;
#pragma unroll
        for (int j = 0; j < 4; ++j) { v[j] = xr[64 * j]; s += (v[j].x * v[j].x + v[j].y * v[j].y) + (v[j].z * v[j].z + v[j].w * v[j].w); }
        s = wave_sum(s);
        v2u* o8 = (v2u*)((bf16*)(ws + WS_HB) + (size_t)m * D) + lane;
#pragma unroll
        for (int j = 0; j < 4; ++j) { v2u w; w.x = pk2(v[j].x, v[j].y); w.y = pk2(v[j].z, v[j].w); o8[64 * j] = w; }
        if (lane < 16) ((float*)(ws + WS_STA))[(size_t)m * 16 + lane] = lane == 0 ? s : 0.f;
    }
}
constexpr int MOE_D_ITEMS = NE * 56 * 32, MOE_GU_ITEMS = NE * 2 * 16 * 112;
DI void cvt_moe_down(const Args& a, int it, LAS float* scr, int lane) {
    const int e = it / (56 * 32), r = it % (56 * 32);
    cvt_plain(a.in[I_MD] + (size_t)e * FFE * D, D, FFE, D, nullptr, (bf16*)(a.ws + WS_WMD) + (size_t)e * D * FFE, r, scr, lane);
}
DI void cvt_moe_gu(const Args& a, int it, LAS float* scr, int lane) {
    const int e = it / (2 * 16 * 112), r0 = it % (2 * 16 * 112), up = r0 / (16 * 112), r = r0 % (16 * 112);
    cvt_gu((up ? a.in[I_MU] : a.in[I_MG]) + (size_t)e * D * FFE, D, FFE, a.in[I_LNFFN] + D, (bf16*)(a.ws + WS_WMGU) + (size_t)e * 2 * FFE * D, up, r, scr, lane);
}

struct LruFrags { bf16x8 wa[4][2], wi[4][2]; };
DI void lru_frags(const Args& a, LAS unsigned char* lds, LruFrags& F, int wave, int lane) {
    const int g = lane >> 4, c16 = lane & 15;
    LAS float* scr = (LAS float*)(lds + wave * 16384);
#pragma unroll
    for (int gate = 0; gate < 2; ++gate) {
        const f32x4* W = (const f32x4*)((gate ? a.in[I_WI] : a.in[I_WA]) + wave * 4096);
#pragma unroll
        for (int q = 0; q < 16; ++q) ((LAS f32x4*)scr)[q * 64 + lane] = W[q * 64 + lane];
        LDS_WAIT();
        const LAS float* sp = scr + (8 * g) * 64 + c16;
#pragma unroll
        for (int jt = 0; jt < 4; ++jt)
#pragma unroll
            for (int ks = 0; ks < 2; ++ks) { float t[8];
#pragma unroll
                for (int e = 0; e < 8; ++e) t[e] = sp[(32 * ks + e) * 64 + 16 * jt];
                v4u p; p.x = pk2(t[0], t[1]); p.y = pk2(t[2], t[3]); p.z = pk2(t[4], t[5]); p.w = pk2(t[6], t[7]);
                if (gate) F.wi[jt][ks] = __builtin_bit_cast(bf16x8, p); else F.wa[jt][ks] = __builtin_bit_cast(bf16x8, p); }
        LDS_WAIT();
    }
}
DI void lru_unit(const Args& a, LAS unsigned char* lds, const LruFrags& F, int unit, int wave, int lane) {
    unsigned char* ws = a.ws;
    const int b = unit >> 7, chk = unit & 127, t0 = chk * 128, g = lane >> 4, c16 = lane & 15;
    const size_t rowb = (size_t)b * SEQ;
    const bf16* proj0 = (const bf16*)(ws + WS_PROJ0);
    float* hloc = (float*)(ws + WS_LRUH); float* pcum = (float*)(ws + WS_LRUP);
    const int c = wave * 64 + lane;
    const float w0 = a.in[I_CONVW][c], w1 = a.in[I_CONVW][512 + c], w2 = a.in[I_CONVW][1024 + c], w3 = a.in[I_CONVW][1536 + c], cb = a.in[I_CONVB][c];
    const float ba = a.in[I_BA][c], bi = a.in[I_BI][c], lam = a.in[I_LAM][c];
    const float sp8 = 8.0f * (lam < -20.f ? -lam : log1pf(expf(-lam)));
    LAS bf16* XC = (LAS bf16*)(lds + wave * 11264);
    LAS float* GA = (LAS float*)(lds + wave * 11264 + 2304);
    LAS float* GI = GA + 16 * 68;
    float x1 = 0.f, x2 = 0.f, x3 = 0.f;
    if (t0 > 0) { x1 = bf2f(proj0[(rowb + t0 - 1) * E_IN + c]); x2 = bf2f(proj0[(rowb + t0 - 2) * E_IN + c]); x3 = bf2f(proj0[(rowb + t0 - 3) * E_IN + c]); }
    float h = 0.f, P = 1.f;
#pragma unroll 1
    for (int st = 0; st < 8; ++st) {
        float xc[16];
#pragma unroll
        for (int tt = 0; tt < 16; ++tt) { const float xn = bf2f(proj0[(rowb + t0 + 16 * st + tt) * E_IN + c]);
            xc[tt] = w0 * x3 + w1 * x2 + w2 * x1 + w3 * xn + cb; x3 = x2; x2 = x1; x1 = xn; XC[tt * 72 + lane] = (bf16)f2bf(xc[tt]); }
        LDS_WAIT();
        bf16x8 bx[2];
#pragma unroll
        for (int ks = 0; ks < 2; ++ks) bx[ks] = *(const LAS bf16x8*)(XC + c16 * 72 + 32 * ks + 8 * g);
#pragma unroll
        for (int jt = 0; jt < 4; ++jt) { f32x4 ca = {0.f, 0.f, 0.f, 0.f}, ci = {0.f, 0.f, 0.f, 0.f};
#pragma unroll
            for (int ks = 0; ks < 2; ++ks) { ca = MFMA16(F.wa[jt][ks], bx[ks], ca); ci = MFMA16(F.wi[jt][ks], bx[ks], ci); }
            *(LAS f32x4*)(GA + c16 * 68 + 16 * jt + 4 * g) = ca; *(LAS f32x4*)(GI + c16 * 68 + 16 * jt + 4 * g) = ci; }
        LDS_WAIT();
#pragma unroll
        for (int tt = 0; tt < 16; ++tt) {
            const float r = sigmoid_f(GA[tt * 68 + lane] + ba), gi = sigmoid_f(GI[tt * 68 + lane] + bi);
            const float la = -sp8 * r, av = __expf(la), mult = sqrtf(fmaxf(1.0f - av * av, 0.f));
            h = av * h + mult * gi * xc[tt]; P *= av;
            const size_t o = (rowb + t0 + 16 * st + tt) * LRU_W + c; hloc[o] = h; pcum[o] = P; }
        LDS_WAIT();
    }
    ((float*)(ws + MS_LRU_A))[(size_t)unit * 512 + c] = P; ((float*)(ws + MS_LRU_H))[(size_t)unit * 512 + c] = h;
}

DI void attn_unit(const Args& a, LAS unsigned char* lds, int unit, int tid, int wave, int lane) {
    unsigned char* ws = a.ws;
    const int kvh = unit & 1, blk = (unit >> 1) & 127, b = unit >> 8, t0 = blk * 128, g = lane >> 4, c = lane & 15;
    const size_t rowb = (size_t)b * SEQ;
    const bf16* proj0 = (const bf16*)(ws + WS_PROJ0); const f32x2* rope = (const f32x2*)(ws + WS_ROPE);
    LAS bf16* Ks = (LAS bf16*)lds;
    LAS bf16* Vt = (LAS bf16*)(lds + 36864);
    {
        const int key = tid >> 1, p = tid & 1, pos = t0 - 128 + key;
        if (pos >= 0) {
            const bf16* src = proj0 + (rowb + pos) * E_IN + 1536 + kvh * 64;
            const v4u q0 = *(const v4u*)(src + 16 * p), q1 = *(const v4u*)(src + 16 * p + 8), q2 = *(const v4u*)(src + 32 + 16 * p), q3 = *(const v4u*)(src + 32 + 16 * p + 8);
            float xa[16], xb[16];
            xa[0] = bflo(q0.x); xa[1] = bfhi(q0.x); xa[2] = bflo(q0.y); xa[3] = bfhi(q0.y); xa[4] = bflo(q0.z); xa[5] = bfhi(q0.z); xa[6] = bflo(q0.w); xa[7] = bfhi(q0.w);
            xa[8] = bflo(q1.x); xa[9] = bfhi(q1.x); xa[10] = bflo(q1.y); xa[11] = bfhi(q1.y); xa[12] = bflo(q1.z); xa[13] = bfhi(q1.z); xa[14] = bflo(q1.w); xa[15] = bfhi(q1.w);
            xb[0] = bflo(q2.x); xb[1] = bfhi(q2.x); xb[2] = bflo(q2.y); xb[3] = bfhi(q2.y); xb[4] = bflo(q2.z); xb[5] = bfhi(q2.z); xb[6] = bflo(q2.w); xb[7] = bfhi(q2.w);
            xb[8] = bflo(q3.x); xb[9] = bfhi(q3.x); xb[10] = bflo(q3.y); xb[11] = bfhi(q3.y); xb[12] = bflo(q3.z); xb[13] = bfhi(q3.z); xb[14] = bflo(q3.w); xb[15] = bfhi(q3.w);
            float ss = 0.f;
#pragma unroll
            for (int e = 0; e < 16; ++e) ss += xa[e] * xa[e] + xb[e] * xb[e];
            ss += __shfl_xor(ss, 1);
            const float rn = __builtin_amdgcn_rsqf(ss * (1.0f / 64.0f) + EPS);
            unsigned oa[8], ob[8];
#pragma unroll
            for (int e = 0; e < 16; e += 2) { float r1[2], r2[2];
#pragma unroll
                for (int k = 0; k < 2; ++k) { const int d = 16 * p + e + k; const f32x2 cs = rope[(size_t)pos * 32 + d];
                    const float y1 = xa[e + k] * rn * a.in[I_KN][d], y2 = xb[e + k] * rn * a.in[I_KN][32 + d]; r1[k] = y1 * cs.x - y2 * cs.y; r2[k] = y2 * cs.x + y1 * cs.y; }
                oa[e >> 1] = pk2(r1[0], r1[1]); ob[e >> 1] = pk2(r2[0], r2[1]); }
            v4u w; w.x = oa[0]; w.y = oa[1]; w.z = oa[2]; w.w = oa[3]; *(LAS v4u*)(Ks + key * 72 + 16 * p) = w;
            w.x = oa[4]; w.y = oa[5]; w.z = oa[6]; w.w = oa[7]; *(LAS v4u*)(Ks + key * 72 + 16 * p + 8) = w;
            w.x = ob[0]; w.y = ob[1]; w.z = ob[2]; w.w = ob[3]; *(LAS v4u*)(Ks + key * 72 + 32 + 16 * p) = w;
            w.x = ob[4]; w.y = ob[5]; w.z = ob[6]; w.w = ob[7]; *(LAS v4u*)(Ks + key * 72 + 32 + 16 * p + 8) = w;
            const bf16* vs = proj0 + (rowb + pos) * E_IN + 1664 + kvh * 64 + 32 * p;
#pragma unroll
            for (int q = 0; q < 4; ++q) { const v4u vv = *(const v4u*)(vs + 8 * q); const unsigned vw[4] = {vv.x, vv.y, vv.z, vv.w};
#pragma unroll
                for (int e = 0; e < 4; ++e) { Vt[(32 * p + 8 * q + 2 * e) * 264 + key] = (bf16)(vw[e] & 0xffffu); Vt[(32 * p + 8 * q + 2 * e + 1) * 264 + key] = (bf16)(vw[e] >> 16); } }
        } else {
            const v4u z = {0u, 0u, 0u, 0u};
            *(LAS v4u*)(Ks + key * 72 + 16 * p) = z; *(LAS v4u*)(Ks + key * 72 + 16 * p + 8) = z; *(LAS v4u*)(Ks + key * 72 + 32 + 16 * p) = z; *(LAS v4u*)(Ks + key * 72 + 32 + 16 * p + 8) = z;
#pragma unroll
            for (int e = 0; e < 32; ++e) Vt[(32 * p + e) * 264 + key] = (bf16)0;
        }
    }
    __syncthreads();
    const int hq = kvh * 4 + (wave >> 1), qh = wave & 1; const float sink = a.in[I_SINK][hq];
    bf16* ymix = (bf16*)(ws + WS_YMIX);
    for (int qt = 0; qt < 4; ++qt) {
        const int q0 = 64 * qh + 16 * qt, kt0 = 4 * qh + qt; const int tok = t0 + q0 + c;
        bf16x8 bq[2];
        {   const bf16* src = proj0 + (rowb + tok) * E_IN + 1024 + hq * 64;
            const v4u r0 = *(const v4u*)(src + 8 * g), r1 = *(const v4u*)(src + 32 + 8 * g);
            const unsigned u0[4] = {r0.x, r0.y, r0.z, r0.w}, u1[4] = {r1.x, r1.y, r1.z, r1.w}; float xa[8], xb[8]; float ss = 0.f;
#pragma unroll
            for (int e = 0; e < 4; ++e) { xa[2 * e] = bflo(u0[e]); xa[2 * e + 1] = bfhi(u0[e]); xb[2 * e] = bflo(u1[e]); xb[2 * e + 1] = bfhi(u1[e]); }
#pragma unroll
            for (int e = 0; e < 8; ++e) ss += xa[e] * xa[e] + xb[e] * xb[e];
            ss += __shfl_xor(ss, 16); ss += __shfl_xor(ss, 32);
            const float rn = __builtin_amdgcn_rsqf(ss * (1.0f / 64.0f) + EPS) * 0.125f;
            float o1[8], o2[8];
#pragma unroll
            for (int e = 0; e < 8; ++e) { const int d = 8 * g + e; const f32x2 cs = rope[(size_t)tok * 32 + d];
                const float y1 = xa[e] * rn * a.in[I_QN][d], y2 = xb[e] * rn * a.in[I_QN][32 + d]; o1[e] = y1 * cs.x - y2 * cs.y; o2[e] = y2 * cs.x + y1 * cs.y; }
            v4u w; w.x = pk2(o1[0], o1[1]); w.y = pk2(o1[2], o1[3]); w.z = pk2(o1[4], o1[5]); w.w = pk2(o1[6], o1[7]); bq[0] = __builtin_bit_cast(bf16x8, w);
            w.x = pk2(o2[0], o2[1]); w.y = pk2(o2[2], o2[3]); w.z = pk2(o2[4], o2[5]); w.w = pk2(o2[6], o2[7]); bq[1] = __builtin_bit_cast(bf16x8, w);
        }
        f32x4 s[9]; float mx = -1e30f;
        const int qi = 128 + q0 + c;
#pragma unroll
        for (int kt = 0; kt < 9; ++kt) {
            const LAS bf16* kp = Ks + (16 * (kt0 + kt) + c) * 72 + 8 * g;
            f32x4 acc = {0.f, 0.f, 0.f, 0.f};
            acc = MFMA16(*(const LAS bf16x8*)kp, bq[0], acc); acc = MFMA16(*(const LAS bf16x8*)(kp + 32), bq[1], acc);
#pragma unroll
            for (int r = 0; r < 4; ++r) { const int kj = 16 * (kt0 + kt) + 4 * g + r; const bool ok = (kj <= qi) && (qi - kj < 128) && (blk > 0 || kj >= 128);
                acc[r] = ok ? acc[r] : -1e30f; mx = fmaxf(mx, acc[r]); }
            s[kt] = acc;
        }
        mx = fmaxf(mx, __shfl_xor(mx, 16)); mx = fmaxf(mx, __shfl_xor(mx, 32)); mx = fmaxf(mx, sink);
        float sum = 0.f;
#pragma unroll
        for (int kt = 0; kt < 9; ++kt)
#pragma unroll
            for (int r = 0; r < 4; ++r) { const float p = (s[kt][r] > -1e29f) ? __expf(s[kt][r] - mx) : 0.f; s[kt][r] = p; sum += p; }
        sum += __shfl_xor(sum, 16); sum += __shfl_xor(sum, 32); sum += __expf(sink - mx);
        const float inv = __builtin_amdgcn_rcpf(sum);
        bf16x8 bp[5];
#pragma unroll
        for (int pp = 0; pp < 4; ++pp) bp[pp] = pack_acc2(s[2 * pp] * inv, s[2 * pp + 1] * inv);
        { const f32x4 z = {0.f, 0.f, 0.f, 0.f}; bp[4] = pack_acc2(s[8] * inv, z); }
#pragma unroll
        for (int dt = 0; dt < 4; ++dt) { f32x4 o = {0.f, 0.f, 0.f, 0.f};
#pragma unroll
            for (int pp = 0; pp < 5; ++pp) { const LAS bf16* vp = Vt + (16 * dt + c) * 264 + 16 * (kt0 + 2 * pp) + 4 * g;
                const v2u lo = *(const LAS v2u*)vp, hi = *(const LAS v2u*)(vp + (pp < 4 ? 16 : 0)); o = MFMA16(mk8(lo, hi), bp[pp], o); }
            v2u w; w.x = pk2(o[0], o[1]); w.y = pk2(o[2], o[3]); *(v2u*)(ymix + (rowb + tok) * D + 512 + hq * 64 + 16 * dt + 4 * g) = w; }
    }
    __syncthreads();
}

DI void lrufix_unit(const Args& a, int unit, int tid) {
    unsigned char* ws = a.ws;
    const int b = unit >> 7, chk = unit & 127, c = tid;
    const float* At = (const float*)(ws + MS_LRU_A); const float* Ht = (const float*)(ws + MS_LRU_H);
    float hin = 0.f;
    for (int cc = 0; cc < chk; ++cc) { const size_t o = (size_t)(b * 128 + cc) * 512 + c; hin = At[o] * hin + Ht[o]; }
    const float* hloc = (const float*)(ws + WS_LRUH); const float* pcum = (const float*)(ws + WS_LRUP);
    const bf16* proj0 = (const bf16*)(ws + WS_PROJ0); bf16* ymix = (bf16*)(ws + WS_YMIX);
#pragma unroll 4
    for (int t = 0; t < 128; ++t) { const size_t row = (size_t)b * SEQ + chk * 128 + t;
        const float h = hloc[row * LRU_W + c] + pcum[row * LRU_W + c] * hin; const float x = bf2f(proj0[row * E_IN + 512 + c]);
        const float z = 0.7978845608028654f * (x + 0.044715f * x * x * x); const float th = 1.0f - 2.0f * __builtin_amdgcn_rcpf(1.0f + __expf(2.0f * z));
        ymix[row * D + c] = (bf16)f2bf(h * 0.5f * x * (1.0f + th)); }
}
DI void skinny_tile(const Args& a, int tile, int lane) {
    unsigned char* ws = a.ws; const int g = lane >> 4, c = lane & 15;
    const bf16* wsk = (const bf16*)(ws + MS_WSK) + c * D + 8 * g; const bf16* hb = (const bf16*)(ws + WS_HB) + (size_t)(tile * 16 + c) * D + 8 * g;
    f32x4 acc = {0.f, 0.f, 0.f, 0.f};
#pragma unroll 8
    for (int ks = 0; ks < 32; ++ks) acc = MFMA16(*(const bf16x8*)(wsk + 32 * ks), *(const bf16x8*)(hb + 32 * ks), acc);
    const int row = tile * 16 + c; const float rs = pg8::rstd16((const float*)(ws + WS_STA), row);
    *(f32x4*)((float*)(ws + WS_AB) + (size_t)row * 16 + 4 * g) = acc * rs;
}

constexpr int PR_XQ = 0, PR_XK = 17408, PR_KT = 34816, PR_VT = 53248, PR_LS = 71680, PR_T1 = 89088, PR_T2 = 98304, PR_VEC = 107520;
DI void prep_unit(const Args& a, LAS unsigned char* lds, int unit, int tid, int wave, int lane) {
    unsigned char* ws = a.ws;
    const int ck = unit & 255, h = (unit >> 8) & 7, b = unit >> 11, g = lane >> 4, c = lane & 15;
    const size_t R0 = (size_t)b * SEQ + (size_t)ck * 64;
    bf16* qkv = (bf16*)(ws + WS_QKV);
    LAS bf16* XQ = (LAS bf16*)(lds + PR_XQ); LAS bf16* XK = (LAS bf16*)(lds + PR_XK); LAS bf16* KT = (LAS bf16*)(lds + PR_KT); LAS bf16* VT = (LAS bf16*)(lds + PR_VT);
    LAS float* Ls = (LAS float*)(lds + PR_LS); LAS bf16* T1 = (LAS bf16*)(lds + PR_T1); LAS bf16* T2 = (LAS bf16*)(lds + PR_T2);
    LAS float* Gs = (LAS float*)(lds + PR_VEC); LAS float* Bs = Gs + 64; LAS float* Rq = Gs + 128; LAS float* Rk = Gs + 192;
    if (tid < 384) {
        const int part = wave >> 1, ch = tid & 127, col = part * 1024 + h * 128 + ch;
        const float w0 = a.in[I_OCONV][col], w1 = a.in[I_OCONV][3072 + col], w2 = a.in[I_OCONV][6144 + col], w3 = a.in[I_OCONV][9216 + col];
        float x1 = 0.f, x2 = 0.f, x3 = 0.f;
        if (ck > 0) { const bf16* hp = (const bf16*)(ws + WS_HALO) + (size_t)(b * NCH + ck - 1) * 3 * 3072 + col; x3 = bf2f(hp[0]); x2 = bf2f(hp[3072]); x1 = bf2f(hp[6144]); }
        const bf16* src = qkv + R0 * 3072 + col;
        for (int j4 = 0; j4 < 16; ++j4) { float y[4];
#pragma unroll
            for (int e = 0; e < 4; ++e) { const float xn = bf2f(src[(size_t)(4 * j4 + e) * 3072]); const float v = w0 * x3 + w1 * x2 + w2 * x1 + w3 * xn; x3 = x2; x2 = x1; x1 = xn; y[e] = silu_f(v); }
            if (part == 0) {
#pragma unroll
                for (int e = 0; e < 4; ++e) XQ[(4 * j4 + e) * 136 + ch] = (bf16)f2bf(y[e]);
            } else { v2u w; w.x = pk2(y[0], y[1]); w.y = pk2(y[2], y[3]);
                if (part == 1) {
#pragma unroll
                    for (int e = 0; e < 4; ++e) XK[(4 * j4 + e) * 136 + ch] = (bf16)f2bf(y[e]);
                    *(LAS v2u*)(KT + ch * 72 + 4 * j4) = w;
                } else *(LAS v2u*)(VT + ch * 72 + 4 * j4) = w; }
        }
    } else if (wave == 6) {
        const float* ab = (const float*)(ws + WS_AB) + (R0 + lane) * 16;
        const float xin = ab[h] + a.in[I_DTB][h]; const float sp = xin > 20.f ? xin : log1pf(expf(xin));
        float G = -expf(a.in[I_ALOG][h]) * sp;
#pragma unroll
        for (int o = 1; o < 64; o <<= 1) { const float v = __shfl_up(G, o); if (lane >= o) G += v; }
        Gs[lane] = G; Bs[lane] = sigmoid_f(ab[8 + h]);
        if (lane == 63) ((float*)(ws + MS_GLAST))[unit] = expf(G);
    } else {
        const f32x4 z = {0.f, 0.f, 0.f, 0.f};
        for (int i = lane; i < 64 * 68 / 4; i += 64) ((LAS f32x4*)Ls)[i] = z;
    }
    __syncthreads();
    { const int row = tid >> 2, qtr = tid & 3; const LAS bf16* s = (row < 64 ? XQ + row * 136 : XK + (row - 64) * 136) + 32 * qtr; float ss = 0.f;
#pragma unroll
      for (int q = 0; q < 4; ++q) { const v4u v = *(const LAS v4u*)(s + 8 * q); const unsigned vw[4] = {v.x, v.y, v.z, v.w};
#pragma unroll
          for (int e = 0; e < 4; ++e) { const float l = bflo(vw[e]), hh = bfhi(vw[e]); ss += l * l + hh * hh; } }
      ss += __shfl_xor(ss, 1); ss += __shfl_xor(ss, 2);
      const float rn = __builtin_amdgcn_rsqf(ss + EPS);
      if (qtr == 0) { if (row < 64) Rq[row] = rn * 0.08838834764831845f; else Rk[row - 64] = rn; } }
    __syncthreads();
    bf16* aq = (bf16*)(ws + WS_AQK) + (size_t)unit * 4096;
    for (int job = wave; job < 26; job += 8) {
        int it, jt; const bool isk = job < 10;
        if (isk) { it = job >= 6 ? 3 : (job >= 3 ? 2 : (job >= 1 ? 1 : 0)); jt = job - it * (it + 1) / 2; } else { it = (job - 10) >> 2; jt = (job - 10) & 3; }
        const int i = 16 * it + c, j0 = 16 * jt + 4 * g;
        if (it < jt) { const v2u z = {0u, 0u}; *(v2u*)(aq + i * 64 + j0) = z; continue; }
        const LAS bf16* ap = XK + (16 * jt + c) * 136 + 8 * g; const LAS bf16* bp = (isk ? XK : XQ) + (16 * it + c) * 136 + 8 * g;
        f32x4 acc = {0.f, 0.f, 0.f, 0.f};
#pragma unroll
        for (int ks = 0; ks < 4; ++ks) acc = MFMA16(*(const LAS bf16x8*)(ap + 32 * ks), *(const LAS bf16x8*)(bp + 32 * ks), acc);
        const float Gi = Gs[i], ri = isk ? Bs[i] * Rk[i] : Rq[i]; f32x4 o;
#pragma unroll
        for (int r = 0; r < 4; ++r) { const int j = j0 + r; const bool ok = isk ? (i > j) : (i >= j); const float dcy = __expf(fminf(Gi - Gs[j], 0.f)); o[r] = ok ? acc[r] * ri * Rk[j] * dcy : 0.f; }
        if (isk) *(LAS f32x4*)(Ls + i * 68 + j0) = o; else { v2u w; w.x = pk2(o[0], o[1]); w.y = pk2(o[2], o[3]); *(v2u*)(aq + i * 64 + j0) = w; }
    }
    __syncthreads();
    if (wave == 0) {
        float t[64]; int ln = lane; asm volatile("" : "+v"(ln));
#pragma unroll
        for (int i = 0; i < 64; ++i) { float acc = (i == ln) ? 1.f : 0.f;
#pragma unroll
            for (int k4 = 0; k4 < (i + 3) / 4; ++k4) { const f32x4 l = *(const LAS f32x4*)(Ls + i * 68 + 4 * k4);
#pragma unroll
                for (int e = 0; e < 4; ++e) if (4 * k4 + e < i) acc -= l[e] * t[4 * k4 + e]; }
            t[i] = acc; }
        const float bj = Bs[lane], s1 = bj, s2 = -bj * __expf(Gs[lane]) * Rk[lane];
#pragma unroll
        for (int i = 0; i < 64; ++i) { T1[i * 72 + lane] = (bf16)f2bf(t[i] * s1); T2[i * 72 + lane] = (bf16)f2bf(t[i] * s2); }
    } else {
        const float Gl = Gs[63];
        for (int task = tid - 64; task < 2048; task += 448) {
            if (task < 1024) { const int i = task >> 4, dc = task & 15; const float sc = Rq[i] * __expf(Gs[i]);
                const v4u v = *(const LAS v4u*)(XQ + i * 136 + 8 * dc); v4u o;
                o.x = pk2(bflo(v.x) * sc, bfhi(v.x) * sc); o.y = pk2(bflo(v.y) * sc, bfhi(v.y) * sc); o.z = pk2(bflo(v.z) * sc, bfhi(v.z) * sc); o.w = pk2(bflo(v.w) * sc, bfhi(v.w) * sc);
                *(v4u*)(qkv + (R0 + i) * 3072 + h * 128 + 8 * dc) = o;
            } else { const int tk = task - 1024, d = tk >> 3, jc = tk & 7; float sc[8];
#pragma unroll
                for (int e = 0; e < 8; ++e) sc[e] = Rk[8 * jc + e] * __expf(Gl - Gs[8 * jc + e]);
                const v4u v = *(const LAS v4u*)(KT + d * 72 + 8 * jc); v4u o;
                o.x = pk2(bflo(v.x) * sc[0], bfhi(v.x) * sc[1]); o.y = pk2(bflo(v.y) * sc[2], bfhi(v.y) * sc[3]); o.z = pk2(bflo(v.z) * sc[4], bfhi(v.z) * sc[5]); o.w = pk2(bflo(v.w) * sc[6], bfhi(v.w) * sc[7]);
                *(v4u*)(qkv + (R0 + (d >> 1)) * 3072 + 2048 + h * 128 + (d & 1) * 64 + 8 * jc) = o; }
        }
    }
    __syncthreads();
    bf16* uT = (bf16*)(ws + WS_UT) + (size_t)unit * 8192;
    for (int job = wave; job < 64; job += 8) {
        f32x4 acc = {0.f, 0.f, 0.f, 0.f};
        if (job < 32) { const int it = job >> 3, et = job & 7; const LAS bf16* ap = T1 + (16 * it + c) * 72 + 8 * g; const LAS bf16* bp = VT + (16 * et + c) * 72 + 8 * g;
#pragma unroll
            for (int ks = 0; ks < 2; ++ks) acc = MFMA16(*(const LAS bf16x8*)(ap + 32 * ks), *(const LAS bf16x8*)(bp + 32 * ks), acc);
            v2u w; w.x = pk2(acc[0], acc[1]); w.y = pk2(acc[2], acc[3]); *(v2u*)(uT + (16 * et + c) * 64 + 16 * it + 4 * g) = w;
        } else { const int dt = (job - 32) >> 2, it = (job - 32) & 3; const LAS bf16* ap = KT + (16 * dt + c) * 72 + 8 * g; const LAS bf16* bp = T2 + (16 * it + c) * 72 + 8 * g;
#pragma unroll
            for (int ks = 0; ks < 2; ++ks) acc = MFMA16(*(const LAS bf16x8*)(ap + 32 * ks), *(const LAS bf16x8*)(bp + 32 * ks), acc);
            v2u w; w.x = pk2(acc[0], acc[1]); w.y = pk2(acc[2], acc[3]); *(v2u*)(qkv + (R0 + 16 * it + c) * 3072 + 1024 + h * 128 + 16 * dt + 4 * g) = w; }
    }
    __syncthreads();
}

constexpr int SC_W = 0, SC_Q = 17408, SC_K = 34816, SC_A = 53248, SC_U = 62464, SC_BUF = 64768;
struct ScanRegs { v4u w[2], q[2], k[2], a, u; };
DI void scan_load(const unsigned char* ws, ScanRegs& r, int b, int h, int es, int ck, int tid) {
    const size_t R0 = (size_t)b * SEQ + (size_t)ck * 64; const int unit = (b * GH + h) * NCH + ck;
    const bf16* qkv = (const bf16*)(ws + WS_QKV);
#pragma unroll
    for (int k = 0; k < 2; ++k) { const int idx = tid + 512 * k, row = idx >> 4, c16 = idx & 15; const bf16* p = qkv + (R0 + row) * 3072 + h * 128 + 8 * c16;
        r.q[k] = *(const v4u*)p; r.w[k] = *(const v4u*)(p + 1024); r.k[k] = *(const v4u*)(p + 2048); }
    r.a = *(const v4u*)((const bf16*)(ws + WS_AQK) + (size_t)unit * 4096 + (tid >> 3) * 64 + 8 * (tid & 7));
    if (tid < 128) r.u = *(const v4u*)((const bf16*)(ws + WS_UT) + (size_t)unit * 8192 + (16 * es + (tid >> 3)) * 64 + 8 * (tid & 7));
}
DI void scan_store(LAS unsigned char* buf, const ScanRegs& r, int tid) {
#pragma unroll
    for (int k = 0; k < 2; ++k) { const int idx = tid + 512 * k, row = idx >> 4, c16 = idx & 15;
        *(LAS v4u*)((LAS bf16*)(buf + SC_W) + row * 136 + 8 * c16) = r.w[k]; *(LAS v4u*)((LAS bf16*)(buf + SC_Q) + row * 136 + 8 * c16) = r.q[k];
        *(LAS v4u*)((LAS bf16*)(buf + SC_K) + (2 * row + (c16 >> 3)) * 72 + 8 * (c16 & 7)) = r.k[k]; }
    *(LAS v4u*)((LAS bf16*)(buf + SC_A) + (tid >> 3) * 72 + 8 * (tid & 7)) = r.a;
    if (tid < 128) *(LAS v4u*)((LAS bf16*)(buf + SC_U) + (tid >> 3) * 72 + 8 * (tid & 7)) = r.u;
}
DI void scan_chain(const Args& a, LAS unsigned char* lds, int chain, int tid, int wave, int lane) {
    unsigned char* ws = a.ws;
    const int es = chain & 7, h = (chain >> 3) & 7, b = chain >> 6, g = lane >> 4, c = lane & 15;
    const float* glast = (const float*)(ws + MS_GLAST) + (b * GH + h) * NCH;
    bf16* oT = (bf16*)(ws + WS_UT) + (size_t)((b * GH + h) * NCH) * 8192 + (16 * es + c) * 64 + 4 * g;
    ScanRegs R;
    scan_load(ws, R, b, h, es, 0, tid); scan_store(lds, R, tid);
    scan_load(ws, R, b, h, es, 1, tid);
    __syncthreads();
    f32x4 S[8]; bf16x8 Sb[4];
#pragma unroll
    for (int i = 0; i < 8; ++i) S[i] = (f32x4){0.f, 0.f, 0.f, 0.f};
#pragma unroll
    for (int i = 0; i < 4; ++i) Sb[i] = (bf16x8){0, 0, 0, 0, 0, 0, 0, 0};
    for (int ck = 0; ck < NCH; ++ck) {
        LAS unsigned char* cur = lds + (ck & 1) * SC_BUF;
        if (ck + 1 < NCH) scan_store(lds + ((ck + 1) & 1) * SC_BUF, R, tid);
        if (ck + 2 < NCH) scan_load(ws, R, b, h, es, ck + 2, tid);
        if (wave == 0) {
            const LAS bf16* Wl = (const LAS bf16*)(cur + SC_W); const LAS bf16* Ql = (const LAS bf16*)(cur + SC_Q); const LAS bf16* Kl = (const LAS bf16*)(cur + SC_K);
            const LAS bf16* Al = (const LAS bf16*)(cur + SC_A); const LAS bf16* Ul = (const LAS bf16*)(cur + SC_U);
            const float gl = glast[ck];
            f32x4 vn[4];
#pragma unroll
            for (int jt = 0; jt < 4; ++jt) { const v2u uu = *(const LAS v2u*)(Ul + c * 72 + 16 * jt + 4 * g); f32x4 acc = {bflo(uu.x), bfhi(uu.x), bflo(uu.y), bfhi(uu.y)};
#pragma unroll
                for (int s = 0; s < 4; ++s) { const LAS bf16* p = Wl + (16 * jt + c) * 136 + 32 * s + 4 * g; acc = MFMA16(mk8(*(const LAS v2u*)p, *(const LAS v2u*)(p + 16)), Sb[s], acc); }
                vn[jt] = acc; }
            bf16x8 vb[2]; vb[0] = pack_acc2(vn[0], vn[1]); vb[1] = pack_acc2(vn[2], vn[3]);
#pragma unroll
            for (int jt = 0; jt < 4; ++jt) { f32x4 acc = {0.f, 0.f, 0.f, 0.f};
#pragma unroll
                for (int s = 0; s < 4; ++s) { const LAS bf16* p = Ql + (16 * jt + c) * 136 + 32 * s + 4 * g; acc = MFMA16(mk8(*(const LAS v2u*)p, *(const LAS v2u*)(p + 16)), Sb[s], acc); }
#pragma unroll
                for (int s = 0; s < 2; ++s) { const LAS bf16* p = Al + (16 * jt + c) * 72 + 32 * s + 4 * g; acc = MFMA16(mk8(*(const LAS v2u*)p, *(const LAS v2u*)(p + 16)), vb[s], acc); }
                v2u w; w.x = pk2(acc[0], acc[1]); w.y = pk2(acc[2], acc[3]); *(v2u*)(oT + (size_t)ck * 8192 + 16 * jt) = w; }
#pragma unroll
            for (int dt = 0; dt < 8; ++dt) { f32x4 acc = S[dt] * gl;
#pragma unroll
                for (int s = 0; s < 2; ++s) { const LAS bf16* p = Kl + (16 * dt + c) * 72 + 32 * s + 4 * g; acc = MFMA16(mk8(*(const LAS v2u*)p, *(const LAS v2u*)(p + 16)), vb[s], acc); }
                S[dt] = acc; }
#pragma unroll
            for (int s = 0; s < 4; ++s) Sb[s] = pack_acc2(S[2 * s], S[2 * s + 1]);
        }
        __syncthreads();
    }
}

DI void onorm_unit(const Args& a, LAS float* red  , int unit, int it, int wave, int lane) {
    unsigned char* ws = a.ws;
    const int ck = unit & 255, h = (unit >> 8) & 7, b = unit >> 11; const size_t row = (size_t)b * SEQ + (size_t)ck * 64 + lane;
    const bf16* oT = (const bf16*)(ws + WS_UT) + (size_t)unit * 8192 + (16 * wave) * 64 + lane;
    float v[16]; float ss = 0.f;
#pragma unroll
    for (int k = 0; k < 16; ++k) { v[k] = bf2f(oT[k * 64]); ss += v[k] * v[k]; }
    LAS float* rb = red + (it & 1) * 512; rb[wave * 64 + lane] = ss;
    const bf16* gp = (const bf16*)(ws + WS_GATE) + row * D + h * 128 + 16 * wave; const v4u g0 = *(const v4u*)gp, g1 = *(const v4u*)(gp + 8);
    __syncthreads();
    float tot = 0.f;
#pragma unroll
    for (int w = 0; w < 8; ++w) tot += rb[w * 64 + lane];
    const float rs = __builtin_amdgcn_rsqf(tot * (1.0f / 128.0f) + EPS);
    const unsigned gw[8] = {g0.x, g0.y, g0.z, g0.w, g1.x, g1.y, g1.z, g1.w}; unsigned o[8];
    const float* on = a.in[I_ONORM] + 16 * wave;
#pragma unroll
    for (int k = 0; k < 8; ++k) { const float ga = bflo(gw[k]), gb = bfhi(gw[k]); o[k] = pk2(v[2 * k] * rs * on[2 * k] * silu_f(ga), v[2 * k + 1] * rs * on[2 * k + 1] * silu_f(gb)); }
    bf16* op = (bf16*)(ws + WS_ON) + row * D + h * 128 + 16 * wave;
    v4u w0, w1; w0.x = o[0]; w0.y = o[1]; w0.z = o[2]; w0.w = o[3]; w1.x = o[4]; w1.y = o[5]; w1.z = o[6]; w1.w = o[7]; *(v4u*)op = w0; *(v4u*)(op + 8) = w1;
}

DI void route_unit(const Args& a, LAS int* esel, int unit, int wave, int lane) {
    unsigned char* ws = a.ws;
    const float* rt = (const float*)(ws + MS_ROUT);
    f32x4 rr[4][4][2];
#pragma unroll
    for (int j = 0; j < 4; ++j)
#pragma unroll
        for (int i = 0; i < 4; ++i) { const f32x4* p = (const f32x4*)(rt + (size_t)(4 * (64 * j + lane) + i) * 8); rr[j][i][0] = p[0]; rr[j][i][1] = p[1]; }
    for (int tl = 16 * wave; tl < 16 * wave + 16; ++tl) {
        const int tok = unit * 128 + tl;
        const f32x4* xr = (const f32x4*)(a.out + (size_t)tok * D) + lane;
        float acc[8] = {0.f, 0.f, 0.f, 0.f, 0.f, 0.f, 0.f, 0.f};
#pragma unroll
        for (int j = 0; j < 4; ++j) { const f32x4 x = xr[64 * j];
#pragma unroll
            for (int i = 0; i < 4; ++i)
#pragma unroll
                for (int e = 0; e < 8; ++e) acc[e] += x[i] * rr[j][i][e >> 2][e & 3]; }
#pragma unroll
        for (int e = 0; e < 8; ++e) acc[e] = wave_sum(acc[e]);
        const float rs = pg8::rstd16((const float*)(ws + WS_STB), tok);
        int e1 = 0; float l1 = acc[0];
#pragma unroll
        for (int e = 1; e < 8; ++e) if (acc[e] > l1) { l1 = acc[e]; e1 = e; }
        int e2 = -1; float l2 = -3.0e38f;
#pragma unroll
        for (int e = 0; e < 8; ++e) if (e != e1 && acc[e] > l2) { l2 = acc[e]; e2 = e; }
        const float w1 = __builtin_amdgcn_rcpf(1.0f + __expf((l2 - l1) * rs));
        if (lane == 0) { ((int*)(ws + MS_TOKE))[tok] = e1 | (e2 << 8); ((float*)(ws + MS_TOKW))[2 * tok] = w1; ((float*)(ws + MS_TOKW))[2 * tok + 1] = 1.0f - w1; esel[2 * tl] = e1; esel[2 * tl + 1] = e2; }
    }
    __syncthreads();
    { int base = 0;
      for (int i = 0; i < 4; ++i) { const bool m = esel[64 * i + lane] == wave; const unsigned long long mask = __ballot(m);
          if (m) ((int*)(ws + MS_RANK))[unit * 256 + 64 * i + lane] = base + __popcll(mask & ((1ull << lane) - 1ull)); base += __popcll(mask); }
      if (lane == 0) ((int*)(ws + MS_CNT))[unit * 8 + wave] = base; }
    __syncthreads();
}

DI void gather_unit(const Args& a, LAS int* sm  , int unit, int tid, int wave, int lane) {
    unsigned char* ws = a.ws;
    const int* cnt = (const int*)(ws + MS_CNT);
    if (tid < 8) { int tot = 0, off = 0; for (int u = 0; u < 256; ++u) { const int v = cnt[u * 8 + tid]; tot += v; if (u < unit) off += v; } sm[tid] = tot; sm[8 + tid] = off; }
    __syncthreads();
    if (tid == 0) { int s = 0; for (int e = 0; e < 8; ++e) { sm[16 + e] = s; s += ((sm[e] + 255) >> 8) << 8; } sm[24] = s;
        if (unit == 0) { int* te = (int*)(ws + MS_TILEE); for (int e = 0; e < 8; ++e) for (int t = sm[16 + e] >> 8; t < (sm[16 + e + 1] >> 8); ++t) te[t] = e; te[MAXTILES] = s >> 8; } }
    __syncthreads();
    const bf16* hb3 = (const bf16*)(ws + WS_HB3); bf16* xg = (bf16*)(ws + WS_XG); float* rg = (float*)(ws + MS_RG);
    for (int s = 32 * wave; s < 32 * wave + 32; ++s) {
        const int tok = unit * 128 + (s >> 1), k = s & 1; const int e = (((const int*)(ws + MS_TOKE))[tok] >> (8 * k)) & 0xff;
        const int dest = sm[16 + e] + sm[8 + e] + ((const int*)(ws + MS_RANK))[unit * 256 + s];
        if (lane == 0) { ((int*)(ws + MS_DEST))[2 * tok + k] = dest; rg[dest] = pg8::rstd16((const float*)(ws + WS_STB), tok); }
        const v4u* src = (const v4u*)(hb3 + (size_t)tok * D) + lane; v4u* dst = (v4u*)(xg + (size_t)dest * D) + lane;
        dst[0] = src[0]; dst[64] = src[64];
    }
    if (unit < 8) {
        const int e = unit, r0 = sm[16 + e] + sm[e], r1 = sm[16 + e + 1]; const v4u z = {0u, 0u, 0u, 0u};
        for (int r = r0 + wave; r < r1; r += 8) { v4u* dst = (v4u*)(xg + (size_t)r * D) + lane; dst[0] = z; dst[64] = z; if (lane == 0) rg[r] = 0.f; }
    }
    __syncthreads();
}

DI void combine_row(const Args& a, int tok, int lane) {
    unsigned char* ws = a.ws;
    const int d1 = ((const int*)(ws + MS_DEST))[2 * tok], d2 = ((const int*)(ws + MS_DEST))[2 * tok + 1];
    const float w1 = ((const float*)(ws + MS_TOKW))[2 * tok], w2 = ((const float*)(ws + MS_TOKW))[2 * tok + 1];
    const bf16* y = (const bf16*)(ws + WS_XG);
    f32x4* o = (f32x4*)(a.out + (size_t)tok * D) + 4 * lane;
    const v4u* y1 = (const v4u*)(y + (size_t)d1 * D) + 2 * lane; const v4u* y2 = (const v4u*)(y + (size_t)d2 * D) + 2 * lane;
#pragma unroll
    for (int q = 0; q < 2; ++q) { const v4u p1 = y1[q], p2 = y2[q]; const unsigned a1[4] = {p1.x, p1.y, p1.z, p1.w}, a2[4] = {p2.x, p2.y, p2.z, p2.w};
#pragma unroll
        for (int e = 0; e < 2; ++e) { f32x4 v = o[2 * q + e];
            v[0] += w1 * bflo(a1[2 * e]) + w2 * bflo(a2[2 * e]); v[1] += w1 * bfhi(a1[2 * e]) + w2 * bfhi(a2[2 * e]);
            v[2] += w1 * bflo(a1[2 * e + 1]) + w2 * bflo(a2[2 * e + 1]); v[3] += w1 * bfhi(a1[2 * e + 1]) + w2 * bfhi(a2[2 * e + 1]); o[2 * q + e] = v; } }
}
constexpr int NPHASE = 23;
#ifndef MK_SUB
#define MK_SUB 3
#endif
#ifndef MK_ONE_LAUNCH
#define MK_ONE_LAUNCH 0
#endif
template <int P> DI void moe_pass(const Args& args, LAS unsigned char* lds, int G, int which  ) {
    unsigned char* ws = args.ws;
    const int* te = (const int*)(ws + MS_TILEE); const int ntiles = te[MAXTILES];
    const int lo = PASS_TILES * P, hi = (P == 3) ? ntiles : (ntiles < PASS_TILES * (P + 1) ? ntiles : PASS_TILES * (P + 1));
    if (lo >= hi) return;
    if (which == 0) {
        pg8::Gemm g{(const bf16*)(ws + WS_XG), (const bf16*)(ws + WS_WMGU), MAXTILES * 256, 2 * FFE, D};
        pg8::MoeOrder S{lo, hi, 2 * FFE / 256, G, (int)blockIdx.x, te};
        pg8::EpiSwiGLU<true> E{(bf16*)(ws + WS_ACT), FFE, (const float*)(ws + MS_RG), 2 * FFE / 256, lo};
        pg8::gemm_phase<pg8::EpiSwiGLU<true>, pg8::MoeOrder, true, true>(lds, g, S, E);
    } else {
        pg8::Gemm g{(const bf16*)(ws + WS_ACT) - (size_t)lo * 256 * FFE, (const bf16*)(ws + WS_WMD), MAXTILES * 256, D, FFE};
        pg8::MoeOrder S{lo, hi, D / 256, G, (int)blockIdx.x, te};
        pg8::EpiPlain E{(bf16*)(ws + WS_XG)};
        pg8::gemm_phase<pg8::EpiPlain, pg8::MoeOrder, true, true>(lds, g, S, E);
    }
}

__global__ void __launch_bounds__(NTHREADS, 2) fwd(Args args) {
    extern __shared__ __attribute__((aligned(16))) unsigned char lds_raw[];
    LAS unsigned char* lds = (LAS unsigned char*)lds_raw;
    volatile LAS unsigned* MISC = (volatile LAS unsigned*)(lds + MISC_OFF);
    const int tid = threadIdx.x, lane = tid & 63, wave = __builtin_amdgcn_readfirstlane(tid >> 6);
    const int G = gridDim.x, bx = blockIdx.x;
    const int vcu = (G % 8 == 0) ? (bx % 8) * (G / 8) + bx / 8 : bx;
    const int gw = vcu * NWAVES + wave, NGW = G * NWAVES;
    unsigned char* ws = args.ws;
    gu32* ctl = (gu32*)(ws + WS_CTL);
    for (int u = tid; u < (LDS_BYTES - LDSCTL_OFF) / 4; u += NTHREADS) ((LAS unsigned*)(lds + LDSCTL_OFF))[u] = 0u;
    __syncthreads();
    const int lo = args.ph_lo, hi = args.ph_hi;
    XcdBarrier bar; bar.bar = (unsigned*)(ctl + CW_BAR); bar.x = 0; bar.st = nullptr;
    if (hi - lo > 1) bar = xcd_barrier_post((unsigned*)(ctl + CW_BAR), MISC + 8);
#ifndef MK_PHMASK
#define MK_PHMASK 0x7fffffu
#endif
#define IN(k) ((((MK_PHMASK) >> (k)) & 1u) && lo <= (k) && (k) < hi)
#define SEAM(k) do { if (IN(k) && IN((k) + 1)) xcd_barrier(bar); } while (0)

    if (IN(0)) { phase_prologue(args, lds, gw, NGW, wave, lane); __syncthreads(); } SEAM(0);

    if (IN(1)) {
        pg8::Gemm g{(const bf16*)(ws + WS_HB), (const bf16*)(ws + W0_IN), T, E_IN, D}; pg8::StaticOrder S; S.init(T, E_IN, G, bx);
        pg8::EpiProj<0> E{(bf16*)(ws + WS_PROJ0), E_IN, (const float*)(ws + WS_STA), nullptr, nullptr};
        pg8::gemm_phase<pg8::EpiProj<0>, pg8::StaticOrder, true, true>(lds, g, S, E);
    } SEAM(1);

    if (IN(2)) {
        if (MK_SUB & 1) { LruFrags LF; lru_frags(args, lds, LF, wave, lane); __syncthreads(); for (int u = vcu; u < NB * 128; u += G) lru_unit(args, lds, LF, u, wave, lane); }
        __syncthreads();
        if (MK_SUB & 2) for (int u = vcu; u < NB * 128 * 2; u += G) attn_unit(args, lds, u, tid, wave, lane);
    } SEAM(2);

    if (IN(3)) { for (int u = vcu; u < NB * 128; u += G) lrufix_unit(args, u, tid); } SEAM(3);

    if (IN(4)) {
        pg8::Gemm g{(const bf16*)(ws + WS_YMIX), (const bf16*)(ws + W0_OUT), T, D, D}; pg8::StaticOrder S; S.init(T, D, G, bx);
        pg8::EpiResid E{args.in[I_X], args.out, (bf16*)(ws + WS_HB), (float*)(ws + WS_STB)};
        pg8::gemm_phase<pg8::EpiResid, pg8::StaticOrder, true, true>(lds, g, S, E);
    } SEAM(4);

    if (IN(5)) {
        pg8::Gemm g{(const bf16*)(ws + WS_HB), (const bf16*)(ws + W0_GU), T, 2 * FF0, D}; pg8::StaticOrder S; S.init(T, 2 * FF0, G, bx);
        pg8::EpiSwiGLU<false> E{(bf16*)(ws + WS_ACT0), FF0, (const float*)(ws + WS_STB), 0, 0};
        pg8::gemm_phase<pg8::EpiSwiGLU<false>, pg8::StaticOrder, true, true>(lds, g, S, E);
    } SEAM(5);

    if (IN(6)) {
        pg8::Gemm g{(const bf16*)(ws + WS_ACT0), (const bf16*)(ws + W0_DN), T, D, FF0}; pg8::StaticOrder S; S.init(T, D, G, bx);
        pg8::EpiResid E{args.out, args.out, (bf16*)(ws + WS_HB), (float*)(ws + WS_STA)};
        pg8::gemm_phase<pg8::EpiResid, pg8::StaticOrder, true, true>(lds, g, S, E);
    } SEAM(6);

    if (IN(7)) {
        pg8::Gemm g{(const bf16*)(ws + WS_HB), (const bf16*)(ws + W1_IN), T, 4096, D}; pg8::StaticOrder S; S.init(T, 4096, G, bx);
        pg8::EpiProj<1> E{(bf16*)(ws + WS_QKV), 3072, (const float*)(ws + WS_STA), (bf16*)(ws + WS_GATE), (bf16*)(ws + WS_HALO)};
        pg8::gemm_phase<pg8::EpiProj<1>, pg8::StaticOrder, true, true>(lds, g, S, E);
        for (int t = gw; t < T / 16; t += NGW) skinny_tile(args, t, lane);
    } SEAM(7);

    if (IN(8)) { for (int u = vcu; u < NUNIT; u += G) prep_unit(args, lds, u, tid, wave, lane); } SEAM(8);

    if (IN(9)) {
        const int li = vcu & 31, xq = vcu >> 5;
        if (G == 256 && li < 16) scan_chain(args, lds, (2 * xq + (li >> 3)) * 8 + (li & 7), tid, wave, lane);
        else if (G == 256) { const int wk = (xq * 16 + (li - 16)) * NWAVES + wave; LAS float* scr = (LAS float*)(lds + wave * 16384);
            for (int it = wk; it < MOE_D_ITEMS; it += 128 * NWAVES) cvt_moe_down(args, it, scr, lane); }
        else { for (int ch = vcu; ch < 128; ch += G) scan_chain(args, lds, ch, tid, wave, lane);
            LAS float* scr = (LAS float*)(lds + wave * 16384); for (int it = gw; it < MOE_D_ITEMS; it += NGW) cvt_moe_down(args, it, scr, lane); }
    } SEAM(9);

    if (IN(10)) {
        LAS float* red = (LAS float*)lds; int it = 0;
        for (int u = vcu; u < NUNIT; u += G, ++it) onorm_unit(args, red, u, it, wave, lane);
        __syncthreads();
        LAS float* scr = (LAS float*)(lds + wave * 16384);
        for (int i = gw; i < MOE_GU_ITEMS; i += NGW) cvt_moe_gu(args, i, scr, lane);
        __syncthreads();
    } SEAM(10);

    if (IN(11)) {
        pg8::Gemm g{(const bf16*)(ws + WS_ON), (const bf16*)(ws + W1_OUT), T, D, D}; pg8::StaticOrder S; S.init(T, D, G, bx);
        pg8::EpiResid E{args.out, args.out, (bf16*)(ws + WS_HB3), (float*)(ws + WS_STB)};
        pg8::gemm_phase<pg8::EpiResid, pg8::StaticOrder, true, true>(lds, g, S, E);
    } SEAM(11);

    if (IN(12)) { for (int u = vcu; u < 256; u += G) route_unit(args, (LAS int*)lds, u, wave, lane); } SEAM(12);
    if (IN(13)) { for (int u = vcu; u < 256; u += G) gather_unit(args, (LAS int*)lds, u, tid, wave, lane); } SEAM(13);

    if (IN(14)) moe_pass<0>(args, lds, G, 0); SEAM(14);
    if (IN(15)) moe_pass<0>(args, lds, G, 1); SEAM(15);
    if (IN(16)) moe_pass<1>(args, lds, G, 0); SEAM(16);
    if (IN(17)) moe_pass<1>(args, lds, G, 1); SEAM(17);
    if (IN(18)) moe_pass<2>(args, lds, G, 0); SEAM(18);
    if (IN(19)) moe_pass<2>(args, lds, G, 1); SEAM(19);
    if (IN(20)) moe_pass<3>(args, lds, G, 0); SEAM(20);
    if (IN(21)) moe_pass<3>(args, lds, G, 1); SEAM(21);

    if (IN(22)) { for (int t = gw; t < T; t += NGW) combine_row(args, t, lane); }
#undef IN
#undef SEAM
}

extern "C" void kernel_launch(void* const* d_in, const int* in_sizes, int n_in, void* d_out, int out_size, void* d_ws, size_t ws_size, hipStream_t stream) {
    static int grid = 0;
    if (grid == 0) {
        if (n_in != 28 || out_size != T * D || ws_size < WS_END) { fprintf(stderr, "kernel_launch: unexpected problem (n_in %d, out %d, ws %zu)\n", n_in, out_size, ws_size); grid = -1; return; }
        int dev = 0, cus = 0, per_cu = 0;
        if (hipGetDevice(&dev) != hipSuccess || hipDeviceGetAttribute(&cus, hipDeviceAttributeMultiprocessorCount, dev) != hipSuccess) { grid = -1; return; }
        if (hipFuncSetAttribute((const void*)fwd, hipFuncAttributeMaxDynamicSharedMemorySize, LDS_BYTES) != hipSuccess) { fprintf(stderr, "kernel_launch: hipFuncSetAttribute failed\n"); grid = -1; return; }
        if (hipOccupancyMaxActiveBlocksPerMultiprocessor(&per_cu, (const void*)fwd, NTHREADS, LDS_BYTES) != hipSuccess || per_cu < 1) fprintf(stderr, "kernel_launch: occupancy query says %d\n", per_cu);
        (void)hipGetLastError();
        grid = cus;
    }
    if (grid < 0) return;
    if (hipMemsetAsync((char*)d_ws + WS_CTL, 0, CTL_ZERO_BYTES, stream) != hipSuccess) return;
    Args a{};
    for (int i = 0; i < 28; ++i) a.in[i] = (const float*)d_in[i];
    a.out = (float*)d_out; a.ws = (unsigned char*)d_ws;
#if MK_ONE_LAUNCH
    a.ph_lo = 0; a.ph_hi = NPHASE;
    hipLaunchKernelGGL(fwd, dim3(grid), dim3(NTHREADS), LDS_BYTES, stream, a);
#else
    for (int p = 0; p < NPHASE; ++p) { a.ph_lo = p; a.ph_hi = p + 1; hipLaunchKernelGGL(fwd, dim3(grid), dim3(NTHREADS), LDS_BYTES, stream, a); }
#endif
}
```

```cpp
#include <hip/hip_runtime.h>
#include <cstdio>
#include <cstdint>
#include <cmath>
namespace pg8 {
#define PG8_LAS __attribute__((address_space(3)))
typedef unsigned short bf16_t;
typedef short bf16x8 __attribute__((ext_vector_type(8)));
typedef float f32x4 __attribute__((ext_vector_type(4)));
typedef unsigned u32x4 __attribute__((ext_vector_type(4)));
constexpr int BM = 256, BK = 64, HALF = 128, HTB = HALF * BK * 2  , STAGE_BYTES = 8 * HTB, NXCD = 8, WGM = 8;

__host__ __device__ __forceinline__ int lds_byte(int r, int c) { const int st = (r >> 4) * 2 + (c >> 5), rr = r & 15, cc = c & 31, ob = rr * 64 + cc * 2; return st * 1024 + (ob ^ (((ob >> 9) & 1) << 5)); }
__host__ __device__ __forceinline__ void stage_rc(int b, int& R, int& C) { const int st = b / 1024, sb = b % 1024, swz = sb ^ (((sb >> 9) & 1) << 5); R = (st >> 1) * 16 + swz / 64; C = (st & 1) * 32 + (swz % 64) / 2; }
__host__ __device__ __forceinline__ int perm32(int rho) { const int n = rho >> 4, i = rho & 15; return 8 * (i >> 2) + 4 * n + (i & 3); }

struct Unit { int pm, pn; };
struct Gemm { const bf16_t* A; const bf16_t* Bt; int M, N, K; };

struct StaticOrder {
    int nM, nN, nwg, G, c;
    __host__ __device__ void init(int M, int N, int G_, int c_) { nM = M / BM; nN = N / BM; nwg = nM * nN; G = G_; c = c_; }
    __host__ __device__ bool next(int i, Unit& u) const {
        const long L = (long)i * G + c; if (L >= nwg) return false;
        int wgid = (int)L; { const int q = nwg / NXCD, r = nwg % NXCD, xcd = wgid % NXCD, off = wgid / NXCD; wgid = (xcd < r ? xcd * (q + 1) : r * (q + 1) + (xcd - r) * q) + off; }
        const int nig = WGM * nN, gid = wgid / nig, fm = gid * WGM, gsz = (nM - fm) < WGM ? (nM - fm) : WGM;
        u.pm = fm + ((wgid % nig) % gsz); u.pn = (wgid % nig) / gsz; return true;
    }
    __device__ __forceinline__ void a_ready(const Unit&) const {}
    __device__ __forceinline__ void done(const Unit&) const {}
};

__device__ __forceinline__ unsigned cvt_pk_bf16(float lo, float hi) { unsigned r; asm volatile("v_cvt_pk_bf16_f32 %0, %1, %2" : "=v"(r) : "v"(lo), "v"(hi)); return r; }
typedef float f32x2 __attribute__((ext_vector_type(2)));
__device__ __forceinline__ float rstd16(const float* st, int row) {
    const f32x4* p = (const f32x4*)(st + (size_t)row * 16); const f32x4 a = p[0], b = p[1], c = p[2], d = p[3];
    const float s = ((a[0] + a[1]) + (a[2] + a[3])) + ((b[0] + b[1]) + (b[2] + b[3])) + ((c[0] + c[1]) + (c[2] + c[3])) + ((d[0] + d[1]) + (d[2] + d[3]));
    return __builtin_amdgcn_rsqf(s * (1.0f / 1024.0f) + 1e-6f);
}
__device__ __forceinline__ u32x4 pack8(const f32x4 v0, const f32x4 v1) { u32x4 w; w.x = cvt_pk_bf16(v0[0], v0[1]); w.y = cvt_pk_bf16(v0[2], v0[3]); w.z = cvt_pk_bf16(v1[0], v1[1]); w.w = cvt_pk_bf16(v1[2], v1[3]); return w; }
__device__ __forceinline__ float silu_f(float x) { return x * __builtin_amdgcn_rcpf(1.0f + __expf(-x)); }

template <int MODE> struct EpiProj {
    static constexpr bool PERM = true, AFTER_DRAIN = false;
    bf16_t* O; int ldo; const float* stats; bf16_t* gate; bf16_t* halo;
    __device__ __forceinline__ void operator()(const f32x4 (&acc)[2][2][4][2], const Unit& u, int wr, int wc, int fr, int fq) const {
        const int row0 = u.pm * BM + wr * 64 + fr, col0 = u.pn * BM + wc * 32 + 8 * fq;
#pragma unroll
        for (int ai = 0; ai < 2; ++ai)
#pragma unroll
            for (int m = 0; m < 4; ++m) { const int row = row0 + ai * HALF + m * 16; const float rs = rstd16(stats, row);
#pragma unroll
                for (int bj = 0; bj < 2; ++bj) { const int col = col0 + bj * HALF; const u32x4 w = pack8(acc[ai][bj][m][0] * rs, acc[ai][bj][m][1] * rs);
                    if (MODE == 0) { *(u32x4*)(O + (size_t)row * ldo + col) = w; }
                    else { if (col < 3072) { *(u32x4*)(O + (size_t)row * 3072 + col) = w; const int t = row & 63; if (t >= 61) *(u32x4*)(halo + ((size_t)(row >> 6) * 3 + (t - 61)) * 3072 + col) = w; }
                           else *(u32x4*)(gate + (size_t)row * 1024 + (col - 3072)) = w; } } }
    }
};
struct EpiResid {
    static constexpr bool PERM = true, AFTER_DRAIN = false;
    const float* resid; float* out; bf16_t* hb; float* stats;
    __device__ __forceinline__ void operator()(const f32x4 (&acc)[2][2][4][2], const Unit& u, int wr, int wc, int fr, int fq) const {
        const int row0 = u.pm * BM + wr * 64 + fr, col0 = u.pn * BM + wc * 32 + 8 * fq;
#pragma unroll
        for (int ai = 0; ai < 2; ++ai)
#pragma unroll
            for (int m = 0; m < 4; ++m) { const int row = row0 + ai * HALF + m * 16; float ss = 0.f;
#pragma unroll
                for (int bj = 0; bj < 2; ++bj) { const size_t off = (size_t)row * 1024 + col0 + bj * HALF;
                    const f32x4 r0 = *(const f32x4*)(resid + off), r1 = *(const f32x4*)(resid + off + 4);
                    const f32x4 v0 = acc[ai][bj][m][0] + r0, v1 = acc[ai][bj][m][1] + r1;
                    *(f32x4*)(out + off) = v0; *(f32x4*)(out + off + 4) = v1; *(u32x4*)(hb + off) = pack8(v0, v1);
                    ss += ((v0[0] * v0[0] + v0[1] * v0[1]) + (v0[2] * v0[2] + v0[3] * v0[3])) + ((v1[0] * v1[0] + v1[1] * v1[1]) + (v1[2] * v1[2] + v1[3] * v1[3])); }
                ss += __shfl_xor(ss, 16); ss += __shfl_xor(ss, 32);
                if (fq == 0) stats[(size_t)row * 16 + (u.pn & 3) * 4 + wc] = ss; }
    }
};
template <bool MOE> struct EpiSwiGLU {
    static constexpr bool PERM = true, AFTER_DRAIN = false;
    bf16_t* O; int ldo; const float* stats; int ntn, pm_lo;
    __device__ __forceinline__ void operator()(const f32x4 (&acc)[2][2][4][2], const Unit& u, int wr, int wc, int fr, int fq) const {
        const int pnl = MOE ? (u.pn % ntn) : u.pn;
        const int row0 = u.pm * BM + wr * 64 + fr, col = pnl * HALF + wc * 32 + 8 * fq;
#pragma unroll
        for (int ai = 0; ai < 2; ++ai)
#pragma unroll
            for (int m = 0; m < 4; ++m) { const int row = row0 + ai * HALF + m * 16; const float rs = MOE ? stats[row] : rstd16(stats, row);
                const f32x4 g0 = acc[ai][0][m][0] * rs, g1 = acc[ai][0][m][1] * rs, u0 = acc[ai][1][m][0] * rs, u1 = acc[ai][1][m][1] * rs; f32x4 a0, a1;
#pragma unroll
                for (int i = 0; i < 4; ++i) { a0[i] = silu_f(g0[i]) * u0[i]; a1[i] = silu_f(g1[i]) * u1[i]; }
                *(u32x4*)(O + (size_t)(row - pm_lo * BM) * ldo + col) = pack8(a0, a1); }
    }
};
struct EpiPlain {
    static constexpr bool PERM = true, AFTER_DRAIN = false;
    bf16_t* O;
    __device__ __forceinline__ void operator()(const f32x4 (&acc)[2][2][4][2], const Unit& u, int wr, int wc, int fr, int fq) const {
        const int row0 = u.pm * BM + wr * 64 + fr, col0 = (u.pn & 3) * BM + wc * 32 + 8 * fq;
#pragma unroll
        for (int ai = 0; ai < 2; ++ai)
#pragma unroll
            for (int m = 0; m < 4; ++m) { const int row = row0 + ai * HALF + m * 16;
#pragma unroll
                for (int bj = 0; bj < 2; ++bj) *(u32x4*)(O + (size_t)row * 1024 + col0 + bj * HALF) = pack8(acc[ai][bj][m][0], acc[ai][bj][m][1]); }
    }
};
struct MoeOrder {
    int lo, hi, NT, G, c; const int* tile_e;
    __device__ __forceinline__ bool next(int i, Unit& u) const {
        const long L = (long)i * G + c; const int nt = hi - lo; if (L >= (long)nt * NT) return false;
        const int grp = (int)(L / (8 * NT)), fm = grp * 8, gsz = (nt - fm) < 8 ? (nt - fm) : 8, w = (int)(L - (long)grp * 8 * NT), rt = lo + fm + (w % gsz);
        u.pm = rt; u.pn = tile_e[rt] * NT + (w / gsz); return true;
    }
    __device__ __forceinline__ void a_ready(const Unit&) const {}
    __device__ __forceinline__ void done(const Unit&) const {}
};
template <class Epi, class Sched, bool ALIGN_EPI = false, bool SP2 = false>
__device__ __forceinline__ void gemm_phase(PG8_LAS unsigned char* lds, const Gemm g, const Sched& S, const Epi& E) {
    const int tid = threadIdx.x, wid = __builtin_amdgcn_readfirstlane(tid >> 6), lane = tid & 63, wr = wid >> 2, wc = wid & 3, fr = lane & 15, fq = lane >> 4;
    const int K = g.K, nt = K / BK;
    unsigned voffA[2], voffB[2];
#pragma unroll
    for (int i = 0; i < 2; ++i) { int R, C; stage_rc(tid * 16 + i * 8192, R, C); const int Rb = Epi::PERM ? ((R & ~31) + perm32(R & 31)) : R;
        voffA[i] = (unsigned)(R * K + C) * 2u; voffB[i] = (unsigned)(Rb * K + C) * 2u; }
    const size_t kstep = (size_t)(BK * 2);
    const size_t hstep = (size_t)HALF * K * 2;
    const size_t tstep = 2 * hstep;
    const unsigned ldsw = (unsigned)wid * 1024u;
    const int aoff = lds_byte(wr * 64 + fr, fq * 8), boff = lds_byte(wc * 32 + fr, fq * 8);
#define PG8_SA(b, h) (((b) * 2 + (h)) * HTB)
#define PG8_SB(b, h) ((4 + (b) * 2 + (h)) * HTB)
#define PG8_STAGE(bufoff, gbase, voff) do { _Pragma("unroll") for (int _i = 0; _i < 2; ++_i) \
        __builtin_amdgcn_global_load_lds((const unsigned*)((const char*)(gbase) + (voff)[_i]), (PG8_LAS unsigned*)(lds + (bufoff) + ldsw + _i * 8192), 16, 0, 0); } while (0)
#define PG8_LDA(dst, b, h) do { _Pragma("unroll") for (int m = 0; m < 4; ++m) _Pragma("unroll") for (int k = 0; k < 2; ++k) dst[m][k] = *(const PG8_LAS bf16x8*)(lds + PG8_SA(b, h) + aoff + m * 2048 + k * 1024); } while (0)
#define PG8_LDB(dst, b, h) do { _Pragma("unroll") for (int n = 0; n < 2; ++n) _Pragma("unroll") for (int k = 0; k < 2; ++k) dst[n][k] = *(const PG8_LAS bf16x8*)(lds + PG8_SB(b, h) + boff + n * 2048 + k * 1024); } while (0)
#define PG8_MMA(ai, bj, At, Bt) do { __builtin_amdgcn_s_setprio(1); _Pragma("unroll") for (int m = 0; m < 4; ++m) _Pragma("unroll") for (int n = 0; n < 2; ++n) _Pragma("unroll") for (int k = 0; k < 2; ++k) \
        acc[ai][bj][m][n] = __builtin_amdgcn_mfma_f32_16x16x32_bf16(Bt[n][k], At[m][k], acc[ai][bj][m][n], 0, 0, 0); __builtin_amdgcn_s_setprio(0); } while (0)
#define PG8_WAIT_V(n) asm volatile("s_waitcnt vmcnt(" #n ")" ::: "memory")
#define PG8_WAIT_L(n) asm volatile("s_waitcnt lgkmcnt(" #n ")" ::: "memory")
#define PG8_BAR __builtin_amdgcn_s_barrier()
#define PG8_SCHED __builtin_amdgcn_sched_barrier(0)
    Unit cur, nxt; int ui = 0;
    if (!S.next(0, cur)) return;
    f32x4 acc[2][2][4][2];
#pragma unroll
    for (int a = 0; a < 2; ++a)
#pragma unroll
        for (int b = 0; b < 2; ++b)
#pragma unroll
            for (int m = 0; m < 4; ++m)
#pragma unroll
                for (int n = 0; n < 2; ++n) acc[a][b][m][n] = (f32x4){0.f, 0.f, 0.f, 0.f};
    bf16x8 At[4][2], B0[2][2], B1[2][2];
    const char* cA = (const char*)g.A + (size_t)cur.pm * tstep; const char* cB = (const char*)g.Bt + (size_t)cur.pn * tstep;
    S.a_ready(cur);
    if constexpr (SP2) {
        PG8_STAGE(PG8_SB(0, 0), cB, voffB); PG8_STAGE(PG8_SB(0, 1), cB + hstep, voffB); PG8_STAGE(PG8_SA(0, 0), cA, voffA); PG8_STAGE(PG8_SA(0, 1), cA + hstep, voffA);
        if (wr == 1) PG8_BAR;
        PG8_WAIT_V(2); PG8_BAR;
        PG8_STAGE(PG8_SB(1, 0), cB + kstep, voffB); PG8_STAGE(PG8_SA(1, 0), cA + kstep, voffA); PG8_STAGE(PG8_SB(1, 1), cB + hstep + kstep, voffB);
        PG8_WAIT_V(6); PG8_BAR;
    } else {
        PG8_STAGE(PG8_SB(0, 0), cB, voffB); PG8_STAGE(PG8_SA(0, 0), cA, voffA); PG8_STAGE(PG8_SB(0, 1), cB + hstep, voffB); PG8_STAGE(PG8_SA(0, 1), cA + hstep, voffA);
        if (wr == 1) PG8_BAR;
        PG8_WAIT_V(4); PG8_BAR;
        PG8_STAGE(PG8_SB(1, 0), cB + kstep, voffB); PG8_STAGE(PG8_SA(1, 0), cA + kstep, voffA); PG8_STAGE(PG8_SB(1, 1), cB + hstep + kstep, voffB);
        PG8_WAIT_V(6); PG8_BAR;
    }
    for (;;) {
        const bool has_next = S.next(ui + 1, nxt);
        const char* nA = has_next ? (const char*)g.A + (size_t)nxt.pm * tstep : cA; const char* nB = has_next ? (const char*)g.Bt + (size_t)nxt.pn * tstep : cB;
        for (int t = 0; t < nt; t += 2) {
            const bool last = (t == nt - 2);
            const char* a1 = cA + (size_t)(t + 1) * kstep;
            const char* a2 = last ? nA : cA + (size_t)(t + 2) * kstep; const char* b2 = last ? nB : cB + (size_t)(t + 2) * kstep;
            const char* a3 = a2 + kstep; const char* b3 = b2 + kstep;
            if (last && has_next) S.a_ready(nxt);
            if constexpr (SP2) {
            PG8_LDB(B0, 0, 0); PG8_LDB(B1, 0, 1); PG8_SCHED; PG8_LDA(At, 0, 0); PG8_STAGE(PG8_SA(1, 1), a1 + hstep, voffA);
            PG8_WAIT_V(8); PG8_WAIT_L(0); PG8_BAR; PG8_MMA(0, 0, At, B0); PG8_MMA(0, 1, At, B1); PG8_BAR; PG8_SCHED;
            PG8_LDA(At, 0, 1); PG8_STAGE(PG8_SB(0, 0), b2, voffB); PG8_STAGE(PG8_SB(0, 1), b2 + hstep, voffB); PG8_STAGE(PG8_SA(0, 0), a2, voffA);
            PG8_WAIT_V(8); PG8_WAIT_L(0); PG8_BAR; PG8_MMA(1, 0, At, B0); PG8_MMA(1, 1, At, B1); PG8_BAR; PG8_SCHED;
            PG8_LDB(B0, 1, 0); PG8_LDB(B1, 1, 1); PG8_SCHED; PG8_LDA(At, 1, 0); PG8_STAGE(PG8_SA(0, 1), a2 + hstep, voffA);
            PG8_WAIT_V(8); PG8_WAIT_L(0); PG8_BAR; PG8_MMA(0, 0, At, B0); PG8_MMA(0, 1, At, B1); PG8_BAR; PG8_SCHED;
            PG8_LDA(At, 1, 1); PG8_STAGE(PG8_SB(1, 0), b3, voffB); PG8_STAGE(PG8_SB(1, 1), b3 + hstep, voffB); PG8_STAGE(PG8_SA(1, 0), a3, voffA);
            PG8_WAIT_V(8); PG8_WAIT_L(0); PG8_BAR; PG8_MMA(1, 0, At, B0); PG8_MMA(1, 1, At, B1); PG8_BAR; PG8_SCHED;
            } else {
            PG8_LDB(B0, 0, 0); PG8_SCHED; PG8_LDA(At, 0, 0); PG8_STAGE(PG8_SA(1, 1), a1 + hstep, voffA);
            PG8_WAIT_L(8); PG8_BAR; PG8_WAIT_L(0); PG8_MMA(0, 0, At, B0); PG8_BAR; PG8_SCHED;
            PG8_LDB(B1, 0, 1); PG8_STAGE(PG8_SB(0, 0), b2, voffB);
            PG8_BAR; PG8_WAIT_L(0); PG8_MMA(0, 1, At, B1); PG8_BAR;
            PG8_LDA(At, 0, 1); PG8_STAGE(PG8_SA(0, 0), a2, voffA);
            PG8_BAR; PG8_WAIT_L(0); PG8_MMA(1, 0, At, B0); PG8_BAR; PG8_SCHED;
            PG8_STAGE(PG8_SB(0, 1), b2 + hstep, voffB);
            PG8_WAIT_V(6); PG8_BAR; PG8_MMA(1, 1, At, B1); PG8_BAR;
            PG8_LDB(B0, 1, 0); PG8_SCHED; PG8_LDA(At, 1, 0); PG8_STAGE(PG8_SA(0, 1), a2 + hstep, voffA);
            PG8_WAIT_L(8); PG8_BAR; PG8_WAIT_L(0); PG8_MMA(0, 0, At, B0); PG8_BAR; PG8_SCHED;
            PG8_LDB(B1, 1, 1); PG8_STAGE(PG8_SB(1, 0), b3, voffB);
            PG8_BAR; PG8_WAIT_L(0); PG8_MMA(0, 1, At, B1); PG8_BAR;
            PG8_LDA(At, 1, 1); PG8_STAGE(PG8_SA(1, 0), a3, voffA);
            PG8_BAR; PG8_WAIT_L(0); PG8_MMA(1, 0, At, B0); PG8_BAR; PG8_SCHED;
            PG8_STAGE(PG8_SB(1, 1), b3 + hstep, voffB);
            PG8_WAIT_V(6); PG8_BAR; PG8_MMA(1, 1, At, B1); PG8_BAR;
            }
        }
        if constexpr (ALIGN_EPI) { if (wr == 0) PG8_BAR; }
        if constexpr (!Epi::AFTER_DRAIN) { E(acc, cur, wr, wc, fr, fq); S.done(cur); }
        if (!has_next) break;
#pragma unroll
        for (int a = 0; a < 2; ++a)
#pragma unroll
            for (int b = 0; b < 2; ++b)
#pragma unroll
                for (int m = 0; m < 4; ++m)
#pragma unroll
                    for (int n = 0; n < 2; ++n) acc[a][b][m][n] = (f32x4){0.f, 0.f, 0.f, 0.f};
        cur = nxt; cA = nA; cB = nB; ++ui;
        if constexpr (ALIGN_EPI) { if (wr == 1) PG8_BAR; }
    }
    PG8_WAIT_V(0);
    if constexpr (!ALIGN_EPI) { if (wr == 0) PG8_BAR; }
    PG8_BAR;
    if constexpr (Epi::AFTER_DRAIN) { E.fused(acc, cur, wr, wc, fr, fq, lds, wid, lane); S.done(cur); }
#undef PG8_SA
#undef PG8_SB
#undef PG8_STAGE
#undef PG8_LDA
#undef PG8_LDB
#undef PG8_MMA
#undef PG8_WAIT_V
#undef PG8_WAIT_L
#undef PG8_BAR
#undef PG8_SCHED
}
}
constexpr int NWAVES = 8, NTHREADS = 512;
constexpr int SEQ = 16384, NB = 2, T = NB * SEQ, D = 1024;
constexpr int E_IN = 1792, LRU_W = 512, FF0 = 2816;
constexpr int O_IN = 4112, GH = 8, GD = 128, GC = 64, NCH = SEQ / GC  , NUNIT = NB * GH * NCH  ;
constexpr int NE = 8, FFE = 3584;
constexpr int MAXTILES = 264, PASS_TILES = 64;
constexpr float EPS = 1e-6f;

constexpr size_t MiB = 1u << 20;
constexpr size_t WS_CTL = 0, CTL_ZERO_BYTES = 1 * MiB;
constexpr size_t WS_ROPE = 1 * MiB;
constexpr size_t WS_STA = 5 * MiB, WS_STB = 7 * MiB;
constexpr size_t WS_MISC = 9 * MiB;
constexpr size_t MS_LRU_A = WS_MISC, MS_LRU_H = WS_MISC + 512 * 1024;
constexpr size_t MS_TOKE = WS_MISC + 1 * MiB;
constexpr size_t MS_TOKW = MS_TOKE + 128 * 1024;
constexpr size_t MS_RANK = MS_TOKW + 256 * 1024;
constexpr size_t MS_DEST = MS_RANK + 256 * 1024;
constexpr size_t MS_CNT = MS_DEST + 256 * 1024;
constexpr size_t MS_TILEE = MS_CNT + 8 * 1024;
constexpr size_t MS_RG = MS_TILEE + 2 * 1024;
constexpr size_t MS_GLAST = WS_MISC + 3 * MiB;
constexpr size_t MS_WSK = MS_GLAST + 16 * 1024;
constexpr size_t MS_ROUT = MS_WSK + 32 * 1024;
constexpr size_t MS_AB = MS_ROUT + 32 * 1024;
constexpr size_t WS_W0 = 13 * MiB;
constexpr size_t W0_IN = WS_W0, W0_OUT = W0_IN + (size_t)E_IN * D * 2, W0_GU = W0_OUT + (size_t)D * D * 2, W0_DN = W0_GU + (size_t)2 * FF0 * D * 2;
constexpr size_t WS_W1 = 35 * MiB;
constexpr size_t W1_IN = WS_W1, W1_OUT = W1_IN + (size_t)4096 * D * 2;
constexpr size_t WS_AB = 46 * MiB;
constexpr size_t WS_HB = 48 * MiB;
constexpr size_t WS_WMD = 48 * MiB;
constexpr size_t WS_PROJ0 = 112 * MiB;
constexpr size_t WS_LRUH = 224 * MiB, WS_LRUP = 288 * MiB;
constexpr size_t WS_YMIX = 352 * MiB;
constexpr size_t WS_ACT0 = 112 * MiB;
constexpr size_t WS_QKV = 112 * MiB;
constexpr size_t WS_GATE = 304 * MiB;
constexpr size_t WS_HALO = 370 * MiB;
constexpr size_t WS_UT = 379 * MiB;
constexpr size_t WS_AQK = 443 * MiB;
constexpr size_t WS_WMGU = 112 * MiB;
constexpr size_t WS_ON = 224 * MiB;
constexpr size_t WS_HB3 = 304 * MiB;
constexpr size_t WS_XG = 380 * MiB;
constexpr size_t WS_ACT = 224 * MiB;
constexpr size_t WS_END = 512 * MiB;
static_assert(W0_DN + (size_t)D * FF0 * 2 <= WS_W1 && W1_OUT + (size_t)D * D * 2 <= WS_AB && MS_AB <= WS_W0, "ws map");
static_assert(WS_XG + (size_t)MAXTILES * 256 * 1024 * 2 <= WS_END && WS_ACT + (size_t)(PASS_TILES + 8) * 256 * FFE * 2 <= WS_XG, "ws map (MoE)");
constexpr int CW_TMO = 0, CW_BAR = 4096;

constexpr int RING_BYTES = 131072;
constexpr int LDSCTL_OFF = RING_BYTES, MISC_OFF = LDSCTL_OFF + 320;
constexpr int LDS_BYTES = 147456;

#define GAS __attribute__((address_space(1)))
#define LAS __attribute__((address_space(3)))
#define DI __device__ __forceinline__
typedef unsigned short bf16;
typedef unsigned v4u __attribute__((ext_vector_type(4)));
typedef unsigned v2u __attribute__((ext_vector_type(2)));
typedef float f32x4 __attribute__((ext_vector_type(4)));
typedef float f32x2 __attribute__((ext_vector_type(2)));
typedef short bf16x8 __attribute__((ext_vector_type(8)));
typedef short bf16x4 __attribute__((ext_vector_type(4)));
typedef GAS unsigned gu32;
#define LDS_WAIT() asm volatile("s_waitcnt lgkmcnt(0)" ::: "memory")
#define VM_WAIT() asm volatile("s_waitcnt vmcnt(0)" ::: "memory")
#define MFMA16(a, b, c) __builtin_amdgcn_mfma_f32_16x16x32_bf16((a), (b), (c), 0, 0, 0)
DI unsigned f2bf(float f) { unsigned u = __builtin_bit_cast(unsigned, f); return (u + 0x7fffu + ((u >> 16) & 1u)) >> 16; }
DI unsigned pk2(float lo, float hi) { return f2bf(lo) | (f2bf(hi) << 16); }
DI float bflo(unsigned w) { return __builtin_bit_cast(float, w << 16); }
DI float bfhi(unsigned w) { return __builtin_bit_cast(float, w & 0xffff0000u); }
DI float bf2f(bf16 v) { return __builtin_bit_cast(float, (unsigned)v << 16); }
DI float sigmoid_f(float x) { return __builtin_amdgcn_rcpf(1.0f + __expf(-x)); }
DI float silu_f(float x) { return x * sigmoid_f(x); }
DI float wave_sum(float v) {
#pragma unroll
    for (int o = 1; o < 64; o <<= 1) v += __shfl_xor(v, o);
    return v;
}
DI bf16x8 mk8(v2u lo, v2u hi) { v4u w; w.x = lo.x; w.y = lo.y; w.z = hi.x; w.w = hi.y; return __builtin_bit_cast(bf16x8, w); }
DI bf16x8 pack_acc2(const f32x4 a, const f32x4 b) { v4u w; w.x = pk2(a[0], a[1]); w.y = pk2(a[2], a[3]); w.z = pk2(b[0], b[1]); w.w = pk2(b[2], b[3]); return __builtin_bit_cast(bf16x8, w); }
#define XB_TMO      128
#define XB_XCNT(j)  (256  + 64 * (j))
#define XB_XSUB(j)  (1280 + 64 * (j))
#define XB_XGEN(j)  (2304 + 64 * (j))
#define XB_TOP      3328
#define XB_TOPGEN   3392
#define XCD_BAR_WORDS 3456
#define XB_SPIN_CAP (1u << 18)

__device__ __forceinline__ unsigned xb_ld(unsigned* p)              { return __hip_atomic_load(p, __ATOMIC_RELAXED, __HIP_MEMORY_SCOPE_AGENT); }
__device__ __forceinline__ unsigned xb_add(unsigned* p, unsigned v) { return __hip_atomic_fetch_add(p, v, __ATOMIC_RELAXED, __HIP_MEMORY_SCOPE_AGENT); }
__device__ __forceinline__ unsigned xb_xcc_id() { return (unsigned)__builtin_amdgcn_s_getreg((3 << 11) | 20) & 0xFu; }
#define XB_SPIN(cond, bar) do { unsigned _sp = 0; while (cond) { __builtin_amdgcn_s_sleep(1); \
    if ((++_sp & 255u) == 0u) { if (xb_ld(&(bar)[XB_TMO])) break; if (_sp > XB_SPIN_CAP) { atomicAdd(&(bar)[XB_TMO], 1u); break; } } } } while (0)

struct XcdBarrier {
    unsigned* bar; unsigned x;
    volatile LAS unsigned* st;
};

__device__ __forceinline__ XcdBarrier xcd_barrier_post(unsigned* bar, volatile LAS unsigned* st) {
    XcdBarrier b; b.bar = bar; b.x = xb_xcc_id(); b.st = st;
    if (threadIdx.x == 0) (void)xb_add(&bar[XB_XCNT(b.x)], 1u);
    return b;
}
__device__ __forceinline__ void xcd_barrier_complete(unsigned* bar, unsigned x, unsigned& nloc, unsigned& nx) {
    const unsigned G = gridDim.x * gridDim.y * gridDim.z;
    unsigned sum, cnt, mine, sp = 0u;
    for (;;) {
        sum = 0u; cnt = 0u; mine = 0u;
#pragma unroll
        for (unsigned j = 0; j < 16; ++j) { const unsigned c = xb_ld(&bar[XB_XCNT(j)]); sum += c; cnt += (c > 0u) ? 1u : 0u; mine = (j == x) ? c : mine; }
        if (sum == G) break;
        __builtin_amdgcn_s_sleep(1);
        if ((++sp & 255u) == 0u) { if (xb_ld(&bar[XB_TMO])) break; if (sp > XB_SPIN_CAP) { atomicAdd(&bar[XB_TMO], 1u); break; } }
    }
    nloc = mine > 0u ? mine : 1u; nx = cnt > 0u ? cnt : 1u;
}

__device__ __forceinline__ void xcd_barrier(const XcdBarrier& b) {
    asm volatile("s_waitcnt vmcnt(0)" ::: "memory");
    __syncthreads();
    if (threadIdx.x == 0) {
        unsigned* bar = b.bar;
        __builtin_amdgcn_s_waitcnt(0);
        unsigned nloc = b.st[0], nx = b.st[1];
        if (nloc == 0u) { xcd_barrier_complete(bar, b.x, nloc, nx); b.st[0] = nloc; b.st[1] = nx; }
        const unsigned old = xb_add(&bar[XB_XSUB(b.x)], 1u);
        const unsigned gen = old / nloc;
        if (old + 1u == (gen + 1u) * nloc) {
            __builtin_amdgcn_fence(__ATOMIC_RELEASE, "agent");
            asm volatile("s_waitcnt vmcnt(0)" ::: "memory");
            const unsigned og = xb_add(&bar[XB_TOP], 1u);
            const unsigned tg = og / nx;
            if (og + 1u == (tg + 1u) * nx) xb_add(&bar[XB_TOPGEN], 1u);
            else XB_SPIN(xb_ld(&bar[XB_TOPGEN]) == tg, bar);
            __builtin_amdgcn_fence(__ATOMIC_ACQUIRE, "agent");
            xb_add(&bar[XB_XGEN(b.x)], 1u);
            asm volatile("s_waitcnt vmcnt(0)" ::: "memory");
        } else {
            XB_SPIN(xb_ld(&bar[XB_XGEN(b.x)]) == gen, bar);
            __builtin_amdgcn_fence(__ATOMIC_ACQUIRE, "agent");
            asm volatile("s_waitcnt vmcnt(0)" ::: "memory");
        }
    }
    __syncthreads();
}
DI void cvt_item(const float* W, int ldw, int K, const float* gain, bf16* WT, int drow0, int k0, int n0, LAS float* scr, int lane) {
#pragma unroll 8
    for (int i = 0; i < 32; ++i) { const int kk = 2 * i + (lane >> 5); scr[kk * 33 + (lane & 31)] = W[(size_t)(k0 + kk) * ldw + n0 + (lane & 31)]; }
    LDS_WAIT();
    const int c = lane & 7;
    float gk[8];
#pragma unroll
    for (int e = 0; e < 8; ++e) gk[e] = gain ? gain[k0 + 8 * c + e] : 1.0f;
#pragma unroll
    for (int j = 0; j < 4; ++j) { const int n = (lane >> 3) + 8 * j; const LAS float* s = scr + (8 * c) * 33 + n;
        v4u o; o.x = pk2(s[0 * 33] * gk[0], s[1 * 33] * gk[1]); o.y = pk2(s[2 * 33] * gk[2], s[3 * 33] * gk[3]); o.z = pk2(s[4 * 33] * gk[4], s[5 * 33] * gk[5]); o.w = pk2(s[6 * 33] * gk[6], s[7 * 33] * gk[7]);
        *(v4u*)(WT + (size_t)(drow0 + n) * K + k0 + 8 * c) = o; }
    LDS_WAIT();
}
DI void cvt_plain(const float* W, int ldw, int K, int N, const float* gain, bf16* WT, int it, LAS float* scr, int lane) {
    const int nblk = N / 32, kb = it / nblk, nb = it % nblk; cvt_item(W, ldw, K, gain, WT, 32 * nb, 64 * kb, 32 * nb, scr, lane);
}
DI void cvt_gu(const float* W, int K, int N, const float* gain, bf16* WT, int up, int it, LAS float* scr, int lane) {
    const int nblk = N / 32, kb = it / nblk, nb = it % nblk, n0 = 32 * nb; cvt_item(W, N, K, gain, WT, (n0 >> 7) * 256 + up * 128 + (n0 & 127), 64 * kb, n0, scr, lane);
}
struct Args { const float* in[28]; float* out; unsigned char* ws; int ph_lo, ph_hi; };
enum { I_X = 0, I_LNMIX, I_LNFFN, I_EWIN, I_CONVW, I_CONVB, I_WA, I_BA, I_WI, I_BI, I_LAM, I_QN, I_KN, I_SINK, I_EWOUT, I_FG, I_FU, I_FD,
       I_OWIN, I_OCONV, I_ALOG, I_DTB, I_ONORM, I_OWOUT, I_ROUT, I_MG, I_MU, I_MD };

DI void phase_prologue(const Args& a, LAS unsigned char* lds, int gw, int NGW, int wave, int lane) {
    unsigned char* ws = a.ws;
    LAS float* scr = (LAS float*)(lds + wave * 16384);
    constexpr int I1 = 16 * 56, I2 = 16 * 32, I3 = 16 * 88, I5 = 44 * 32, I6 = 16 * 128, I7 = 16 * 32, NIT = I1 + I2 + 2 * I3 + I5 + I6 + I7;
    for (int it = gw; it < NIT; it += NGW) {
        int r = it;
        if (r < I1) { cvt_plain(a.in[I_EWIN], E_IN, D, E_IN, a.in[I_LNMIX], (bf16*)(ws + W0_IN), r, scr, lane); continue; } r -= I1;
        if (r < I2) { cvt_plain(a.in[I_EWOUT], D, D, D, nullptr, (bf16*)(ws + W0_OUT), r, scr, lane); continue; } r -= I2;
        if (r < I3) { cvt_gu(a.in[I_FG], D, FF0, a.in[I_LNFFN], (bf16*)(ws + W0_GU), 0, r, scr, lane); continue; } r -= I3;
        if (r < I3) { cvt_gu(a.in[I_FU], D, FF0, a.in[I_LNFFN], (bf16*)(ws + W0_GU), 1, r, scr, lane); continue; } r -= I3;
        if (r < I5) { cvt_plain(a.in[I_FD], D, FF0, D, nullptr, (bf16*)(ws + W0_DN), r, scr, lane); continue; } r -= I5;
        if (r < I6) { cvt_plain(a.in[I_OWIN], O_IN, D, 4096, a.in[I_LNMIX] + D, (bf16*)(ws + W1_IN), r, scr, lane); continue; } r -= I6;
        cvt_plain(a.in[I_OWOUT], D, D, D, nullptr, (bf16*)(ws + W1_OUT), r, scr, lane);
    }
    const int gt = gw * 64 + lane, NGT = NGW * 64;
    for (int i = gt; i < 16 * D; i += NGT) { const int c = i >> 10, k = i & 1023; ((bf16*)(ws + MS_WSK))[i] = (bf16)f2bf(a.in[I_OWIN][(size_t)k * O_IN + 4096 + c] * a.in[I_LNMIX][D + k]); }
    for (int i = gt; i < 8 * D; i += NGT) { const int k = i >> 3; ((float*)(ws + MS_ROUT))[i] = a.in[I_ROUT][i] * a.in[I_LNFFN][D + k]; }
    for (int i = gt; i < SEQ * 32; i += NGT) { const int pos = i >> 5, f = i & 31;
        const float inv = powf(10000.0f, -(float)f * (1.0f / 32.0f)); const float ang = (float)pos * inv;
        const double tt = (double)ang * 0.15915494309189535; const float fr = (float)(tt - rint(tt));
        f32x2 cs; cs.x = __builtin_amdgcn_cosf(fr); cs.y = __builtin_amdgcn_sinf(fr); ((f32x2*)(ws + WS_ROPE))[i] = cs; }
    for (int m = gw; m < T; m += NGW) {
        const f32x4* xr = (const f32x4*)(a.in[I_X] + (size_t)m * D) + lane; f32x4 v[4]; float s = 0.f;
#pragma unroll
        for (int j = 0; j < 4; ++j) { v[j] = xr[64 * j]; s += (v[j].x * v[j].x + v[j].y * v[j].y) + (v[j].z * v[j].z + v[j].w * v[j].w); }
        s = wave_sum(s);
        v2u* o8 = (v2u*)((bf16*)(ws + WS_HB) + (size_t)m * D) + lane;
#pragma unroll
        for (int j = 0; j < 4; ++j) { v2u w; w.x = pk2(v[j].x, v[j].y); w.y = pk2(v[j].z, v[j].w); o8[64 * j] = w; }
        if (lane < 16) ((float*)(ws + WS_STA))[(size_t)m * 16 + lane] = lane == 0 ? s : 0.f;
    }
}
constexpr int MOE_D_ITEMS = NE * 56 * 32, MOE_GU_ITEMS = NE * 2 * 16 * 112;
DI void cvt_moe_down(const Args& a, int it, LAS float* scr, int lane) {
    const int e = it / (56 * 32), r = it % (56 * 32);
    cvt_plain(a.in[I_MD] + (size_t)e * FFE * D, D, FFE, D, nullptr, (bf16*)(a.ws + WS_WMD) + (size_t)e * D * FFE, r, scr, lane);
}
DI void cvt_moe_gu(const Args& a, int it, LAS float* scr, int lane) {
    const int e = it / (2 * 16 * 112), r0 = it % (2 * 16 * 112), up = r0 / (16 * 112), r = r0 % (16 * 112);
    cvt_gu((up ? a.in[I_MU] : a.in[I_MG]) + (size_t)e * D * FFE, D, FFE, a.in[I_LNFFN] + D, (bf16*)(a.ws + WS_WMGU) + (size_t)e * 2 * FFE * D, up, r, scr, lane);
}

struct LruFrags { bf16x8 wa[4][2], wi[4][2]; };
DI void lru_frags(const Args& a, LAS unsigned char* lds, LruFrags& F, int wave, int lane) {
    const int g = lane >> 4, c16 = lane & 15;
    LAS float* scr = (LAS float*)(lds + wave * 16384);
#pragma unroll
    for (int gate = 0; gate < 2; ++gate) {
        const f32x4* W = (const f32x4*)((gate ? a.in[I_WI] : a.in[I_WA]) + wave * 4096);
#pragma unroll
        for (int q = 0; q < 16; ++q) ((LAS f32x4*)scr)[q * 64 + lane] = W[q * 64 + lane];
        LDS_WAIT();
        const LAS float* sp = scr + (8 * g) * 64 + c16;
#pragma unroll
        for (int jt = 0; jt < 4; ++jt)
#pragma unroll
            for (int ks = 0; ks < 2; ++ks) { float t[8];
#pragma unroll
                for (int e = 0; e < 8; ++e) t[e] = sp[(32 * ks + e) * 64 + 16 * jt];
                v4u p; p.x = pk2(t[0], t[1]); p.y = pk2(t[2], t[3]); p.z = pk2(t[4], t[5]); p.w = pk2(t[6], t[7]);
                if (gate) F.wi[jt][ks] = __builtin_bit_cast(bf16x8, p); else F.wa[jt][ks] = __builtin_bit_cast(bf16x8, p); }
        LDS_WAIT();
    }
}
DI void lru_unit(const Args& a, LAS unsigned char* lds, const LruFrags& F, int unit, int wave, int lane) {
    unsigned char* ws = a.ws;
    const int b = unit >> 7, chk = unit & 127, t0 = chk * 128, g = lane >> 4, c16 = lane & 15;
    const size_t rowb = (size_t)b * SEQ;
    const bf16* proj0 = (const bf16*)(ws + WS_PROJ0);
    float* hloc = (float*)(ws + WS_LRUH); float* pcum = (float*)(ws + WS_LRUP);
    const int c = wave * 64 + lane;
    const float w0 = a.in[I_CONVW][c], w1 = a.in[I_CONVW][512 + c], w2 = a.in[I_CONVW][1024 + c], w3 = a.in[I_CONVW][1536 + c], cb = a.in[I_CONVB][c];
    const float ba = a.in[I_BA][c], bi = a.in[I_BI][c], lam = a.in[I_LAM][c];
    const float sp8 = 8.0f * (lam < -20.f ? -lam : log1pf(expf(-lam)));
    LAS bf16* XC = (LAS bf16*)(lds + wave * 11264);
    LAS float* GA = (LAS float*)(lds + wave * 11264 + 2304);
    LAS float* GI = GA + 16 * 68;
    float x1 = 0.f, x2 = 0.f, x3 = 0.f;
    if (t0 > 0) { x1 = bf2f(proj0[(rowb + t0 - 1) * E_IN + c]); x2 = bf2f(proj0[(rowb + t0 - 2) * E_IN + c]); x3 = bf2f(proj0[(rowb + t0 - 3) * E_IN + c]); }
    float h = 0.f, P = 1.f;
#pragma unroll 1
    for (int st = 0; st < 8; ++st) {
        float xc[16];
#pragma unroll
        for (int tt = 0; tt < 16; ++tt) { const float xn = bf2f(proj0[(rowb + t0 + 16 * st + tt) * E_IN + c]);
            xc[tt] = w0 * x3 + w1 * x2 + w2 * x1 + w3 * xn + cb; x3 = x2; x2 = x1; x1 = xn; XC[tt * 72 + lane] = (bf16)f2bf(xc[tt]); }
        LDS_WAIT();
        bf16x8 bx[2];
#pragma unroll
        for (int ks = 0; ks < 2; ++ks) bx[ks] = *(const LAS bf16x8*)(XC + c16 * 72 + 32 * ks + 8 * g);
#pragma unroll
        for (int jt = 0; jt < 4; ++jt) { f32x4 ca = {0.f, 0.f, 0.f, 0.f}, ci = {0.f, 0.f, 0.f, 0.f};
#pragma unroll
            for (int ks = 0; ks < 2; ++ks) { ca = MFMA16(F.wa[jt][ks], bx[ks], ca); ci = MFMA16(F.wi[jt][ks], bx[ks], ci); }
            *(LAS f32x4*)(GA + c16 * 68 + 16 * jt + 4 * g) = ca; *(LAS f32x4*)(GI + c16 * 68 + 16 * jt + 4 * g) = ci; }
        LDS_WAIT();
#pragma unroll
        for (int tt = 0; tt < 16; ++tt) {
            const float r = sigmoid_f(GA[tt * 68 + lane] + ba), gi = sigmoid_f(GI[tt * 68 + lane] + bi);
            const float la = -sp8 * r, av = __expf(la), mult = sqrtf(fmaxf(1.0f - av * av, 0.f));
            h = av * h + mult * gi * xc[tt]; P *= av;
            const size_t o = (rowb + t0 + 16 * st + tt) * LRU_W + c; hloc[o] = h; pcum[o] = P; }
        LDS_WAIT();
    }
    ((float*)(ws + MS_LRU_A))[(size_t)unit * 512 + c] = P; ((float*)(ws + MS_LRU_H))[(size_t)unit * 512 + c] = h;
}

DI void attn_unit(const Args& a, LAS unsigned char* lds, int unit, int tid, int wave, int lane) {
    unsigned char* ws = a.ws;
    const int kvh = unit & 1, blk = (unit >> 1) & 127, b = unit >> 8, t0 = blk * 128, g = lane >> 4, c = lane & 15;
    const size_t rowb = (size_t)b * SEQ;
    const bf16* proj0 = (const bf16*)(ws + WS_PROJ0); const f32x2* rope = (const f32x2*)(ws + WS_ROPE);
    LAS bf16* Ks = (LAS bf16*)lds;
    LAS bf16* Vt = (LAS bf16*)(lds + 36864);
    {
        const int key = tid >> 1, p = tid & 1, pos = t0 - 128 + key;
        if (pos >= 0) {
            const bf16* src = proj0 + (rowb + pos) * E_IN + 1536 + kvh * 64;
            const v4u q0 = *(const v4u*)(src + 16 * p), q1 = *(const v4u*)(src + 16 * p + 8), q2 = *(const v4u*)(src + 32 + 16 * p), q3 = *(const v4u*)(src + 32 + 16 * p + 8);
            float xa[16], xb[16];
            xa[0] = bflo(q0.x); xa[1] = bfhi(q0.x); xa[2] = bflo(q0.y); xa[3] = bfhi(q0.y); xa[4] = bflo(q0.z); xa[5] = bfhi(q0.z); xa[6] = bflo(q0.w); xa[7] = bfhi(q0.w);
            xa[8] = bflo(q1.x); xa[9] = bfhi(q1.x); xa[10] = bflo(q1.y); xa[11] = bfhi(q1.y); xa[12] = bflo(q1.z); xa[13] = bfhi(q1.z); xa[14] = bflo(q1.w); xa[15] = bfhi(q1.w);
            xb[0] = bflo(q2.x); xb[1] = bfhi(q2.x); xb[2] = bflo(q2.y); xb[3] = bfhi(q2.y); xb[4] = bflo(q2.z); xb[5] = bfhi(q2.z); xb[6] = bflo(q2.w); xb[7] = bfhi(q2.w);
            xb[8] = bflo(q3.x); xb[9] = bfhi(q3.x); xb[10] = bflo(q3.y); xb[11] = bfhi(q3.y); xb[12] = bflo(q3.z); xb[13] = bfhi(q3.z); xb[14] = bflo(q3.w); xb[15] = bfhi(q3.w);
            float ss = 0.f;
#pragma unroll
            for (int e = 0; e < 16; ++e) ss += xa[e] * xa[e] + xb[e] * xb[e];
            ss += __shfl_xor(ss, 1);
            const float rn = __builtin_amdgcn_rsqf(ss * (1.0f / 64.0f) + EPS);
            unsigned oa[8], ob[8];
#pragma unroll
            for (int e = 0; e < 16; e += 2) { float r1[2], r2[2];
#pragma unroll
                for (int k = 0; k < 2; ++k) { const int d = 16 * p + e + k; const f32x2 cs = rope[(size_t)pos * 32 + d];
                    const float y1 = xa[e + k] * rn * a.in[I_KN][d], y2 = xb[e + k] * rn * a.in[I_KN][32 + d]; r1[k] = y1 * cs.x - y2 * cs.y; r2[k] = y2 * cs.x + y1 * cs.y; }
                oa[e >> 1] = pk2(r1[0], r1[1]); ob[e >> 1] = pk2(r2[0], r2[1]); }
            v4u w; w.x = oa[0]; w.y = oa[1]; w.z = oa[2]; w.w = oa[3]; *(LAS v4u*)(Ks + key * 72 + 16 * p) = w;
            w.x = oa[4]; w.y = oa[5]; w.z = oa[6]; w.w = oa[7]; *(LAS v4u*)(Ks + key * 72 + 16 * p + 8) = w;
            w.x = ob[0]; w.y = ob[1]; w.z = ob[2]; w.w = ob[3]; *(LAS v4u*)(Ks + key * 72 + 32 + 16 * p) = w;
            w.x = ob[4]; w.y = ob[5]; w.z = ob[6]; w.w = ob[7]; *(LAS v4u*)(Ks + key * 72 + 32 + 16 * p + 8) = w;
            const bf16* vs = proj0 + (rowb + pos) * E_IN + 1664 + kvh * 64 + 32 * p;
#pragma unroll
            for (int q = 0; q < 4; ++q) { const v4u vv = *(const v4u*)(vs + 8 * q); const unsigned vw[4] = {vv.x, vv.y, vv.z, vv.w};
#pragma unroll
                for (int e = 0; e < 4; ++e) { Vt[(32 * p + 8 * q + 2 * e) * 264 + key] = (bf16)(vw[e] & 0xffffu); Vt[(32 * p + 8 * q + 2 * e + 1) * 264 + key] = (bf16)(vw[e] >> 16); } }
        } else {
            const v4u z = {0u, 0u, 0u, 0u};
            *(LAS v4u*)(Ks + key * 72 + 16 * p) = z; *(LAS v4u*)(Ks + key * 72 + 16 * p + 8) = z; *(LAS v4u*)(Ks + key * 72 + 32 + 16 * p) = z; *(LAS v4u*)(Ks + key * 72 + 32 + 16 * p + 8) = z;
#pragma unroll
            for (int e = 0; e < 32; ++e) Vt[(32 * p + e) * 264 + key] = (bf16)0;
        }
    }
    __syncthreads();
    const int hq = kvh * 4 + (wave >> 1), qh = wave & 1; const float sink = a.in[I_SINK][hq];
    bf16* ymix = (bf16*)(ws + WS_YMIX);
    for (int qt = 0; qt < 4; ++qt) {
        const int q0 = 64 * qh + 16 * qt, kt0 = 4 * qh + qt; const int tok = t0 + q0 + c;
        bf16x8 bq[2];
        {   const bf16* src = proj0 + (rowb + tok) * E_IN + 1024 + hq * 64;
            const v4u r0 = *(const v4u*)(src + 8 * g), r1 = *(const v4u*)(src + 32 + 8 * g);
            const unsigned u0[4] = {r0.x, r0.y, r0.z, r0.w}, u1[4] = {r1.x, r1.y, r1.z, r1.w}; float xa[8], xb[8]; float ss = 0.f;
#pragma unroll
            for (int e = 0; e < 4; ++e) { xa[2 * e] = bflo(u0[e]); xa[2 * e + 1] = bfhi(u0[e]); xb[2 * e] = bflo(u1[e]); xb[2 * e + 1] = bfhi(u1[e]); }
#pragma unroll
            for (int e = 0; e < 8; ++e) ss += xa[e] * xa[e] + xb[e] * xb[e];
            ss += __shfl_xor(ss, 16); ss += __shfl_xor(ss, 32);
            const float rn = __builtin_amdgcn_rsqf(ss * (1.0f / 64.0f) + EPS) * 0.125f;
            float o1[8], o2[8];
#pragma unroll
            for (int e = 0; e < 8; ++e) { const int d = 8 * g + e; const f32x2 cs = rope[(size_t)tok * 32 + d];
                const float y1 = xa[e] * rn * a.in[I_QN][d], y2 = xb[e] * rn * a.in[I_QN][32 + d]; o1[e] = y1 * cs.x - y2 * cs.y; o2[e] = y2 * cs.x + y1 * cs.y; }
            v4u w; w.x = pk2(o1[0], o1[1]); w.y = pk2(o1[2], o1[3]); w.z = pk2(o1[4], o1[5]); w.w = pk2(o1[6], o1[7]); bq[0] = __builtin_bit_cast(bf16x8, w);
            w.x = pk2(o2[0], o2[1]); w.y = pk2(o2[2], o2[3]); w.z = pk2(o2[4], o2[5]); w.w = pk2(o2[6], o2[7]); bq[1] = __builtin_bit_cast(bf16x8, w);
        }
        f32x4 s[9]; float mx = -1e30f;
        const int qi = 128 + q0 + c;
#pragma unroll
        for (int kt = 0; kt < 9; ++kt) {
            const LAS bf16* kp = Ks + (16 * (kt0 + kt) + c) * 72 + 8 * g;
            f32x4 acc = {0.f, 0.f, 0.f, 0.f};
            acc = MFMA16(*(const LAS bf16x8*)kp, bq[0], acc); acc = MFMA16(*(const LAS bf16x8*)(kp + 32), bq[1], acc);
#pragma unroll
            for (int r = 0; r < 4; ++r) { const int kj = 16 * (kt0 + kt) + 4 * g + r; const bool ok = (kj <= qi) && (qi - kj < 128) && (blk > 0 || kj >= 128);
                acc[r] = ok ? acc[r] : -1e30f; mx = fmaxf(mx, acc[r]); }
            s[kt] = acc;
        }
        mx = fmaxf(mx, __shfl_xor(mx, 16)); mx = fmaxf(mx, __shfl_xor(mx, 32)); mx = fmaxf(mx, sink);
        float sum = 0.f;
#pragma unroll
        for (int kt = 0; kt < 9; ++kt)
#pragma unroll
            for (int r = 0; r < 4; ++r) { const float p = (s[kt][r] > -1e29f) ? __expf(s[kt][r] - mx) : 0.f; s[kt][r] = p; sum += p; }
        sum += __shfl_xor(sum, 16); sum += __shfl_xor(sum, 32); sum += __expf(sink - mx);
        const float inv = __builtin_amdgcn_rcpf(sum);
        bf16x8 bp[5];
#pragma unroll
        for (int pp = 0; pp < 4; ++pp) bp[pp] = pack_acc2(s[2 * pp] * inv, s[2 * pp + 1] * inv);
        { const f32x4 z = {0.f, 0.f, 0.f, 0.f}; bp[4] = pack_acc2(s[8] * inv, z); }
#pragma unroll
        for (int dt = 0; dt < 4; ++dt) { f32x4 o = {0.f, 0.f, 0.f, 0.f};
#pragma unroll
            for (int pp = 0; pp < 5; ++pp) { const LAS bf16* vp = Vt + (16 * dt + c) * 264 + 16 * (kt0 + 2 * pp) + 4 * g;
                const v2u lo = *(const LAS v2u*)vp, hi = *(const LAS v2u*)(vp + (pp < 4 ? 16 : 0)); o = MFMA16(mk8(lo, hi), bp[pp], o); }
            v2u w; w.x = pk2(o[0], o[1]); w.y = pk2(o[2], o[3]); *(v2u*)(ymix + (rowb + tok) * D + 512 + hq * 64 + 16 * dt + 4 * g) = w; }
    }
    __syncthreads();
}

DI void lrufix_unit(const Args& a, int unit, int tid) {
    unsigned char* ws = a.ws;
    const int b = unit >> 7, chk = unit & 127, c = tid;
    const float* At = (const float*)(ws + MS_LRU_A); const float* Ht = (const float*)(ws + MS_LRU_H);
    float hin = 0.f;
    for (int cc = 0; cc < chk; ++cc) { const size_t o = (size_t)(b * 128 + cc) * 512 + c; hin = At[o] * hin + Ht[o]; }
    const float* hloc = (const float*)(ws + WS_LRUH); const float* pcum = (const float*)(ws + WS_LRUP);
    const bf16* proj0 = (const bf16*)(ws + WS_PROJ0); bf16* ymix = (bf16*)(ws + WS_YMIX);
#pragma unroll 4
    for (int t = 0; t < 128; ++t) { const size_t row = (size_t)b * SEQ + chk * 128 + t;
        const float h = hloc[row * LRU_W + c] + pcum[row * LRU_W + c] * hin; const float x = bf2f(proj0[row * E_IN + 512 + c]);
        const float z = 0.7978845608028654f * (x + 0.044715f * x * x * x); const float th = 1.0f - 2.0f * __builtin_amdgcn_rcpf(1.0f + __expf(2.0f * z));
        ymix[row * D + c] = (bf16)f2bf(h * 0.5f * x * (1.0f + th)); }
}
DI void skinny_tile(const Args& a, int tile, int lane) {
    unsigned char* ws = a.ws; const int g = lane >> 4, c = lane & 15;
    const bf16* wsk = (const bf16*)(ws + MS_WSK) + c * D + 8 * g; const bf16* hb = (const bf16*)(ws + WS_HB) + (size_t)(tile * 16 + c) * D + 8 * g;
    f32x4 acc = {0.f, 0.f, 0.f, 0.f};
#pragma unroll 8
    for (int ks = 0; ks < 32; ++ks) acc = MFMA16(*(const bf16x8*)(wsk + 32 * ks), *(const bf16x8*)(hb + 32 * ks), acc);
    const int row = tile * 16 + c; const float rs = pg8::rstd16((const float*)(ws + WS_STA), row);
    *(f32x4*)((float*)(ws + WS_AB) + (size_t)row * 16 + 4 * g) = acc * rs;
}

constexpr int PR_XQ = 0, PR_XK = 17408, PR_KT = 34816, PR_VT = 53248, PR_LS = 71680, PR_T1 = 89088, PR_T2 = 98304, PR_VEC = 107520;
DI void prep_unit(const Args& a, LAS unsigned char* lds, int unit, int tid, int wave, int lane) {
    unsigned char* ws = a.ws;
    const int ck = unit & 255, h = (unit >> 8) & 7, b = unit >> 11, g = lane >> 4, c = lane & 15;
    const size_t R0 = (size_t)b * SEQ + (size_t)ck * 64;
    bf16* qkv = (bf16*)(ws + WS_QKV);
    LAS bf16* XQ = (LAS bf16*)(lds + PR_XQ); LAS bf16* XK = (LAS bf16*)(lds + PR_XK); LAS bf16* KT = (LAS bf16*)(lds + PR_KT); LAS bf16* VT = (LAS bf16*)(lds + PR_VT);
    LAS float* Ls = (LAS float*)(lds + PR_LS); LAS bf16* T1 = (LAS bf16*)(lds + PR_T1); LAS bf16* T2 = (LAS bf16*)(lds + PR_T2);
    LAS float* Gs = (LAS float*)(lds + PR_VEC); LAS float* Bs = Gs + 64; LAS float* Rq = Gs + 128; LAS float* Rk = Gs + 192;
    if (tid < 384) {
        const int part = wave >> 1, ch = tid & 127, col = part * 1024 + h * 128 + ch;
        const float w0 = a.in[I_OCONV][col], w1 = a.in[I_OCONV][3072 + col], w2 = a.in[I_OCONV][6144 + col], w3 = a.in[I_OCONV][9216 + col];
        float x1 = 0.f, x2 = 0.f, x3 = 0.f;
        if (ck > 0) { const bf16* hp = (const bf16*)(ws + WS_HALO) + (size_t)(b * NCH + ck - 1) * 3 * 3072 + col; x3 = bf2f(hp[0]); x2 = bf2f(hp[3072]); x1 = bf2f(hp[6144]); }
        const bf16* src = qkv + R0 * 3072 + col;
        for (int j4 = 0; j4 < 16; ++j4) { float y[4];
#pragma unroll
            for (int e = 0; e < 4; ++e) { const float xn = bf2f(src[(size_t)(4 * j4 + e) * 3072]); const float v = w0 * x3 + w1 * x2 + w2 * x1 + w3 * xn; x3 = x2; x2 = x1; x1 = xn; y[e] = silu_f(v); }
            if (part == 0) {
#pragma unroll
                for (int e = 0; e < 4; ++e) XQ[(4 * j4 + e) * 136 + ch] = (bf16)f2bf(y[e]);
            } else { v2u w; w.x = pk2(y[0], y[1]); w.y = pk2(y[2], y[3]);
                if (part == 1) {
#pragma unroll
                    for (int e = 0; e < 4; ++e) XK[(4 * j4 + e) * 136 + ch] = (bf16)f2bf(y[e]);
                    *(LAS v2u*)(KT + ch * 72 + 4 * j4) = w;
                } else *(LAS v2u*)(VT + ch * 72 + 4 * j4) = w; }
        }
    } else if (wave == 6) {
        const float* ab = (const float*)(ws + WS_AB) + (R0 + lane) * 16;
        const float xin = ab[h] + a.in[I_DTB][h]; const float sp = xin > 20.f ? xin : log1pf(expf(xin));
        float G = -expf(a.in[I_ALOG][h]) * sp;
#pragma unroll
        for (int o = 1; o < 64; o <<= 1) { const float v = __shfl_up(G, o); if (lane >= o) G += v; }
        Gs[lane] = G; Bs[lane] = sigmoid_f(ab[8 + h]);
        if (lane == 63) ((float*)(ws + MS_GLAST))[unit] = expf(G);
    } else {
        const f32x4 z = {0.f, 0.f, 0.f, 0.f};
        for (int i = lane; i < 64 * 68 / 4; i += 64) ((LAS f32x4*)Ls)[i] = z;
    }
    __syncthreads();
    { const int row = tid >> 2, qtr = tid & 3; const LAS bf16* s = (row < 64 ? XQ + row * 136 : XK + (row - 64) * 136) + 32 * qtr; float ss = 0.f;
#pragma unroll
      for (int q = 0; q < 4; ++q) { const v4u v = *(const LAS v4u*)(s + 8 * q); const unsigned vw[4] = {v.x, v.y, v.z, v.w};
#pragma unroll
          for (int e = 0; e < 4; ++e) { const float l = bflo(vw[e]), hh = bfhi(vw[e]); ss += l * l + hh * hh; } }
      ss += __shfl_xor(ss, 1); ss += __shfl_xor(ss, 2);
      const float rn = __builtin_amdgcn_rsqf(ss + EPS);
      if (qtr == 0) { if (row < 64) Rq[row] = rn * 0.08838834764831845f; else Rk[row - 64] = rn; } }
    __syncthreads();
    bf16* aq = (bf16*)(ws + WS_AQK) + (size_t)unit * 4096;
    for (int job = wave; job < 26; job += 8) {
        int it, jt; const bool isk = job < 10;
        if (isk) { it = job >= 6 ? 3 : (job >= 3 ? 2 : (job >= 1 ? 1 : 0)); jt = job - it * (it + 1) / 2; } else { it = (job - 10) >> 2; jt = (job - 10) & 3; }
        const int i = 16 * it + c, j0 = 16 * jt + 4 * g;
        if (it < jt) { const v2u z = {0u, 0u}; *(v2u*)(aq + i * 64 + j0) = z; continue; }
        const LAS bf16* ap = XK + (16 * jt + c) * 136 + 8 * g; const LAS bf16* bp = (isk ? XK : XQ) + (16 * it + c) * 136 + 8 * g;
        f32x4 acc = {0.f, 0.f, 0.f, 0.f};
#pragma unroll
        for (int ks = 0; ks < 4; ++ks) acc = MFMA16(*(const LAS bf16x8*)(ap + 32 * ks), *(const LAS bf16x8*)(bp + 32 * ks), acc);
        const float Gi = Gs[i], ri = isk ? Bs[i] * Rk[i] : Rq[i]; f32x4 o;
#pragma unroll
        for (int r = 0; r < 4; ++r) { const int j = j0 + r; const bool ok = isk ? (i > j) : (i >= j); const float dcy = __expf(fminf(Gi - Gs[j], 0.f)); o[r] = ok ? acc[r] * ri * Rk[j] * dcy : 0.f; }
        if (isk) *(LAS f32x4*)(Ls + i * 68 + j0) = o; else { v2u w; w.x = pk2(o[0], o[1]); w.y = pk2(o[2], o[3]); *(v2u*)(aq + i * 64 + j0) = w; }
    }
    __syncthreads();
    if (wave == 0) {
        float t[64]; int ln = lane; asm volatile("" : "+v"(ln));
#pragma unroll
        for (int i = 0; i < 64; ++i) { float acc = (i == ln) ? 1.f : 0.f;
#pragma unroll
            for (int k4 = 0; k4 < (i + 3) / 4; ++k4) { const f32x4 l = *(const LAS f32x4*)(Ls + i * 68 + 4 * k4);
#pragma unroll
                for (int e = 0; e < 4; ++e) if (4 * k4 + e < i) acc -= l[e] * t[4 * k4 + e]; }
            t[i] = acc; }
        const float bj = Bs[lane], s1 = bj, s2 = -bj * __expf(Gs[lane]) * Rk[lane];
#pragma unroll
        for (int i = 0; i < 64; ++i) { T1[i * 72 + lane] = (bf16)f2bf(t[i] * s1); T2[i * 72 + lane] = (bf16)f2bf(t[i] * s2); }
    } else {
        const float Gl = Gs[63];
        for (int task = tid - 64; task < 2048; task += 448) {
            if (task < 1024) { const int i = task >> 4, dc = task & 15; const float sc = Rq[i] * __expf(Gs[i]);
                const v4u v = *(const LAS v4u*)(XQ + i * 136 + 8 * dc); v4u o;
                o.x = pk2(bflo(v.x) * sc, bfhi(v.x) * sc); o.y = pk2(bflo(v.y) * sc, bfhi(v.y) * sc); o.z = pk2(bflo(v.z) * sc, bfhi(v.z) * sc); o.w = pk2(bflo(v.w) * sc, bfhi(v.w) * sc);
                *(v4u*)(qkv + (R0 + i) * 3072 + h * 128 + 8 * dc) = o;
            } else { const int tk = task - 1024, d = tk >> 3, jc = tk & 7; float sc[8];
#pragma unroll
                for (int e = 0; e < 8; ++e) sc[e] = Rk[8 * jc + e] * __expf(Gl - Gs[8 * jc + e]);
                const v4u v = *(const LAS v4u*)(KT + d * 72 + 8 * jc); v4u o;
                o.x = pk2(bflo(v.x) * sc[0], bfhi(v.x) * sc[1]); o.y = pk2(bflo(v.y) * sc[2], bfhi(v.y) * sc[3]); o.z = pk2(bflo(v.z) * sc[4], bfhi(v.z) * sc[5]); o.w = pk2(bflo(v.w) * sc[6], bfhi(v.w) * sc[7]);
                *(v4u*)(qkv + (R0 + (d >> 1)) * 3072 + 2048 + h * 128 + (d & 1) * 64 + 8 * jc) = o; }
        }
    }
    __syncthreads();
    bf16* uT = (bf16*)(ws + WS_UT) + (size_t)unit * 8192;
    for (int job = wave; job < 64; job += 8) {
        f32x4 acc = {0.f, 0.f, 0.f, 0.f};
        if (job < 32) { const int it = job >> 3, et = job & 7; const LAS bf16* ap = T1 + (16 * it + c) * 72 + 8 * g; const LAS bf16* bp = VT + (16 * et + c) * 72 + 8 * g;
#pragma unroll
            for (int ks = 0; ks < 2; ++ks) acc = MFMA16(*(const LAS bf16x8*)(ap + 32 * ks), *(const LAS bf16x8*)(bp + 32 * ks), acc);
            v2u w; w.x = pk2(acc[0], acc[1]); w.y = pk2(acc[2], acc[3]); *(v2u*)(uT + (16 * et + c) * 64 + 16 * it + 4 * g) = w;
        } else { const int dt = (job - 32) >> 2, it = (job - 32) & 3; const LAS bf16* ap = KT + (16 * dt + c) * 72 + 8 * g; const LAS bf16* bp = T2 + (16 * it + c) * 72 + 8 * g;
#pragma unroll
            for (int ks = 0; ks < 2; ++ks) acc = MFMA16(*(const LAS bf16x8*)(ap + 32 * ks), *(const LAS bf16x8*)(bp + 32 * ks), acc);
            v2u w; w.x = pk2(acc[0], acc[1]); w.y = pk2(acc[2], acc[3]); *(v2u*)(qkv + (R0 + 16 * it + c) * 3072 + 1024 + h * 128 + 16 * dt + 4 * g) = w; }
    }
    __syncthreads();
}

constexpr int SC_W = 0, SC_Q = 17408, SC_K = 34816, SC_A = 53248, SC_U = 62464, SC_BUF = 64768;
struct ScanRegs { v4u w[2], q[2], k[2], a, u; };
DI void scan_load(const unsigned char* ws, ScanRegs& r, int b, int h, int es, int ck, int tid) {
    const size_t R0 = (size_t)b * SEQ + (size_t)ck * 64; const int unit = (b * GH + h) * NCH + ck;
    const bf16* qkv = (const bf16*)(ws + WS_QKV);
#pragma unroll
    for (int k = 0; k < 2; ++k) { const int idx = tid + 512 * k, row = idx >> 4, c16 = idx & 15; const bf16* p = qkv + (R0 + row) * 3072 + h * 128 + 8 * c16;
        r.q[k] = *(const v4u*)p; r.w[k] = *(const v4u*)(p + 1024); r.k[k] = *(const v4u*)(p + 2048); }
    r.a = *(const v4u*)((const bf16*)(ws + WS_AQK) + (size_t)unit * 4096 + (tid >> 3) * 64 + 8 * (tid & 7));
    if (tid < 128) r.u = *(const v4u*)((const bf16*)(ws + WS_UT) + (size_t)unit * 8192 + (16 * es + (tid >> 3)) * 64 + 8 * (tid & 7));
}
DI void scan_store(LAS unsigned char* buf, const ScanRegs& r, int tid) {
#pragma unroll
    for (int k = 0; k < 2; ++k) { const int idx = tid + 512 * k, row = idx >> 4, c16 = idx & 15;
        *(LAS v4u*)((LAS bf16*)(buf + SC_W) + row * 136 + 8 * c16) = r.w[k]; *(LAS v4u*)((LAS bf16*)(buf + SC_Q) + row * 136 + 8 * c16) = r.q[k];
        *(LAS v4u*)((LAS bf16*)(buf + SC_K) + (2 * row + (c16 >> 3)) * 72 + 8 * (c16 & 7)) = r.k[k]; }
    *(LAS v4u*)((LAS bf16*)(buf + SC_A) + (tid >> 3) * 72 + 8 * (tid & 7)) = r.a;
    if (tid < 128) *(LAS v4u*)((LAS bf16*)(buf + SC_U) + (tid >> 3) * 72 + 8 * (tid & 7)) = r.u;
}
DI void scan_chain(const Args& a, LAS unsigned char* lds, int chain, int tid, int wave, int lane) {
    unsigned char* ws = a.ws;
    const int es = chain & 7, h = (chain >> 3) & 7, b = chain >> 6, g = lane >> 4, c = lane & 15;
    const float* glast = (const float*)(ws + MS_GLAST) + (b * GH + h) * NCH;
    bf16* oT = (bf16*)(ws + WS_UT) + (size_t)((b * GH + h) * NCH) * 8192 + (16 * es + c) * 64 + 4 * g;
    ScanRegs R;
    scan_load(ws, R, b, h, es, 0, tid); scan_store(lds, R, tid);
    scan_load(ws, R, b, h, es, 1, tid);
    __syncthreads();
    f32x4 S[8]; bf16x8 Sb[4];
#pragma unroll
    for (int i = 0; i < 8; ++i) S[i] = (f32x4){0.f, 0.f, 0.f, 0.f};
#pragma unroll
    for (int i = 0; i < 4; ++i) Sb[i] = (bf16x8){0, 0, 0, 0, 0, 0, 0, 0};
    for (int ck = 0; ck < NCH; ++ck) {
        LAS unsigned char* cur = lds + (ck & 1) * SC_BUF;
        if (ck + 1 < NCH) scan_store(lds + ((ck + 1) & 1) * SC_BUF, R, tid);
        if (ck + 2 < NCH) scan_load(ws, R, b, h, es, ck + 2, tid);
        if (wave == 0) {
            const LAS bf16* Wl = (const LAS bf16*)(cur + SC_W); const LAS bf16* Ql = (const LAS bf16*)(cur + SC_Q); const LAS bf16* Kl = (const LAS bf16*)(cur + SC_K);
            const LAS bf16* Al = (const LAS bf16*)(cur + SC_A); const LAS bf16* Ul = (const LAS bf16*)(cur + SC_U);
            const float gl = glast[ck];
            f32x4 vn[4];
#pragma unroll
            for (int jt = 0; jt < 4; ++jt) { const v2u uu = *(const LAS v2u*)(Ul + c * 72 + 16 * jt + 4 * g); f32x4 acc = {bflo(uu.x), bfhi(uu.x), bflo(uu.y), bfhi(uu.y)};
#pragma unroll
                for (int s = 0; s < 4; ++s) { const LAS bf16* p = Wl + (16 * jt + c) * 136 + 32 * s + 4 * g; acc = MFMA16(mk8(*(const LAS v2u*)p, *(const LAS v2u*)(p + 16)), Sb[s], acc); }
                vn[jt] = acc; }
            bf16x8 vb[2]; vb[0] = pack_acc2(vn[0], vn[1]); vb[1] = pack_acc2(vn[2], vn[3]);
#pragma unroll
            for (int jt = 0; jt < 4; ++jt) { f32x4 acc = {0.f, 0.f, 0.f, 0.f};
#pragma unroll
                for (int s = 0; s < 4; ++s) { const LAS bf16* p = Ql + (16 * jt + c) * 136 + 32 * s + 4 * g; acc = MFMA16(mk8(*(const LAS v2u*)p, *(const LAS v2u*)(p + 16)), Sb[s], acc); }
#pragma unroll
                for (int s = 0; s < 2; ++s) { const LAS bf16* p = Al + (16 * jt + c) * 72 + 32 * s + 4 * g; acc = MFMA16(mk8(*(const LAS v2u*)p, *(const LAS v2u*)(p + 16)), vb[s], acc); }
                v2u w; w.x = pk2(acc[0], acc[1]); w.y = pk2(acc[2], acc[3]); *(v2u*)(oT + (size_t)ck * 8192 + 16 * jt) = w; }
#pragma unroll
            for (int dt = 0; dt < 8; ++dt) { f32x4 acc = S[dt] * gl;
#pragma unroll
                for (int s = 0; s < 2; ++s) { const LAS bf16* p = Kl + (16 * dt + c) * 72 + 32 * s + 4 * g; acc = MFMA16(mk8(*(const LAS v2u*)p, *(const LAS v2u*)(p + 16)), vb[s], acc); }
                S[dt] = acc; }
#pragma unroll
            for (int s = 0; s < 4; ++s) Sb[s] = pack_acc2(S[2 * s], S[2 * s + 1]);
        }
        __syncthreads();
    }
}

DI void onorm_unit(const Args& a, LAS float* red  , int unit, int it, int wave, int lane) {
    unsigned char* ws = a.ws;
    const int ck = unit & 255, h = (unit >> 8) & 7, b = unit >> 11; const size_t row = (size_t)b * SEQ + (size_t)ck * 64 + lane;
    const bf16* oT = (const bf16*)(ws + WS_UT) + (size_t)unit * 8192 + (16 * wave) * 64 + lane;
    float v[16]; float ss = 0.f;
#pragma unroll
    for (int k = 0; k < 16; ++k) { v[k] = bf2f(oT[k * 64]); ss += v[k] * v[k]; }
    LAS float* rb = red + (it & 1) * 512; rb[wave * 64 + lane] = ss;
    const bf16* gp = (const bf16*)(ws + WS_GATE) + row * D + h * 128 + 16 * wave; const v4u g0 = *(const v4u*)gp, g1 = *(const v4u*)(gp + 8);
    __syncthreads();
    float tot = 0.f;
#pragma unroll
    for (int w = 0; w < 8; ++w) tot += rb[w * 64 + lane];
    const float rs = __builtin_amdgcn_rsqf(tot * (1.0f / 128.0f) + EPS);
    const unsigned gw[8] = {g0.x, g0.y, g0.z, g0.w, g1.x, g1.y, g1.z, g1.w}; unsigned o[8];
    const float* on = a.in[I_ONORM] + 16 * wave;
#pragma unroll
    for (int k = 0; k < 8; ++k) { const float ga = bflo(gw[k]), gb = bfhi(gw[k]); o[k] = pk2(v[2 * k] * rs * on[2 * k] * silu_f(ga), v[2 * k + 1] * rs * on[2 * k + 1] * silu_f(gb)); }
    bf16* op = (bf16*)(ws + WS_ON) + row * D + h * 128 + 16 * wave;
    v4u w0, w1; w0.x = o[0]; w0.y = o[1]; w0.z = o[2]; w0.w = o[3]; w1.x = o[4]; w1.y = o[5]; w1.z = o[6]; w1.w = o[7]; *(v4u*)op = w0; *(v4u*)(op + 8) = w1;
}

DI void route_unit(const Args& a, LAS int* esel, int unit, int wave, int lane) {
    unsigned char* ws = a.ws;
    const float* rt = (const float*)(ws + MS_ROUT);
    f32x4 rr[4][4][2];
#pragma unroll
    for (int j = 0; j < 4; ++j)
#pragma unroll
        for (int i = 0; i < 4; ++i) { const f32x4* p = (const f32x4*)(rt + (size_t)(4 * (64 * j + lane) + i) * 8); rr[j][i][0] = p[0]; rr[j][i][1] = p[1]; }
    for (int tl = 16 * wave; tl < 16 * wave + 16; ++tl) {
        const int tok = unit * 128 + tl;
        const f32x4* xr = (const f32x4*)(a.out + (size_t)tok * D) + lane;
        float acc[8] = {0.f, 0.f, 0.f, 0.f, 0.f, 0.f, 0.f, 0.f};
#pragma unroll
        for (int j = 0; j < 4; ++j) { const f32x4 x = xr[64 * j];
#pragma unroll
            for (int i = 0; i < 4; ++i)
#pragma unroll
                for (int e = 0; e < 8; ++e) acc[e] += x[i] * rr[j][i][e >> 2][e & 3]; }
#pragma unroll
        for (int e = 0; e < 8; ++e) acc[e] = wave_sum(acc[e]);
        const float rs = pg8::rstd16((const float*)(ws + WS_STB), tok);
        int e1 = 0; float l1 = acc[0];
#pragma unroll
        for (int e = 1; e < 8; ++e) if (acc[e] > l1) { l1 = acc[e]; e1 = e; }
        int e2 = -1; float l2 = -3.0e38f;
#pragma unroll
        for (int e = 0; e < 8; ++e) if (e != e1 && acc[e] > l2) { l2 = acc[e]; e2 = e; }
        const float w1 = __builtin_amdgcn_rcpf(1.0f + __expf((l2 - l1) * rs));
        if (lane == 0) { ((int*)(ws + MS_TOKE))[tok] = e1 | (e2 << 8); ((float*)(ws + MS_TOKW))[2 * tok] = w1; ((float*)(ws + MS_TOKW))[2 * tok + 1] = 1.0f - w1; esel[2 * tl] = e1; esel[2 * tl + 1] = e2; }
    }
    __syncthreads();
    { int base = 0;
      for (int i = 0; i < 4; ++i) { const bool m = esel[64 * i + lane] == wave; const unsigned long long mask = __ballot(m);
          if (m) ((int*)(ws + MS_RANK))[unit * 256 + 64 * i + lane] = base + __popcll(mask & ((1ull << lane) - 1ull)); base += __popcll(mask); }
      if (lane == 0) ((int*)(ws + MS_CNT))[unit * 8 + wave] = base; }
    __syncthreads();
}

DI void gather_unit(const Args& a, LAS int* sm  , int unit, int tid, int wave, int lane) {
    unsigned char* ws = a.ws;
    const int* cnt = (const int*)(ws + MS_CNT);
    if (tid < 8) { int tot = 0, off = 0; for (int u = 0; u < 256; ++u) { const int v = cnt[u * 8 + tid]; tot += v; if (u < unit) off += v; } sm[tid] = tot; sm[8 + tid] = off; }
    __syncthreads();
    if (tid == 0) { int s = 0; for (int e = 0; e < 8; ++e) { sm[16 + e] = s; s += ((sm[e] + 255) >> 8) << 8; } sm[24] = s;
        if (unit == 0) { int* te = (int*)(ws + MS_TILEE); for (int e = 0; e < 8; ++e) for (int t = sm[16 + e] >> 8; t < (sm[16 + e + 1] >> 8); ++t) te[t] = e; te[MAXTILES] = s >> 8; } }
    __syncthreads();
    const bf16* hb3 = (const bf16*)(ws + WS_HB3); bf16* xg = (bf16*)(ws + WS_XG); float* rg = (float*)(ws + MS_RG);
    for (int s = 32 * wave; s < 32 * wave + 32; ++s) {
        const int tok = unit * 128 + (s >> 1), k = s & 1; const int e = (((const int*)(ws + MS_TOKE))[tok] >> (8 * k)) & 0xff;
        const int dest = sm[16 + e] + sm[8 + e] + ((const int*)(ws + MS_RANK))[unit * 256 + s];
        if (lane == 0) { ((int*)(ws + MS_DEST))[2 * tok + k] = dest; rg[dest] = pg8::rstd16((const float*)(ws + WS_STB), tok); }
        const v4u* src = (const v4u*)(hb3 + (size_t)tok * D) + lane; v4u* dst = (v4u*)(xg + (size_t)dest * D) + lane;
        dst[0] = src[0]; dst[64] = src[64];
    }
    if (unit < 8) {
        const int e = unit, r0 = sm[16 + e] + sm[e], r1 = sm[16 + e + 1]; const v4u z = {0u, 0u, 0u, 0u};
        for (int r = r0 + wave; r < r1; r += 8) { v4u* dst = (v4u*)(xg + (size_t)r * D) + lane; dst[0] = z; dst[64] = z; if (lane == 0) rg[r] = 0.f; }
    }
    __syncthreads();
}

DI void combine_row(const Args& a, int tok, int lane) {
    unsigned char* ws = a.ws;
    const int d1 = ((const int*)(ws + MS_DEST))[2 * tok], d2 = ((const int*)(ws + MS_DEST))[2 * tok + 1];
    const float w1 = ((const float*)(ws + MS_TOKW))[2 * tok], w2 = ((const float*)(ws + MS_TOKW))[2 * tok + 1];
    const bf16* y = (const bf16*)(ws + WS_XG);
    f32x4* o = (f32x4*)(a.out + (size_t)tok * D) + 4 * lane;
    const v4u* y1 = (const v4u*)(y + (size_t)d1 * D) + 2 * lane; const v4u* y2 = (const v4u*)(y + (size_t)d2 * D) + 2 * lane;
#pragma unroll
    for (int q = 0; q < 2; ++q) { const v4u p1 = y1[q], p2 = y2[q]; const unsigned a1[4] = {p1.x, p1.y, p1.z, p1.w}, a2[4] = {p2.x, p2.y, p2.z, p2.w};
#pragma unroll
        for (int e = 0; e < 2; ++e) { f32x4 v = o[2 * q + e];
            v[0] += w1 * bflo(a1[2 * e]) + w2 * bflo(a2[2 * e]); v[1] += w1 * bfhi(a1[2 * e]) + w2 * bfhi(a2[2 * e]);
            v[2] += w1 * bflo(a1[2 * e + 1]) + w2 * bflo(a2[2 * e + 1]); v[3] += w1 * bfhi(a1[2 * e + 1]) + w2 * bfhi(a2[2 * e + 1]); o[2 * q + e] = v; } }
}
constexpr int NPHASE = 23;
#ifndef MK_SUB
#define MK_SUB 3
#endif
#ifndef MK_ONE_LAUNCH
#define MK_ONE_LAUNCH 1
#endif
template <int P> DI void moe_pass(const Args& args, LAS unsigned char* lds, int G, int which  ) {
    unsigned char* ws = args.ws;
    const int* te = (const int*)(ws + MS_TILEE); const int ntiles = te[MAXTILES];
    const int lo = PASS_TILES * P, hi = (P == 3) ? ntiles : (ntiles < PASS_TILES * (P + 1) ? ntiles : PASS_TILES * (P + 1));
    if (lo >= hi) return;
    if (which == 0) {
        pg8::Gemm g{(const bf16*)(ws + WS_XG), (const bf16*)(ws + WS_WMGU), MAXTILES * 256, 2 * FFE, D};
        pg8::MoeOrder S{lo, hi, 2 * FFE / 256, G, (int)blockIdx.x, te};
        pg8::EpiSwiGLU<true> E{(bf16*)(ws + WS_ACT), FFE, (const float*)(ws + MS_RG), 2 * FFE / 256, lo};
        pg8::gemm_phase<pg8::EpiSwiGLU<true>, pg8::MoeOrder, true, true>(lds, g, S, E);
    } else {
        pg8::Gemm g{(const bf16*)(ws + WS_ACT) - (size_t)lo * 256 * FFE, (const bf16*)(ws + WS_WMD), MAXTILES * 256, D, FFE};
        pg8::MoeOrder S{lo, hi, D / 256, G, (int)blockIdx.x, te};
        pg8::EpiPlain E{(bf16*)(ws + WS_XG)};
        pg8::gemm_phase<pg8::EpiPlain, pg8::MoeOrder, true, true>(lds, g, S, E);
    }
}

__global__ void __launch_bounds__(NTHREADS, 2) fwd(Args args) {
    extern __shared__ __attribute__((aligned(16))) unsigned char lds_raw[];
    LAS unsigned char* lds = (LAS unsigned char*)lds_raw;
    volatile LAS unsigned* MISC = (volatile LAS unsigned*)(lds + MISC_OFF);
    const int tid = threadIdx.x, lane = tid & 63, wave = __builtin_amdgcn_readfirstlane(tid >> 6);
    const int G = gridDim.x, bx = blockIdx.x;
    const int vcu = (G % 8 == 0) ? (bx % 8) * (G / 8) + bx / 8 : bx;
    const int gw = vcu * NWAVES + wave, NGW = G * NWAVES;
    unsigned char* ws = args.ws;
    gu32* ctl = (gu32*)(ws + WS_CTL);
    for (int u = tid; u < (LDS_BYTES - LDSCTL_OFF) / 4; u += NTHREADS) ((LAS unsigned*)(lds + LDSCTL_OFF))[u] = 0u;
    __syncthreads();
    const int lo = args.ph_lo, hi = args.ph_hi;
    XcdBarrier bar; bar.bar = (unsigned*)(ctl + CW_BAR); bar.x = 0; bar.st = nullptr;
    if (hi - lo > 1) bar = xcd_barrier_post((unsigned*)(ctl + CW_BAR), MISC + 8);
#ifndef MK_PHMASK
#define MK_PHMASK 0x7fffffu
#endif
#define IN(k) ((((MK_PHMASK) >> (k)) & 1u) && lo <= (k) && (k) < hi)
#define SEAM(k) do { if (IN(k) && IN((k) + 1)) xcd_barrier(bar); } while (0)

    if (IN(0)) { phase_prologue(args, lds, gw, NGW, wave, lane); __syncthreads(); } SEAM(0);

    if (IN(1)) {
        pg8::Gemm g{(const bf16*)(ws + WS_HB), (const bf16*)(ws + W0_IN), T, E_IN, D}; pg8::StaticOrder S; S.init(T, E_IN, G, bx);
        pg8::EpiProj<0> E{(bf16*)(ws + WS_PROJ0), E_IN, (const float*)(ws + WS_STA), nullptr, nullptr};
        pg8::gemm_phase<pg8::EpiProj<0>, pg8::StaticOrder, true, true>(lds, g, S, E);
    } SEAM(1);

    if (IN(2)) {
        if (MK_SUB & 1) { LruFrags LF; lru_frags(args, lds, LF, wave, lane); __syncthreads(); for (int u = vcu; u < NB * 128; u += G) lru_unit(args, lds, LF, u, wave, lane); }
        __syncthreads();
        if (MK_SUB & 2) for (int u = vcu; u < NB * 128 * 2; u += G) attn_unit(args, lds, u, tid, wave, lane);
    } SEAM(2);

    if (IN(3)) { for (int u = vcu; u < NB * 128; u += G) lrufix_unit(args, u, tid); } SEAM(3);

    if (IN(4)) {
        pg8::Gemm g{(const bf16*)(ws + WS_YMIX), (const bf16*)(ws + W0_OUT), T, D, D}; pg8::StaticOrder S; S.init(T, D, G, bx);
        pg8::EpiResid E{args.in[I_X], args.out, (bf16*)(ws + WS_HB), (float*)(ws + WS_STB)};
        pg8::gemm_phase<pg8::EpiResid, pg8::StaticOrder, true, true>(lds, g, S, E);
    } SEAM(4);

    if (IN(5)) {
        pg8::Gemm g{(const bf16*)(ws + WS_HB), (const bf16*)(ws + W0_GU), T, 2 * FF0, D}; pg8::StaticOrder S; S.init(T, 2 * FF0, G, bx);
        pg8::EpiSwiGLU<false> E{(bf16*)(ws + WS_ACT0), FF0, (const float*)(ws + WS_STB), 0, 0};
        pg8::gemm_phase<pg8::EpiSwiGLU<false>, pg8::StaticOrder, true, true>(lds, g, S, E);
    } SEAM(5);

    if (IN(6)) {
        pg8::Gemm g{(const bf16*)(ws + WS_ACT0), (const bf16*)(ws + W0_DN), T, D, FF0}; pg8::StaticOrder S; S.init(T, D, G, bx);
        pg8::EpiResid E{args.out, args.out, (bf16*)(ws + WS_HB), (float*)(ws + WS_STA)};
        pg8::gemm_phase<pg8::EpiResid, pg8::StaticOrder, true, true>(lds, g, S, E);
    } SEAM(6);

    if (IN(7)) {
        pg8::Gemm g{(const bf16*)(ws + WS_HB), (const bf16*)(ws + W1_IN), T, 4096, D}; pg8::StaticOrder S; S.init(T, 4096, G, bx);
        pg8::EpiProj<1> E{(bf16*)(ws + WS_QKV), 3072, (const float*)(ws + WS_STA), (bf16*)(ws + WS_GATE), (bf16*)(ws + WS_HALO)};
        pg8::gemm_phase<pg8::EpiProj<1>, pg8::StaticOrder, true, true>(lds, g, S, E);
        for (int t = gw; t < T / 16; t += NGW) skinny_tile(args, t, lane);
    } SEAM(7);

    if (IN(8)) { for (int u = vcu; u < NUNIT; u += G) prep_unit(args, lds, u, tid, wave, lane); } SEAM(8);

    if (IN(9)) {
        const int li = vcu & 31, xq = vcu >> 5;
        if (G == 256 && li < 16) scan_chain(args, lds, (2 * xq + (li >> 3)) * 8 + (li & 7), tid, wave, lane);
        else if (G == 256) { const int wk = (xq * 16 + (li - 16)) * NWAVES + wave; LAS float* scr = (LAS float*)(lds + wave * 16384);
            for (int it = wk; it < MOE_D_ITEMS; it += 128 * NWAVES) cvt_moe_down(args, it, scr, lane); }
        else { for (int ch = vcu; ch < 128; ch += G) scan_chain(args, lds, ch, tid, wave, lane);
            LAS float* scr = (LAS float*)(lds + wave * 16384); for (int it = gw; it < MOE_D_ITEMS; it += NGW) cvt_moe_down(args, it, scr, lane); }
    } SEAM(9);

    if (IN(10)) {
        LAS float* red = (LAS float*)lds; int it = 0;
        for (int u = vcu; u < NUNIT; u += G, ++it) onorm_unit(args, red, u, it, wave, lane);
        __syncthreads();
        LAS float* scr = (LAS float*)(lds + wave * 16384);
        for (int i = gw; i < MOE_GU_ITEMS; i += NGW) cvt_moe_gu(args, i, scr, lane);
        __syncthreads();
    } SEAM(10);

    if (IN(11)) {
        pg8::Gemm g{(const bf16*)(ws + WS_ON), (const bf16*)(ws + W1_OUT), T, D, D}; pg8::StaticOrder S; S.init(T, D, G, bx);
        pg8::EpiResid E{args.out, args.out, (bf16*)(ws + WS_HB3), (float*)(ws + WS_STB)};
        pg8::gemm_phase<pg8::EpiResid, pg8::StaticOrder, true, true>(lds, g, S, E);
    } SEAM(11);

    if (IN(12)) { for (int u = vcu; u < 256; u += G) route_unit(args, (LAS int*)lds, u, wave, lane); } SEAM(12);
    if (IN(13)) { for (int u = vcu; u < 256; u += G) gather_unit(args, (LAS int*)lds, u, tid, wave, lane); } SEAM(13);

    if (IN(14)) moe_pass<0>(args, lds, G, 0); SEAM(14);
    if (IN(15)) moe_pass<0>(args, lds, G, 1); SEAM(15);
    if (IN(16)) moe_pass<1>(args, lds, G, 0); SEAM(16);
    if (IN(17)) moe_pass<1>(args, lds, G, 1); SEAM(17);
    if (IN(18)) moe_pass<2>(args, lds, G, 0); SEAM(18);
    if (IN(19)) moe_pass<2>(args, lds, G, 1); SEAM(19);
    if (IN(20)) moe_pass<3>(args, lds, G, 0); SEAM(20);
    if (IN(21)) moe_pass<3>(args, lds, G, 1); SEAM(21);

    if (IN(22)) { for (int t = gw; t < T; t += NGW) combine_row(args, t, lane); }
#undef IN
#undef SEAM
}

extern "C" void kernel_launch(void* const* d_in, const int* in_sizes, int n_in, void* d_out, int out_size, void* d_ws, size_t ws_size, hipStream_t stream) {
    static int grid = 0;
    if (grid == 0) {
        if (n_in != 28 || out_size != T * D || ws_size < WS_END) { fprintf(stderr, "kernel_launch: unexpected problem (n_in %d, out %d, ws %zu)\n", n_in, out_size, ws_size); grid = -1; return; }
        int dev = 0, cus = 0, per_cu = 0;
        if (hipGetDevice(&dev) != hipSuccess || hipDeviceGetAttribute(&cus, hipDeviceAttributeMultiprocessorCount, dev) != hipSuccess) { grid = -1; return; }
        if (hipFuncSetAttribute((const void*)fwd, hipFuncAttributeMaxDynamicSharedMemorySize, LDS_BYTES) != hipSuccess) { fprintf(stderr, "kernel_launch: hipFuncSetAttribute failed\n"); grid = -1; return; }
        if (hipOccupancyMaxActiveBlocksPerMultiprocessor(&per_cu, (const void*)fwd, NTHREADS, LDS_BYTES) != hipSuccess || per_cu < 1) fprintf(stderr, "kernel_launch: occupancy query says %d\n", per_cu);
        (void)hipGetLastError();
        grid = cus;
    }
    if (grid < 0) return;
    if (hipMemsetAsync((char*)d_ws + WS_CTL, 0, CTL_ZERO_BYTES, stream) != hipSuccess) return;
    Args a{};
    for (int i = 0; i < 28; ++i) a.in[i] = (const float*)d_in[i];
    a.out = (float*)d_out; a.ws = (unsigned char*)d_ws;
#if MK_ONE_LAUNCH
    a.ph_lo = 0; a.ph_hi = NPHASE;
    hipLaunchKernelGGL(fwd, dim3(grid), dim3(NTHREADS), LDS_BYTES, stream, a);
#else
    for (int p = 0; p < NPHASE; ++p) { a.ph_lo = p; a.ph_hi = p + 1; hipLaunchKernelGGL(fwd, dim3(grid), dim3(NTHREADS), LDS_BYTES, stream, a); }
#endif
}
```

```cpp
#include <hip/hip_runtime.h>
#include <cstdio>
#include <cstdint>
#include <cmath>
namespace pg8 {
#define PG8_LAS __attribute__((address_space(3)))
typedef unsigned short bf16_t;
typedef short bf16x8 __attribute__((ext_vector_type(8)));
typedef float f32x4 __attribute__((ext_vector_type(4)));
typedef unsigned u32x4 __attribute__((ext_vector_type(4)));
constexpr int BM = 256, BK = 64, HALF = 128, HTB = HALF * BK * 2  , STAGE_BYTES = 8 * HTB, NXCD = 8, WGM = 8;

__host__ __device__ __forceinline__ int lds_byte(int r, int c) { const int st = (r >> 4) * 2 + (c >> 5), rr = r & 15, cc = c & 31, ob = rr * 64 + cc * 2; return st * 1024 + (ob ^ (((ob >> 9) & 1) << 5)); }
__host__ __device__ __forceinline__ void stage_rc(int b, int& R, int& C) { const int st = b / 1024, sb = b % 1024, swz = sb ^ (((sb >> 9) & 1) << 5); R = (st >> 1) * 16 + swz / 64; C = (st & 1) * 32 + (swz % 64) / 2; }
__host__ __device__ __forceinline__ int perm32(int rho) { const int n = rho >> 4, i = rho & 15; return 8 * (i >> 2) + 4 * n + (i & 3); }

struct Unit { int pm, pn; };
struct Gemm { const bf16_t* A; const bf16_t* Bt; int M, N, K; };

struct StaticOrder {
    int nM, nN, nwg, G, c;
    __host__ __device__ void init(int M, int N, int G_, int c_) { nM = M / BM; nN = N / BM; nwg = nM * nN; G = G_; c = c_; }
    __host__ __device__ bool next(int i, Unit& u) const {
        const long L = (long)i * G + c; if (L >= nwg) return false;
        int wgid = (int)L; { const int q = nwg / NXCD, r = nwg % NXCD, xcd = wgid % NXCD, off = wgid / NXCD; wgid = (xcd < r ? xcd * (q + 1) : r * (q + 1) + (xcd - r) * q) + off; }
        const int nig = WGM * nN, gid = wgid / nig, fm = gid * WGM, gsz = (nM - fm) < WGM ? (nM - fm) : WGM;
        u.pm = fm + ((wgid % nig) % gsz); u.pn = (wgid % nig) / gsz; return true;
    }
    __device__ __forceinline__ void a_ready(const Unit&) const {}
    __device__ __forceinline__ void done(const Unit&) const {}
};

__device__ __forceinline__ unsigned cvt_pk_bf16(float lo, float hi) { unsigned r; asm volatile("v_cvt_pk_bf16_f32 %0, %1, %2" : "=v"(r) : "v"(lo), "v"(hi)); return r; }
typedef float f32x2 __attribute__((ext_vector_type(2)));
__device__ __forceinline__ float rstd16(const float* st, int row) {
    const f32x4* p = (const f32x4*)(st + (size_t)row * 16); const f32x4 a = p[0], b = p[1], c = p[2], d = p[3];
    const float s = ((a[0] + a[1]) + (a[2] + a[3])) + ((b[0] + b[1]) + (b[2] + b[3])) + ((c[0] + c[1]) + (c[2] + c[3])) + ((d[0] + d[1]) + (d[2] + d[3]));
    return __builtin_amdgcn_rsqf(s * (1.0f / 1024.0f) + 1e-6f);
}
__device__ __forceinline__ u32x4 pack8(const f32x4 v0, const f32x4 v1) { u32x4 w; w.x = cvt_pk_bf16(v0[0], v0[1]); w.y = cvt_pk_bf16(v0[2], v0[3]); w.z = cvt_pk_bf16(v1[0], v1[1]); w.w = cvt_pk_bf16(v1[2], v1[3]); return w; }
__device__ __forceinline__ float silu_f(float x) { return x * __builtin_amdgcn_rcpf(1.0f + __expf(-x)); }

template <int MODE> struct EpiProj {
    static constexpr bool PERM = true, AFTER_DRAIN = false;
    bf16_t* O; int ldo; const float* stats; bf16_t* gate; bf16_t* halo;
    __device__ __forceinline__ void operator()(const f32x4 (&acc)[2][2][4][2], const Unit& u, int wr, int wc, int fr, int fq) const {
        const int row0 = u.pm * BM + wr * 64 + fr, col0 = u.pn * BM + wc * 32 + 8 * fq;
#pragma unroll
        for (int ai = 0; ai < 2; ++ai)
#pragma unroll
            for (int m = 0; m < 4; ++m) { const int row = row0 + ai * HALF + m * 16; const float rs = stats[row];
#pragma unroll
                for (int bj = 0; bj < 2; ++bj) { const int col = col0 + bj * HALF; const u32x4 w = pack8(acc[ai][bj][m][0] * rs, acc[ai][bj][m][1] * rs);
                    if (MODE == 0) { *(u32x4*)(O + (size_t)row * ldo + col) = w; }
                    else { if (col < 3072) { *(u32x4*)(O + (size_t)row * 3072 + col) = w; const int t = row & 63; if (t >= 61) *(u32x4*)(halo + ((size_t)(row >> 6) * 3 + (t - 61)) * 3072 + col) = w; }
                           else *(u32x4*)(gate + (size_t)row * 1024 + (col - 3072)) = w; } } }
    }
};
struct EpiResid {
    static constexpr bool PERM = true, AFTER_DRAIN = false;
    bf16_t* hb; float* stats;
    __device__ __forceinline__ void operator()(const f32x4 (&acc)[2][2][4][2], const Unit& u, int wr, int wc, int fr, int fq) const {
        const int row0 = u.pm * BM + wr * 64 + fr, col0 = u.pn * BM + wc * 32 + 8 * fq;
#pragma unroll
        for (int ai = 0; ai < 2; ++ai)
#pragma unroll
            for (int m = 0; m < 4; ++m) { const int row = row0 + ai * HALF + m * 16; float ss = 0.f;
#pragma unroll
                for (int bj = 0; bj < 2; ++bj) { const size_t off = (size_t)row * 1024 + col0 + bj * HALF;
                    const u32x4 r = *(const u32x4*)(hb + off);
                    const f32x4 r0 = {__builtin_bit_cast(float, r.x << 16), __builtin_bit_cast(float, r.x & 0xffff0000u), __builtin_bit_cast(float, r.y << 16), __builtin_bit_cast(float, r.y & 0xffff0000u)};
                    const f32x4 r1 = {__builtin_bit_cast(float, r.z << 16), __builtin_bit_cast(float, r.z & 0xffff0000u), __builtin_bit_cast(float, r.w << 16), __builtin_bit_cast(float, r.w & 0xffff0000u)};
                    const f32x4 v0 = acc[ai][bj][m][0] + r0, v1 = acc[ai][bj][m][1] + r1;
                    *(u32x4*)(hb + off) = pack8(v0, v1);
                    ss += ((v0[0] * v0[0] + v0[1] * v0[1]) + (v0[2] * v0[2] + v0[3] * v0[3])) + ((v1[0] * v1[0] + v1[1] * v1[1]) + (v1[2] * v1[2] + v1[3] * v1[3])); }
                ss += __shfl_xor(ss, 16); ss += __shfl_xor(ss, 32);
                if (fq == 0) stats[(size_t)row * 16 + (u.pn & 3) * 4 + wc] = ss; }
    }
};
template <bool MOE> struct EpiSwiGLU {
    static constexpr bool PERM = true, AFTER_DRAIN = false;
    bf16_t* O; int ldo; const float* stats; int ntn, pm_lo;
    __device__ __forceinline__ void operator()(const f32x4 (&acc)[2][2][4][2], const Unit& u, int wr, int wc, int fr, int fq) const {
        const int pnl = MOE ? (u.pn % ntn) : u.pn;
        const int row0 = u.pm * BM + wr * 64 + fr, col = pnl * HALF + wc * 32 + 8 * fq;
#pragma unroll
        for (int ai = 0; ai < 2; ++ai)
#pragma unroll
            for (int m = 0; m < 4; ++m) { const int row = row0 + ai * HALF + m * 16; const float rs = stats[row];
                const f32x4 g0 = acc[ai][0][m][0] * rs, g1 = acc[ai][0][m][1] * rs, u0 = acc[ai][1][m][0] * rs, u1 = acc[ai][1][m][1] * rs; f32x4 a0, a1;
#pragma unroll
                for (int i = 0; i < 4; ++i) { a0[i] = silu_f(g0[i]) * u0[i]; a1[i] = silu_f(g1[i]) * u1[i]; }
                *(u32x4*)(O + (size_t)(row - pm_lo * BM) * ldo + col) = pack8(a0, a1); }
    }
};
struct EpiPlain {
    static constexpr bool PERM = true, AFTER_DRAIN = false;
    bf16_t* O;
    __device__ __forceinline__ void operator()(const f32x4 (&acc)[2][2][4][2], const Unit& u, int wr, int wc, int fr, int fq) const {
        const int row0 = u.pm * BM + wr * 64 + fr, col0 = (u.pn & 3) * BM + wc * 32 + 8 * fq;
#pragma unroll
        for (int ai = 0; ai < 2; ++ai)
#pragma unroll
            for (int m = 0; m < 4; ++m) { const int row = row0 + ai * HALF + m * 16;
#pragma unroll
                for (int bj = 0; bj < 2; ++bj) *(u32x4*)(O + (size_t)row * 1024 + col0 + bj * HALF) = pack8(acc[ai][bj][m][0], acc[ai][bj][m][1]); }
    }
};
template <class Sched> __device__ __forceinline__ void rstd_prepass(const Sched& S, const float* st, float* rc) {
    Unit u; const int tid = threadIdx.x;
    for (int i = 0; S.next(i, u); ++i) { const int row = u.pm * BM + (tid >> 1); const f32x4* p = (const f32x4*)(st + (size_t)row * 16) + 2 * (tid & 1); const f32x4 a = p[0], b = p[1];
        float s = ((a[0] + a[1]) + (a[2] + a[3])) + ((b[0] + b[1]) + (b[2] + b[3])); s += __shfl_xor(s, 1);
        if ((tid & 1) == 0) rc[row] = __builtin_amdgcn_rsqf(s * (1.0f / 1024.0f) + 1e-6f); }
    asm volatile("s_waitcnt vmcnt(0)" ::: "memory"); __syncthreads();
}
struct GroupOrder {
    int nM, nN, G, c;
    __device__ __forceinline__ void init(int M, int N, int G_, int c_) { nM = M / BM; nN = N / BM; G = G_; c = c_; }
    __device__ __forceinline__ bool next(int i, Unit& u) const {
        const long L = (long)i * G + c; if (L >= (long)nM * nN) return false;
        const int grp = (int)(L / (8 * nN)), fm = grp * 8, gsz = (nM - fm) < 8 ? (nM - fm) : 8, w = (int)(L - (long)grp * 8 * nN);
        u.pm = fm + (w % gsz); u.pn = w / gsz; return true;
    }
    __device__ __forceinline__ void a_ready(const Unit&) const {}
    __device__ __forceinline__ void done(const Unit&) const {}
};
struct MoeOrder {
    int lo, hi, NT, G, c; const int* tile_e;
    __device__ __forceinline__ bool next(int i, Unit& u) const {
        const long L = (long)i * G + c; const int nt = hi - lo; if (L >= (long)nt * NT) return false;
        const int grp = (int)(L / (8 * NT)), fm = grp * 8, gsz = (nt - fm) < 8 ? (nt - fm) : 8, w = (int)(L - (long)grp * 8 * NT), rt = lo + fm + (w % gsz);
        u.pm = rt; u.pn = tile_e[rt] * NT + (w / gsz); return true;
    }
    __device__ __forceinline__ void a_ready(const Unit&) const {}
    __device__ __forceinline__ void done(const Unit&) const {}
};
template <class Epi, class Sched, bool ALIGN_EPI = false, bool SP2 = false>
__device__ __forceinline__ void gemm_phase(PG8_LAS unsigned char* lds, const Gemm g, const Sched& S, const Epi& E) {
    const int tid = threadIdx.x, wid = __builtin_amdgcn_readfirstlane(tid >> 6), lane = tid & 63, wr = wid >> 2, wc = wid & 3, fr = lane & 15, fq = lane >> 4;
    const int K = g.K, nt = K / BK;
    unsigned voffA[2], voffB[2];
#pragma unroll
    for (int i = 0; i < 2; ++i) { int R, C; stage_rc(tid * 16 + i * 8192, R, C); const int Rb = Epi::PERM ? ((R & ~31) + perm32(R & 31)) : R;
        voffA[i] = (unsigned)(R * K + C) * 2u; voffB[i] = (unsigned)(Rb * K + C) * 2u; }
    const size_t kstep = (size_t)(BK * 2);
    const size_t hstep = (size_t)HALF * K * 2;
    const size_t tstep = 2 * hstep;
    const unsigned ldsw = (unsigned)wid * 1024u;
    const int aoff = lds_byte(wr * 64 + fr, fq * 8), boff = lds_byte(wc * 32 + fr, fq * 8);
#define PG8_SA(b, h) (((b) * 2 + (h)) * HTB)
#define PG8_SB(b, h) ((4 + (b) * 2 + (h)) * HTB)
#define PG8_STAGE(bufoff, gbase, voff) do { _Pragma("unroll") for (int _i = 0; _i < 2; ++_i) \
        __builtin_amdgcn_global_load_lds((const unsigned*)((const char*)(gbase) + (voff)[_i]), (PG8_LAS unsigned*)(lds + (bufoff) + ldsw + _i * 8192), 16, 0, 0); } while (0)
#define PG8_LDA(dst, b, h) do { _Pragma("unroll") for (int m = 0; m < 4; ++m) _Pragma("unroll") for (int k = 0; k < 2; ++k) dst[m][k] = *(const PG8_LAS bf16x8*)(lds + PG8_SA(b, h) + aoff + m * 2048 + k * 1024); } while (0)
#define PG8_LDB(dst, b, h) do { _Pragma("unroll") for (int n = 0; n < 2; ++n) _Pragma("unroll") for (int k = 0; k < 2; ++k) dst[n][k] = *(const PG8_LAS bf16x8*)(lds + PG8_SB(b, h) + boff + n * 2048 + k * 1024); } while (0)
#define PG8_MMA(ai, bj, At, Bt) do { __builtin_amdgcn_s_setprio(1); _Pragma("unroll") for (int m = 0; m < 4; ++m) _Pragma("unroll") for (int n = 0; n < 2; ++n) _Pragma("unroll") for (int k = 0; k < 2; ++k) \
        acc[ai][bj][m][n] = __builtin_amdgcn_mfma_f32_16x16x32_bf16(Bt[n][k], At[m][k], acc[ai][bj][m][n], 0, 0, 0); __builtin_amdgcn_s_setprio(0); } while (0)
#define PG8_WAIT_V(n) asm volatile("s_waitcnt vmcnt(" #n ")" ::: "memory")
#define PG8_WAIT_L(n) asm volatile("s_waitcnt lgkmcnt(" #n ")" ::: "memory")
#define PG8_BAR __builtin_amdgcn_s_barrier()
#define PG8_SCHED __builtin_amdgcn_sched_barrier(0)
    Unit cur, nxt; int ui = 0;
    if (!S.next(0, cur)) return;
    f32x4 acc[2][2][4][2];
#pragma unroll
    for (int a = 0; a < 2; ++a)
#pragma unroll
        for (int b = 0; b < 2; ++b)
#pragma unroll
            for (int m = 0; m < 4; ++m)
#pragma unroll
                for (int n = 0; n < 2; ++n) acc[a][b][m][n] = (f32x4){0.f, 0.f, 0.f, 0.f};
    bf16x8 At[4][2], B0[2][2], B1[2][2];
    const char* cA = (const char*)g.A + (size_t)cur.pm * tstep; const char* cB = (const char*)g.Bt + (size_t)cur.pn * tstep;
    S.a_ready(cur);
    if constexpr (SP2) {
        PG8_STAGE(PG8_SB(0, 0), cB, voffB); PG8_STAGE(PG8_SB(0, 1), cB + hstep, voffB); PG8_STAGE(PG8_SA(0, 0), cA, voffA); PG8_STAGE(PG8_SA(0, 1), cA + hstep, voffA);
        if (wr == 1) PG8_BAR;
        PG8_WAIT_V(2); PG8_BAR;
        PG8_STAGE(PG8_SB(1, 0), cB + kstep, voffB); PG8_STAGE(PG8_SA(1, 0), cA + kstep, voffA); PG8_STAGE(PG8_SB(1, 1), cB + hstep + kstep, voffB);
        PG8_WAIT_V(6); PG8_BAR;
    } else {
        PG8_STAGE(PG8_SB(0, 0), cB, voffB); PG8_STAGE(PG8_SA(0, 0), cA, voffA); PG8_STAGE(PG8_SB(0, 1), cB + hstep, voffB); PG8_STAGE(PG8_SA(0, 1), cA + hstep, voffA);
        if (wr == 1) PG8_BAR;
        PG8_WAIT_V(4); PG8_BAR;
        PG8_STAGE(PG8_SB(1, 0), cB + kstep, voffB); PG8_STAGE(PG8_SA(1, 0), cA + kstep, voffA); PG8_STAGE(PG8_SB(1, 1), cB + hstep + kstep, voffB);
        PG8_WAIT_V(6); PG8_BAR;
    }
    for (;;) {
        const bool has_next = S.next(ui + 1, nxt);
        const char* nA = has_next ? (const char*)g.A + (size_t)nxt.pm * tstep : cA; const char* nB = has_next ? (const char*)g.Bt + (size_t)nxt.pn * tstep : cB;
        for (int t = 0; t < nt; t += 2) {
            const bool last = (t == nt - 2);
            const char* a1 = cA + (size_t)(t + 1) * kstep;
            const char* a2 = last ? nA : cA + (size_t)(t + 2) * kstep; const char* b2 = last ? nB : cB + (size_t)(t + 2) * kstep;
            const char* a3 = a2 + kstep; const char* b3 = b2 + kstep;
            if (last && has_next) S.a_ready(nxt);
            if constexpr (SP2) {
            PG8_LDB(B0, 0, 0); PG8_LDB(B1, 0, 1); PG8_SCHED; PG8_LDA(At, 0, 0); PG8_STAGE(PG8_SA(1, 1), a1 + hstep, voffA);
            PG8_WAIT_V(8); PG8_WAIT_L(0); PG8_BAR; PG8_MMA(0, 0, At, B0); PG8_MMA(0, 1, At, B1); PG8_BAR; PG8_SCHED;
            PG8_LDA(At, 0, 1); PG8_STAGE(PG8_SB(0, 0), b2, voffB); PG8_STAGE(PG8_SB(0, 1), b2 + hstep, voffB); PG8_STAGE(PG8_SA(0, 0), a2, voffA);
            PG8_WAIT_V(8); PG8_WAIT_L(0); PG8_BAR; PG8_MMA(1, 0, At, B0); PG8_MMA(1, 1, At, B1); PG8_BAR; PG8_SCHED;
            PG8_LDB(B0, 1, 0); PG8_LDB(B1, 1, 1); PG8_SCHED; PG8_LDA(At, 1, 0); PG8_STAGE(PG8_SA(0, 1), a2 + hstep, voffA);
            PG8_WAIT_V(8); PG8_WAIT_L(0); PG8_BAR; PG8_MMA(0, 0, At, B0); PG8_MMA(0, 1, At, B1); PG8_BAR; PG8_SCHED;
            PG8_LDA(At, 1, 1); PG8_STAGE(PG8_SB(1, 0), b3, voffB); PG8_STAGE(PG8_SB(1, 1), b3 + hstep, voffB); PG8_STAGE(PG8_SA(1, 0), a3, voffA);
            PG8_WAIT_V(8); PG8_WAIT_L(0); PG8_BAR; PG8_MMA(1, 0, At, B0); PG8_MMA(1, 1, At, B1); PG8_BAR; PG8_SCHED;
            } else {
            PG8_LDB(B0, 0, 0); PG8_SCHED; PG8_LDA(At, 0, 0); PG8_STAGE(PG8_SA(1, 1), a1 + hstep, voffA);
            PG8_WAIT_L(8); PG8_BAR; PG8_WAIT_L(0); PG8_MMA(0, 0, At, B0); PG8_BAR; PG8_SCHED;
            PG8_LDB(B1, 0, 1); PG8_STAGE(PG8_SB(0, 0), b2, voffB);
            PG8_BAR; PG8_WAIT_L(0); PG8_MMA(0, 1, At, B1); PG8_BAR;
            PG8_LDA(At, 0, 1); PG8_STAGE(PG8_SA(0, 0), a2, voffA);
            PG8_BAR; PG8_WAIT_L(0); PG8_MMA(1, 0, At, B0); PG8_BAR; PG8_SCHED;
            PG8_STAGE(PG8_SB(0, 1), b2 + hstep, voffB);
            PG8_WAIT_V(6); PG8_BAR; PG8_MMA(1, 1, At, B1); PG8_BAR;
            PG8_LDB(B0, 1, 0); PG8_SCHED; PG8_LDA(At, 1, 0); PG8_STAGE(PG8_SA(0, 1), a2 + hstep, voffA);
            PG8_WAIT_L(8); PG8_BAR; PG8_WAIT_L(0); PG8_MMA(0, 0, At, B0); PG8_BAR; PG8_SCHED;
            PG8_LDB(B1, 1, 1); PG8_STAGE(PG8_SB(1, 0), b3, voffB);
            PG8_BAR; PG8_WAIT_L(0); PG8_MMA(0, 1, At, B1); PG8_BAR;
            PG8_LDA(At, 1, 1); PG8_STAGE(PG8_SA(1, 0), a3, voffA);
            PG8_BAR; PG8_WAIT_L(0); PG8_MMA(1, 0, At, B0); PG8_BAR; PG8_SCHED;
            PG8_STAGE(PG8_SB(1, 1), b3 + hstep, voffB);
            PG8_WAIT_V(6); PG8_BAR; PG8_MMA(1, 1, At, B1); PG8_BAR;
            }
        }
        if constexpr (ALIGN_EPI) { if (wr == 0) PG8_BAR; }
        if constexpr (!Epi::AFTER_DRAIN) { E(acc, cur, wr, wc, fr, fq); S.done(cur); }
        if (!has_next) break;
#pragma unroll
        for (int a = 0; a < 2; ++a)
#pragma unroll
            for (int b = 0; b < 2; ++b)
#pragma unroll
                for (int m = 0; m < 4; ++m)
#pragma unroll
                    for (int n = 0; n < 2; ++n) acc[a][b][m][n] = (f32x4){0.f, 0.f, 0.f, 0.f};
        cur = nxt; cA = nA; cB = nB; ++ui;
        if constexpr (ALIGN_EPI) { if (wr == 1) PG8_BAR; }
    }
    PG8_WAIT_V(0);
    if constexpr (!ALIGN_EPI) { if (wr == 0) PG8_BAR; }
    PG8_BAR;
    if constexpr (Epi::AFTER_DRAIN) { E.fused(acc, cur, wr, wc, fr, fq, lds, wid, lane); S.done(cur); }
#undef PG8_SA
#undef PG8_SB
#undef PG8_STAGE
#undef PG8_LDA
#undef PG8_LDB
#undef PG8_MMA
#undef PG8_WAIT_V
#undef PG8_WAIT_L
#undef PG8_BAR
#undef PG8_SCHED
}
}
constexpr int NWAVES = 8, NTHREADS = 512;
constexpr int SEQ = 16384, NB = 2, T = NB * SEQ, D = 1024;
constexpr int E_IN = 1792, LRU_W = 512, FF0 = 2816;
constexpr int O_IN = 4112, GH = 8, GD = 128, GC = 64, NCH = SEQ / GC  , NUNIT = NB * GH * NCH  ;
constexpr int NE = 8, FFE = 3584;
constexpr int MAXTILES = 264, PASS_TILES = 64;
constexpr float EPS = 1e-6f;

constexpr size_t MiB = 1u << 20;
constexpr size_t WS_CTL = 0, CTL_ZERO_BYTES = 1 * MiB;
constexpr size_t WS_ROPE = 1 * MiB;
constexpr size_t WS_STA = 5 * MiB, WS_STB = 7 * MiB;
constexpr size_t WS_MISC = 9 * MiB;
constexpr size_t MS_LRU_A = WS_MISC, MS_LRU_H = WS_MISC + 512 * 1024;
constexpr size_t MS_TOKE = WS_MISC + 1 * MiB;
constexpr size_t MS_TOKW = MS_TOKE + 128 * 1024;
constexpr size_t MS_RANK = MS_TOKW + 256 * 1024;
constexpr size_t MS_DEST = MS_RANK + 256 * 1024;
constexpr size_t MS_CNT = MS_DEST + 256 * 1024;
constexpr size_t MS_TILEE = MS_CNT + 8 * 1024;
constexpr size_t MS_RG = MS_TILEE + 2 * 1024;
constexpr size_t MS_GLAST = WS_MISC + 3 * MiB;
constexpr size_t MS_WSK = MS_GLAST + 16 * 1024;
constexpr size_t MS_ROUT = MS_WSK + 32 * 1024;
constexpr size_t MS_RC = MS_ROUT + 32 * 1024;
constexpr size_t MS_AB = MS_RC + 128 * 1024;
constexpr size_t WS_W0 = 13 * MiB;
constexpr size_t W0_IN = WS_W0, W0_OUT = W0_IN + (size_t)E_IN * D * 2, W0_GU = W0_OUT + (size_t)D * D * 2, W0_DN = W0_GU + (size_t)2 * FF0 * D * 2;
constexpr size_t WS_HALO = 13 * MiB;
constexpr size_t W1_OUT = 35 * MiB;
constexpr size_t WS_AB = 37 * MiB;
constexpr size_t WS_HB = 40 * MiB;
constexpr size_t WS_PROJ0 = 104 * MiB;
constexpr size_t WS_LRUH = 216 * MiB, WS_LRUP = 280 * MiB;
constexpr size_t WS_YMIX = 344 * MiB;
constexpr size_t W1_IN = 408 * MiB;
constexpr size_t WS_ACT0 = 104 * MiB;
constexpr size_t WS_QKV = 104 * MiB;
constexpr size_t WS_GATE = 296 * MiB;
constexpr size_t WS_UT = 360 * MiB;
constexpr size_t WS_AQK = 424 * MiB;
constexpr size_t WS_WMD = 456 * MiB;
constexpr size_t WS_ON = 104 * MiB;
constexpr size_t WS_XG = 168 * MiB;
constexpr size_t WS_ACT = 300 * MiB;
constexpr size_t WS_END = 512 * MiB;
static_assert(W0_DN + (size_t)D * FF0 * 2 <= W1_OUT && MS_AB <= WS_W0 && WS_HALO + (size_t)NB * NCH * 3 * 3072 * 2 <= W1_OUT, "ws map");
static_assert(WS_XG + (size_t)MAXTILES * 256 * 1024 * 2 <= WS_ACT && WS_ACT + (size_t)(PASS_TILES + 8) * 256 * FFE * 2 <= WS_WMD && WS_WMD + (size_t)NE * D * FFE * 2 <= WS_END, "ws map (MoE)");
constexpr int CW_TMO = 0, CW_BAR = 4096, CW_SCANQ = 8192;

constexpr int RING_BYTES = 131072;
constexpr int LDSCTL_OFF = 161024, MISC_OFF = LDSCTL_OFF + 320;
constexpr int LDS_BYTES = 162048;

#define GAS __attribute__((address_space(1)))
#define LAS __attribute__((address_space(3)))
#define DI __device__ __forceinline__
typedef unsigned short bf16;
typedef unsigned v4u __attribute__((ext_vector_type(4)));
typedef unsigned v2u __attribute__((ext_vector_type(2)));
typedef float f32x4 __attribute__((ext_vector_type(4)));
typedef float f32x2 __attribute__((ext_vector_type(2)));
typedef short bf16x8 __attribute__((ext_vector_type(8)));
typedef short bf16x4 __attribute__((ext_vector_type(4)));
typedef GAS unsigned gu32;
#define LDS_WAIT() asm volatile("s_waitcnt lgkmcnt(0)" ::: "memory")
#define VM_WAIT() asm volatile("s_waitcnt vmcnt(0)" ::: "memory")
#define MFMA16(a, b, c) __builtin_amdgcn_mfma_f32_16x16x32_bf16((a), (b), (c), 0, 0, 0)
typedef __bf16 bf16v2_t __attribute__((ext_vector_type(2)));
DI unsigned pk2(float lo, float hi) { const f32x2 v = {lo, hi}; return __builtin_bit_cast(unsigned, __builtin_convertvector(v, bf16v2_t)); }
DI unsigned f2bf(float f) { return pk2(f, 0.f) & 0xffffu; }
DI float bflo(unsigned w) { return __builtin_bit_cast(float, w << 16); }
DI float bfhi(unsigned w) { return __builtin_bit_cast(float, w & 0xffff0000u); }
DI float bf2f(bf16 v) { return __builtin_bit_cast(float, (unsigned)v << 16); }
DI float sigmoid_f(float x) { return __builtin_amdgcn_rcpf(1.0f + __expf(-x)); }
DI float silu_f(float x) { return x * sigmoid_f(x); }
DI float wave_sum(float v) {
#pragma unroll
    for (int o = 1; o < 64; o <<= 1) v += __shfl_xor(v, o);
    return v;
}
DI bf16x8 mk8(v2u lo, v2u hi) { v4u w; w.x = lo.x; w.y = lo.y; w.z = hi.x; w.w = hi.y; return __builtin_bit_cast(bf16x8, w); }
DI bf16x8 pack_acc2(const f32x4 a, const f32x4 b) { v4u w; w.x = pk2(a[0], a[1]); w.y = pk2(a[2], a[3]); w.z = pk2(b[0], b[1]); w.w = pk2(b[2], b[3]); return __builtin_bit_cast(bf16x8, w); }
#define XB_TMO      128
#define XB_XCNT(j)  (256  + 64 * (j))
#define XB_XSUB(j)  (1280 + 64 * (j))
#define XB_XGEN(j)  (2304 + 64 * (j))
#define XB_TOP      3328
#define XB_TOPGEN   3392
#define XCD_BAR_WORDS 3456
#define XB_SPIN_CAP (1u << 18)

__device__ __forceinline__ unsigned xb_ld(unsigned* p)              { return __hip_atomic_load(p, __ATOMIC_RELAXED, __HIP_MEMORY_SCOPE_AGENT); }
__device__ __forceinline__ unsigned xb_add(unsigned* p, unsigned v) { return __hip_atomic_fetch_add(p, v, __ATOMIC_RELAXED, __HIP_MEMORY_SCOPE_AGENT); }
__device__ __forceinline__ unsigned xb_xcc_id() { return (unsigned)__builtin_amdgcn_s_getreg((3 << 11) | 20) & 0xFu; }
#define XB_SPIN(cond, bar) do { unsigned _sp = 0; while (cond) { __builtin_amdgcn_s_sleep(1); \
    if ((++_sp & 255u) == 0u) { if (xb_ld(&(bar)[XB_TMO])) break; if (_sp > XB_SPIN_CAP) { atomicAdd(&(bar)[XB_TMO], 1u); break; } } } } while (0)

struct XcdBarrier {
    unsigned* bar; unsigned x;
    volatile LAS unsigned* st;
};

__device__ __forceinline__ XcdBarrier xcd_barrier_post(unsigned* bar, volatile LAS unsigned* st) {
    XcdBarrier b; b.bar = bar; b.x = xb_xcc_id(); b.st = st;
    if (threadIdx.x == 0) (void)xb_add(&bar[XB_XCNT(b.x)], 1u);
    return b;
}
__device__ __forceinline__ void xcd_barrier_complete(unsigned* bar, unsigned x, unsigned& nloc, unsigned& nx) {
    const unsigned G = gridDim.x * gridDim.y * gridDim.z;
    unsigned sum, cnt, mine, sp = 0u;
    for (;;) {
        sum = 0u; cnt = 0u; mine = 0u;
#pragma unroll
        for (unsigned j = 0; j < 16; ++j) { const unsigned c = xb_ld(&bar[XB_XCNT(j)]); sum += c; cnt += (c > 0u) ? 1u : 0u; mine = (j == x) ? c : mine; }
        if (sum == G) break;
        __builtin_amdgcn_s_sleep(1);
        if ((++sp & 255u) == 0u) { if (xb_ld(&bar[XB_TMO])) break; if (sp > XB_SPIN_CAP) { atomicAdd(&bar[XB_TMO], 1u); break; } }
    }
    nloc = mine > 0u ? mine : 1u; nx = cnt > 0u ? cnt : 1u;
}

__device__ __forceinline__ void xcd_barrier(const XcdBarrier& b) {
    asm volatile("s_waitcnt vmcnt(0)" ::: "memory");
    __syncthreads();
    if (threadIdx.x == 0) {
        unsigned* bar = b.bar;
        __builtin_amdgcn_s_waitcnt(0);
        unsigned nloc = b.st[0], nx = b.st[1];
        if (nloc == 0u) { xcd_barrier_complete(bar, b.x, nloc, nx); b.st[0] = nloc; b.st[1] = nx; }
        const unsigned old = xb_add(&bar[XB_XSUB(b.x)], 1u);
        const unsigned gen = old / nloc;
        if (old + 1u == (gen + 1u) * nloc) {
            __builtin_amdgcn_fence(__ATOMIC_RELEASE, "agent");
            asm volatile("s_waitcnt vmcnt(0)" ::: "memory");
            const unsigned og = xb_add(&bar[XB_TOP], 1u);
            const unsigned tg = og / nx;
            if (og + 1u == (tg + 1u) * nx) xb_add(&bar[XB_TOPGEN], 1u);
            else XB_SPIN(xb_ld(&bar[XB_TOPGEN]) == tg, bar);
            __builtin_amdgcn_fence(__ATOMIC_ACQUIRE, "agent");
            xb_add(&bar[XB_XGEN(b.x)], 1u);
            asm volatile("s_waitcnt vmcnt(0)" ::: "memory");
        } else {
            XB_SPIN(xb_ld(&bar[XB_XGEN(b.x)]) == gen, bar);
            __builtin_amdgcn_fence(__ATOMIC_ACQUIRE, "agent");
            asm volatile("s_waitcnt vmcnt(0)" ::: "memory");
        }
    }
    __syncthreads();
}
struct CvtJob { const float* src; const float* gain; bf16* dst; int ldw, K; };
DI CvtJob cvt_job(const float* W, int ldw, int K, const float* gain, bf16* WT, int drow0, int k0, int n0, int lane) {
    const int kg = lane >> 3, c = lane & 7; CvtJob j; j.src = W + (size_t)(k0 + 8 * kg) * ldw + n0 + 4 * c; j.gain = gain ? gain + k0 + 8 * kg : nullptr; j.dst = WT + (size_t)(drow0 + 4 * c) * K + k0 + 8 * kg; j.ldw = ldw; j.K = K; return j;
}
struct CvtRegs { f32x4 v[8]; };
DI void cvt_ld(const CvtJob& j, CvtRegs& r) {
#pragma unroll
    for (int i = 0; i < 8; ++i) r.v[i] = *(const f32x4*)(j.src + (size_t)i * j.ldw);
}
DI void cvt_st(const CvtJob& j, CvtRegs& r) {
    if (j.gain) { const f32x4 g0 = *(const f32x4*)j.gain, g1 = *(const f32x4*)(j.gain + 4);
#pragma unroll
        for (int i = 0; i < 4; ++i) { r.v[i] = r.v[i] * g0[i]; r.v[4 + i] = r.v[4 + i] * g1[i]; } }
#pragma unroll
    for (int q = 0; q < 4; ++q) { v4u o; o.x = pk2(r.v[0][q], r.v[1][q]); o.y = pk2(r.v[2][q], r.v[3][q]); o.z = pk2(r.v[4][q], r.v[5][q]); o.w = pk2(r.v[6][q], r.v[7][q]); *(v4u*)(j.dst + (size_t)q * j.K) = o; }
}
DI void cvt_item(const float* W, int ldw, int K, const float* gain, bf16* WT, int drow0, int k0, int n0, LAS float* scr, int lane) {
    (void)scr; const CvtJob j = cvt_job(W, ldw, K, gain, WT, drow0, k0, n0, lane); CvtRegs r; cvt_ld(j, r); cvt_st(j, r);
}
DI void cvt_plain(const float* W, int ldw, int K, int N, const float* gain, bf16* WT, int it, LAS float* scr, int lane) {
    const int nblk = N / 32, kb = it / nblk, nb = it % nblk; cvt_item(W, ldw, K, gain, WT, 32 * nb, 64 * kb, 32 * nb, scr, lane);
}
DI void cvt_gu(const float* W, int K, int N, const float* gain, bf16* WT, int up, int it, LAS float* scr, int lane) {
    const int nblk = N / 32, kb = it / nblk, nb = it % nblk, n0 = 32 * nb; cvt_item(W, N, K, gain, WT, (n0 >> 7) * 256 + up * 128 + (n0 & 127), 64 * kb, n0, scr, lane);
}
struct Args { const float* in[28]; float* out; unsigned char* ws; int ph_lo, ph_hi; };
enum { I_X = 0, I_LNMIX, I_LNFFN, I_EWIN, I_CONVW, I_CONVB, I_WA, I_BA, I_WI, I_BI, I_LAM, I_QN, I_KN, I_SINK, I_EWOUT, I_FG, I_FU, I_FD,
       I_OWIN, I_OCONV, I_ALOG, I_DTB, I_ONORM, I_OWOUT, I_ROUT, I_MG, I_MU, I_MD };

DI void phase_prologue(const Args& a, LAS unsigned char* lds, int gw, int NGW, int wave, int lane) {
    unsigned char* ws = a.ws;
    LAS float* scr = (LAS float*)(lds + wave * 16384);
    constexpr int I1 = 16 * 56, I2 = 16 * 32, I3 = 16 * 88, I5 = 44 * 32, I6 = 16 * 128, I7 = 16 * 32, NIT = I1 + I2 + 2 * I3 + I5 + I6 + I7;
    for (int it = gw; it < NIT; it += NGW) {
        int r = it;
        if (r < I1) { cvt_plain(a.in[I_EWIN], E_IN, D, E_IN, a.in[I_LNMIX], (bf16*)(ws + W0_IN), r, scr, lane); continue; } r -= I1;
        if (r < I2) { cvt_plain(a.in[I_EWOUT], D, D, D, nullptr, (bf16*)(ws + W0_OUT), r, scr, lane); continue; } r -= I2;
        if (r < I3) { cvt_gu(a.in[I_FG], D, FF0, a.in[I_LNFFN], (bf16*)(ws + W0_GU), 0, r, scr, lane); continue; } r -= I3;
        if (r < I3) { cvt_gu(a.in[I_FU], D, FF0, a.in[I_LNFFN], (bf16*)(ws + W0_GU), 1, r, scr, lane); continue; } r -= I3;
        if (r < I5) { cvt_plain(a.in[I_FD], D, FF0, D, nullptr, (bf16*)(ws + W0_DN), r, scr, lane); continue; } r -= I5;
        if (r < I6) { cvt_plain(a.in[I_OWIN], O_IN, D, 4096, a.in[I_LNMIX] + D, (bf16*)(ws + W1_IN), r, scr, lane); continue; } r -= I6;
        cvt_plain(a.in[I_OWOUT], D, D, D, nullptr, (bf16*)(ws + W1_OUT), r, scr, lane);
    }
    const int gt = gw * 64 + lane, NGT = NGW * 64;
    for (int i = gt; i < 16 * D; i += NGT) { const int c = i >> 10, k = i & 1023; ((bf16*)(ws + MS_WSK))[i] = (bf16)f2bf(a.in[I_OWIN][(size_t)k * O_IN + 4096 + c] * a.in[I_LNMIX][D + k]); }
    for (int i = gt; i < 8 * D; i += NGT) { const int k = i >> 3; ((float*)(ws + MS_ROUT))[i] = a.in[I_ROUT][i] * a.in[I_LNFFN][D + k]; }
    for (int i = gt; i < SEQ * 32; i += NGT) { const int pos = i >> 5, f = i & 31;
        const float inv = powf(10000.0f, -(float)f * (1.0f / 32.0f)); const float ang = (float)pos * inv;
        const double tt = (double)ang * 0.15915494309189535; const float fr = (float)(tt - rint(tt));
        f32x2 cs; cs.x = __builtin_amdgcn_cosf(fr); cs.y = __builtin_amdgcn_sinf(fr); ((f32x2*)(ws + WS_ROPE))[i] = cs; }
    for (int m0 = gw; m0 < T; m0 += 4 * NGW) { f32x4 v[4][4];
#pragma unroll
        for (int r = 0; r < 4; ++r) { const int m = m0 + r * NGW < T ? m0 + r * NGW : m0; const f32x4* xr = (const f32x4*)(a.in[I_X] + (size_t)m * D) + lane;
#pragma unroll
            for (int j = 0; j < 4; ++j) v[r][j] = xr[64 * j]; }
#pragma unroll
        for (int r = 0; r < 4; ++r) { const int m = m0 + r * NGW; if (m >= T) break; float s = 0.f;
#pragma unroll
            for (int j = 0; j < 4; ++j) s += (v[r][j].x * v[r][j].x + v[r][j].y * v[r][j].y) + (v[r][j].z * v[r][j].z + v[r][j].w * v[r][j].w);
            s = wave_sum(s);
            v2u* o8 = (v2u*)((bf16*)(ws + WS_HB) + (size_t)m * D) + lane;
#pragma unroll
            for (int j = 0; j < 4; ++j) { v2u w; w.x = pk2(v[r][j].x, v[r][j].y); w.y = pk2(v[r][j].z, v[r][j].w); o8[64 * j] = w; }
            if (lane < 16) ((float*)(ws + WS_STA))[(size_t)m * 16 + lane] = lane == 0 ? s : 0.f; }
    }
}
constexpr int MOE_D_ITEMS = NE * 56 * 32, MOE_GU_ITEMS = NE * 2 * 16 * 112;
DI CvtJob moe_job(const Args& a, int it, int lane) {
    if (it < MOE_D_ITEMS) { const int e = it / (56 * 32), r = it % (56 * 32), kb = r / 32, nb = r % 32;
        return cvt_job(a.in[I_MD] + (size_t)e * FFE * D, D, FFE, nullptr, (bf16*)(a.ws + WS_WMD) + (size_t)e * D * FFE, 32 * nb, 64 * kb, 32 * nb, lane); }
    const int i2 = it - MOE_D_ITEMS, e = i2 / (2 * 16 * 112), r0 = i2 % (2 * 16 * 112), up = r0 / (16 * 112), r = r0 % (16 * 112), kb = r / 112, nb = r % 112, n0 = 32 * nb;
    return cvt_job((up ? a.in[I_MU] : a.in[I_MG]) + (size_t)e * D * FFE, FFE, D, a.in[I_LNFFN] + D, (bf16*)a.out + (size_t)e * 2 * FFE * D, (n0 >> 7) * 256 + up * 128 + (n0 & 127), 64 * kb, n0, lane);
}
DI void moe_convert(const Args& a, int first, int stride, int lane) {
    constexpr int N = MOE_D_ITEMS + MOE_GU_ITEMS;
    for (int it = first; it < N; it += 4 * stride) {
        CvtJob j0 = moe_job(a, it, lane); CvtRegs r0, r1, r2, r3; cvt_ld(j0, r0);
        const bool h1 = it + stride < N, h2 = it + 2 * stride < N, h3 = it + 3 * stride < N;
        CvtJob j1 = moe_job(a, h1 ? it + stride : it, lane), j2 = moe_job(a, h2 ? it + 2 * stride : it, lane), j3 = moe_job(a, h3 ? it + 3 * stride : it, lane);
        cvt_ld(j1, r1); cvt_ld(j2, r2); cvt_ld(j3, r3);
        cvt_st(j0, r0); if (h1) cvt_st(j1, r1); if (h2) cvt_st(j2, r2); if (h3) cvt_st(j3, r3);
    }
}

struct LruFrags { bf16x8 wa[4][2], wi[4][2]; };
DI void lru_frags(const Args& a, LAS unsigned char* lds, LruFrags& F, int wave, int lane) {
    const int g = lane >> 4, c16 = lane & 15;
    LAS float* scr = (LAS float*)(lds + wave * 16384);
#pragma unroll
    for (int gate = 0; gate < 2; ++gate) {
        const f32x4* W = (const f32x4*)((gate ? a.in[I_WI] : a.in[I_WA]) + wave * 4096);
#pragma unroll
        for (int q = 0; q < 16; ++q) ((LAS f32x4*)scr)[q * 64 + lane] = W[q * 64 + lane];
        LDS_WAIT();
        const LAS float* sp = scr + (8 * g) * 64 + c16;
#pragma unroll
        for (int jt = 0; jt < 4; ++jt)
#pragma unroll
            for (int ks = 0; ks < 2; ++ks) { float t[8];
#pragma unroll
                for (int e = 0; e < 8; ++e) t[e] = sp[(32 * ks + e) * 64 + 16 * jt];
                v4u p; p.x = pk2(t[0], t[1]); p.y = pk2(t[2], t[3]); p.z = pk2(t[4], t[5]); p.w = pk2(t[6], t[7]);
                if (gate) F.wi[jt][ks] = __builtin_bit_cast(bf16x8, p); else F.wa[jt][ks] = __builtin_bit_cast(bf16x8, p); }
        LDS_WAIT();
    }
}
DI void lru_unit(const Args& a, LAS unsigned char* lds, const LruFrags& F, int unit, int wave, int lane) {
    unsigned char* ws = a.ws;
    const int b = unit >> 7, chk = unit & 127, t0 = chk * 128, g = lane >> 4, c16 = lane & 15;
    const size_t rowb = (size_t)b * SEQ;
    const bf16* proj0 = (const bf16*)(ws + WS_PROJ0);
    float* hloc = (float*)(ws + WS_LRUH); float* pcum = (float*)(ws + WS_LRUP);
    const int c = wave * 64 + lane;
    const float w0 = a.in[I_CONVW][c], w1 = a.in[I_CONVW][512 + c], w2 = a.in[I_CONVW][1024 + c], w3 = a.in[I_CONVW][1536 + c], cb = a.in[I_CONVB][c];
    const float ba = a.in[I_BA][c], bi = a.in[I_BI][c], lam = a.in[I_LAM][c];
    const float sp8 = 8.0f * (lam < -20.f ? -lam : log1pf(expf(-lam)));
    LAS bf16* XC = (LAS bf16*)(lds + wave * 11264);
    LAS float* GA = (LAS float*)(lds + wave * 11264 + 2304);
    LAS float* GI = GA + 16 * 68;
    float x1 = 0.f, x2 = 0.f, x3 = 0.f;
    if (t0 > 0) { x1 = bf2f(proj0[(rowb + t0 - 1) * E_IN + c]); x2 = bf2f(proj0[(rowb + t0 - 2) * E_IN + c]); x3 = bf2f(proj0[(rowb + t0 - 3) * E_IN + c]); }
    float h = 0.f, P = 1.f;
    bf16 xr[16];
#pragma unroll
    for (int tt = 0; tt < 16; ++tt) xr[tt] = proj0[(rowb + t0 + tt) * E_IN + c];
#pragma unroll 1
    for (int st = 0; st < 8; ++st) {
        float xc[16]; bf16 xcur[16];
#pragma unroll
        for (int tt = 0; tt < 16; ++tt) xcur[tt] = xr[tt];
        if (st < 7) {
#pragma unroll
            for (int tt = 0; tt < 16; ++tt) xr[tt] = proj0[(rowb + t0 + 16 * (st + 1) + tt) * E_IN + c]; }
#pragma unroll
        for (int tt = 0; tt < 16; ++tt) { const float xn = bf2f(xcur[tt]);
            xc[tt] = w0 * x3 + w1 * x2 + w2 * x1 + w3 * xn + cb; x3 = x2; x2 = x1; x1 = xn; XC[tt * 72 + lane] = (bf16)f2bf(xc[tt]); }
        LDS_WAIT();
        bf16x8 bx[2];
#pragma unroll
        for (int ks = 0; ks < 2; ++ks) bx[ks] = *(const LAS bf16x8*)(XC + c16 * 72 + 32 * ks + 8 * g);
#pragma unroll
        for (int jt = 0; jt < 4; ++jt) { f32x4 ca = {0.f, 0.f, 0.f, 0.f}, ci = {0.f, 0.f, 0.f, 0.f};
#pragma unroll
            for (int ks = 0; ks < 2; ++ks) { ca = MFMA16(F.wa[jt][ks], bx[ks], ca); ci = MFMA16(F.wi[jt][ks], bx[ks], ci); }
            *(LAS f32x4*)(GA + c16 * 68 + 16 * jt + 4 * g) = ca; *(LAS f32x4*)(GI + c16 * 68 + 16 * jt + 4 * g) = ci; }
        LDS_WAIT();
#pragma unroll
        for (int tt = 0; tt < 16; ++tt) {
            const float r = sigmoid_f(GA[tt * 68 + lane] + ba), gi = sigmoid_f(GI[tt * 68 + lane] + bi);
            const float la = -sp8 * r, av = __expf(la), mult = sqrtf(fmaxf(1.0f - av * av, 0.f));
            h = av * h + mult * gi * xc[tt]; P *= av;
            const size_t o = (rowb + t0 + 16 * st + tt) * LRU_W + c; hloc[o] = h; pcum[o] = P; }
        LDS_WAIT();
    }
    ((float*)(ws + MS_LRU_A))[(size_t)unit * 512 + c] = P; ((float*)(ws + MS_LRU_H))[(size_t)unit * 512 + c] = h;
}

DI void attn_unit(const Args& a, LAS unsigned char* lds, int unit, int tid, int wave, int lane) {
    unsigned char* ws = a.ws;
    const int kvh = unit & 1, blk = (unit >> 1) & 127, b = unit >> 8, t0 = blk * 128, g = lane >> 4, c = lane & 15;
    const size_t rowb = (size_t)b * SEQ;
    const bf16* proj0 = (const bf16*)(ws + WS_PROJ0); const f32x2* rope = (const f32x2*)(ws + WS_ROPE);
    LAS bf16* Ks = (LAS bf16*)lds;
    LAS bf16* Vt = (LAS bf16*)(lds + 36864);
    {
        const int key = tid >> 1, p = tid & 1, pos = t0 - 128 + key;
        if (pos >= 0) {
            const bf16* src = proj0 + (rowb + pos) * E_IN + 1536 + kvh * 64;
            const v4u q0 = *(const v4u*)(src + 16 * p), q1 = *(const v4u*)(src + 16 * p + 8), q2 = *(const v4u*)(src + 32 + 16 * p), q3 = *(const v4u*)(src + 32 + 16 * p + 8);
            float xa[16], xb[16];
            xa[0] = bflo(q0.x); xa[1] = bfhi(q0.x); xa[2] = bflo(q0.y); xa[3] = bfhi(q0.y); xa[4] = bflo(q0.z); xa[5] = bfhi(q0.z); xa[6] = bflo(q0.w); xa[7] = bfhi(q0.w);
            xa[8] = bflo(q1.x); xa[9] = bfhi(q1.x); xa[10] = bflo(q1.y); xa[11] = bfhi(q1.y); xa[12] = bflo(q1.z); xa[13] = bfhi(q1.z); xa[14] = bflo(q1.w); xa[15] = bfhi(q1.w);
            xb[0] = bflo(q2.x); xb[1] = bfhi(q2.x); xb[2] = bflo(q2.y); xb[3] = bfhi(q2.y); xb[4] = bflo(q2.z); xb[5] = bfhi(q2.z); xb[6] = bflo(q2.w); xb[7] = bfhi(q2.w);
            xb[8] = bflo(q3.x); xb[9] = bfhi(q3.x); xb[10] = bflo(q3.y); xb[11] = bfhi(q3.y); xb[12] = bflo(q3.z); xb[13] = bfhi(q3.z); xb[14] = bflo(q3.w); xb[15] = bfhi(q3.w);
            float ss = 0.f;
#pragma unroll
            for (int e = 0; e < 16; ++e) ss += xa[e] * xa[e] + xb[e] * xb[e];
            ss += __shfl_xor(ss, 1);
            const float rn = __builtin_amdgcn_rsqf(ss * (1.0f / 64.0f) + EPS);
            unsigned oa[8], ob[8];
#pragma unroll
            for (int e = 0; e < 16; e += 2) { float r1[2], r2[2];
#pragma unroll
                for (int k = 0; k < 2; ++k) { const int d = 16 * p + e + k; const f32x2 cs = rope[(size_t)pos * 32 + d];
                    const float y1 = xa[e + k] * rn * a.in[I_KN][d], y2 = xb[e + k] * rn * a.in[I_KN][32 + d]; r1[k] = y1 * cs.x - y2 * cs.y; r2[k] = y2 * cs.x + y1 * cs.y; }
                oa[e >> 1] = pk2(r1[0], r1[1]); ob[e >> 1] = pk2(r2[0], r2[1]); }
            v4u w; w.x = oa[0]; w.y = oa[1]; w.z = oa[2]; w.w = oa[3]; *(LAS v4u*)(Ks + key * 72 + 16 * p) = w;
            w.x = oa[4]; w.y = oa[5]; w.z = oa[6]; w.w = oa[7]; *(LAS v4u*)(Ks + key * 72 + 16 * p + 8) = w;
            w.x = ob[0]; w.y = ob[1]; w.z = ob[2]; w.w = ob[3]; *(LAS v4u*)(Ks + key * 72 + 32 + 16 * p) = w;
            w.x = ob[4]; w.y = ob[5]; w.z = ob[6]; w.w = ob[7]; *(LAS v4u*)(Ks + key * 72 + 32 + 16 * p + 8) = w;
            const bf16* vs = proj0 + (rowb + pos) * E_IN + 1664 + kvh * 64 + 32 * p;
#pragma unroll
            for (int q = 0; q < 4; ++q) { const v4u vv = *(const v4u*)(vs + 8 * q); const unsigned vw[4] = {vv.x, vv.y, vv.z, vv.w};
#pragma unroll
                for (int e = 0; e < 4; ++e) { Vt[(32 * p + 8 * q + 2 * e) * 264 + key] = (bf16)(vw[e] & 0xffffu); Vt[(32 * p + 8 * q + 2 * e + 1) * 264 + key] = (bf16)(vw[e] >> 16); } }
        } else {
            const v4u z = {0u, 0u, 0u, 0u};
            *(LAS v4u*)(Ks + key * 72 + 16 * p) = z; *(LAS v4u*)(Ks + key * 72 + 16 * p + 8) = z; *(LAS v4u*)(Ks + key * 72 + 32 + 16 * p) = z; *(LAS v4u*)(Ks + key * 72 + 32 + 16 * p + 8) = z;
#pragma unroll
            for (int e = 0; e < 32; ++e) Vt[(32 * p + e) * 264 + key] = (bf16)0;
        }
    }
    __syncthreads();
    const int hq = kvh * 4 + (wave >> 1), qh = wave & 1; const float sink = a.in[I_SINK][hq];
    bf16* ymix = (bf16*)(ws + WS_YMIX);
    v4u qr0[4], qr1[4];
#pragma unroll
    for (int qt = 0; qt < 4; ++qt) { const bf16* src = proj0 + (rowb + t0 + 64 * qh + 16 * qt + c) * E_IN + 1024 + hq * 64; qr0[qt] = *(const v4u*)(src + 8 * g); qr1[qt] = *(const v4u*)(src + 32 + 8 * g); }
#pragma unroll
    for (int qt = 0; qt < 4; ++qt) {
        const int q0 = 64 * qh + 16 * qt, kt0 = 4 * qh + qt; const int tok = t0 + q0 + c;
        bf16x8 bq[2];
        {   const v4u r0 = qr0[qt], r1 = qr1[qt];
            const unsigned u0[4] = {r0.x, r0.y, r0.z, r0.w}, u1[4] = {r1.x, r1.y, r1.z, r1.w}; float xa[8], xb[8]; float ss = 0.f;
#pragma unroll
            for (int e = 0; e < 4; ++e) { xa[2 * e] = bflo(u0[e]); xa[2 * e + 1] = bfhi(u0[e]); xb[2 * e] = bflo(u1[e]); xb[2 * e + 1] = bfhi(u1[e]); }
#pragma unroll
            for (int e = 0; e < 8; ++e) ss += xa[e] * xa[e] + xb[e] * xb[e];
            ss += __shfl_xor(ss, 16); ss += __shfl_xor(ss, 32);
            const float rn = __builtin_amdgcn_rsqf(ss * (1.0f / 64.0f) + EPS) * 0.125f;
            float o1[8], o2[8];
#pragma unroll
            for (int e = 0; e < 8; ++e) { const int d = 8 * g + e; const f32x2 cs = rope[(size_t)tok * 32 + d];
                const float y1 = xa[e] * rn * a.in[I_QN][d], y2 = xb[e] * rn * a.in[I_QN][32 + d]; o1[e] = y1 * cs.x - y2 * cs.y; o2[e] = y2 * cs.x + y1 * cs.y; }
            v4u w; w.x = pk2(o1[0], o1[1]); w.y = pk2(o1[2], o1[3]); w.z = pk2(o1[4], o1[5]); w.w = pk2(o1[6], o1[7]); bq[0] = __builtin_bit_cast(bf16x8, w);
            w.x = pk2(o2[0], o2[1]); w.y = pk2(o2[2], o2[3]); w.z = pk2(o2[4], o2[5]); w.w = pk2(o2[6], o2[7]); bq[1] = __builtin_bit_cast(bf16x8, w);
        }
        f32x4 s[9]; float mx = -1e30f;
        const int qi = 128 + q0 + c;
#pragma unroll
        for (int kt = 0; kt < 9; ++kt) {
            const LAS bf16* kp = Ks + (16 * (kt0 + kt) + c) * 72 + 8 * g;
            f32x4 acc = {0.f, 0.f, 0.f, 0.f};
            acc = MFMA16(*(const LAS bf16x8*)kp, bq[0], acc); acc = MFMA16(*(const LAS bf16x8*)(kp + 32), bq[1], acc);
#pragma unroll
            for (int r = 0; r < 4; ++r) { const int kj = 16 * (kt0 + kt) + 4 * g + r; const bool ok = (kj <= qi) && (qi - kj < 128) && (blk > 0 || kj >= 128);
                acc[r] = ok ? acc[r] : -1e30f; mx = fmaxf(mx, acc[r]); }
            s[kt] = acc;
        }
        mx = fmaxf(mx, __shfl_xor(mx, 16)); mx = fmaxf(mx, __shfl_xor(mx, 32)); mx = fmaxf(mx, sink);
        float sum = 0.f;
#pragma unroll
        for (int kt = 0; kt < 9; ++kt)
#pragma unroll
            for (int r = 0; r < 4; ++r) { const float p = (s[kt][r] > -1e29f) ? __expf(s[kt][r] - mx) : 0.f; s[kt][r] = p; sum += p; }
        sum += __shfl_xor(sum, 16); sum += __shfl_xor(sum, 32); sum += __expf(sink - mx);
        const float inv = __builtin_amdgcn_rcpf(sum);
        bf16x8 bp[5];
#pragma unroll
        for (int pp = 0; pp < 4; ++pp) bp[pp] = pack_acc2(s[2 * pp] * inv, s[2 * pp + 1] * inv);
        { const f32x4 z = {0.f, 0.f, 0.f, 0.f}; bp[4] = pack_acc2(s[8] * inv, z); }
#pragma unroll
        for (int dt = 0; dt < 4; ++dt) { f32x4 o = {0.f, 0.f, 0.f, 0.f};
#pragma unroll
            for (int pp = 0; pp < 5; ++pp) { const LAS bf16* vp = Vt + (16 * dt + c) * 264 + 16 * (kt0 + 2 * pp) + 4 * g;
                const v2u lo = *(const LAS v2u*)vp, hi = *(const LAS v2u*)(vp + (pp < 4 ? 16 : 0)); o = MFMA16(mk8(lo, hi), bp[pp], o); }
            v2u w; w.x = pk2(o[0], o[1]); w.y = pk2(o[2], o[3]); *(v2u*)(ymix + (rowb + tok) * D + 512 + hq * 64 + 16 * dt + 4 * g) = w; }
    }
    __syncthreads();
}

DI void lrufix_unit(const Args& a, int unit, int tid) {
    unsigned char* ws = a.ws;
    const int b = unit >> 7, chk = unit & 127, c = tid;
    const float* At = (const float*)(ws + MS_LRU_A); const float* Ht = (const float*)(ws + MS_LRU_H);
    float hin = 0.f;
    for (int c0 = 0; c0 < chk; c0 += 8) { float av[8], hv[8];
#pragma unroll
        for (int e = 0; e < 8; ++e) { const int cc = c0 + e < chk ? c0 + e : chk - 1; const size_t o = (size_t)(b * 128 + cc) * 512 + c; av[e] = At[o]; hv[e] = Ht[o]; }
#pragma unroll
        for (int e = 0; e < 8; ++e) if (c0 + e < chk) hin = av[e] * hin + hv[e]; }
    const float* hloc = (const float*)(ws + WS_LRUH); const float* pcum = (const float*)(ws + WS_LRUP);
    const bf16* proj0 = (const bf16*)(ws + WS_PROJ0); bf16* ymix = (bf16*)(ws + WS_YMIX);
    for (int t0 = 0; t0 < 128; t0 += 8) { float hl[8], pc[8], xg[8];
#pragma unroll
        for (int e = 0; e < 8; ++e) { const size_t row = (size_t)b * SEQ + chk * 128 + t0 + e; hl[e] = hloc[row * LRU_W + c]; pc[e] = pcum[row * LRU_W + c]; xg[e] = bf2f(proj0[row * E_IN + 512 + c]); }
#pragma unroll
        for (int e = 0; e < 8; ++e) { const size_t row = (size_t)b * SEQ + chk * 128 + t0 + e; const float h = hl[e] + pc[e] * hin, x = xg[e];
            const float z = 0.7978845608028654f * (x + 0.044715f * x * x * x); const float th = 1.0f - 2.0f * __builtin_amdgcn_rcpf(1.0f + __expf(2.0f * z));
            ymix[row * D + c] = (bf16)f2bf(h * 0.5f * x * (1.0f + th)); } }
}
DI void skinny_tile(const Args& a, int tile, int lane) {
    unsigned char* ws = a.ws; const int g = lane >> 4, c = lane & 15;
    const bf16* wsk = (const bf16*)(ws + MS_WSK) + c * D + 8 * g; const bf16* hb = (const bf16*)(ws + WS_HB) + (size_t)(tile * 16 + c) * D + 8 * g;
    f32x4 acc = {0.f, 0.f, 0.f, 0.f};
#pragma unroll 8
    for (int ks = 0; ks < 32; ++ks) acc = MFMA16(*(const bf16x8*)(wsk + 32 * ks), *(const bf16x8*)(hb + 32 * ks), acc);
    const int row = tile * 16 + c; const float rs = pg8::rstd16((const float*)(ws + WS_STA), row);
    *(f32x4*)((float*)(ws + WS_AB) + (size_t)row * 16 + 4 * g) = acc * rs;
}

DI void conv_unit(const Args& a, int unit, int tid) {
    if (tid >= 384) return;
    unsigned char* ws = a.ws; const int b = unit >> 8, ck = unit & 255, col = 8 * tid;
    bf16* p = (bf16*)(ws + WS_QKV) + ((size_t)b * SEQ + (size_t)ck * 64) * 3072 + col;
    float w[4][8];
#pragma unroll
    for (int j = 0; j < 4; ++j) { const f32x4 w0 = *(const f32x4*)(a.in[I_OCONV] + j * 3072 + col), w1 = *(const f32x4*)(a.in[I_OCONV] + j * 3072 + col + 4);
#pragma unroll
        for (int e = 0; e < 4; ++e) { w[j][e] = w0[e]; w[j][4 + e] = w1[e]; } }
    float x1[8], x2[8], x3[8];
    if (ck > 0) { const bf16* hp = (const bf16*)(ws + WS_HALO) + (size_t)(b * NCH + ck - 1) * 3 * 3072 + col; const v4u h3 = *(const v4u*)hp, h2 = *(const v4u*)(hp + 3072), h1 = *(const v4u*)(hp + 6144);
        const unsigned u3[4] = {h3.x, h3.y, h3.z, h3.w}, u2[4] = {h2.x, h2.y, h2.z, h2.w}, u1[4] = {h1.x, h1.y, h1.z, h1.w};
#pragma unroll
        for (int e = 0; e < 4; ++e) { x3[2 * e] = bflo(u3[e]); x3[2 * e + 1] = bfhi(u3[e]); x2[2 * e] = bflo(u2[e]); x2[2 * e + 1] = bfhi(u2[e]); x1[2 * e] = bflo(u1[e]); x1[2 * e + 1] = bfhi(u1[e]); } }
    else {
#pragma unroll
        for (int e = 0; e < 8; ++e) { x1[e] = 0.f; x2[e] = 0.f; x3[e] = 0.f; } }
    for (int j0 = 0; j0 < 64; j0 += 8) { v4u raw[8];
#pragma unroll
        for (int t = 0; t < 8; ++t) raw[t] = *(const v4u*)(p + (size_t)(j0 + t) * 3072);
#pragma unroll
        for (int t = 0; t < 8; ++t) { const unsigned uw[4] = {raw[t].x, raw[t].y, raw[t].z, raw[t].w}; float y[8];
#pragma unroll
            for (int e = 0; e < 8; ++e) { const float xn = (e & 1) ? bfhi(uw[e >> 1]) : bflo(uw[e >> 1]); const float v = w[0][e] * x3[e] + w[1][e] * x2[e] + w[2][e] * x1[e] + w[3][e] * xn; x3[e] = x2[e]; x2[e] = x1[e]; x1[e] = xn; y[e] = silu_f(v); }
            v4u o; o.x = pk2(y[0], y[1]); o.y = pk2(y[2], y[3]); o.z = pk2(y[4], y[5]); o.w = pk2(y[6], y[7]); *(v4u*)(p + (size_t)(j0 + t) * 3072) = o; }
    }
}

constexpr int PR_XQ = 0, PR_XK = 17408;
constexpr int PR_KT = 36448, PR_VT = 54880;
constexpr int PR_SLOT = 73728, PR_SLOTB = 9216, PR_VEC = 147456, PR_VECB = 1536;
DI int lrow_off(int i) { const int m = (i - 1) >> 2; return i <= 0 ? 0 : 8 * m * (m + 1) + (i - 1 - 4 * m) * 4 * (m + 1); }
struct PrepRegs { v4u a[2], b[2]; float ab0, ab1; };
DI void prep_load(const unsigned char* ws, PrepRegs& r, int unit, int colA, int colB, int tid, bool want_ab) {
    const int ck = unit & 255, h = (unit >> 8) & 7, b = unit >> 11; const size_t R0 = (size_t)b * SEQ + (size_t)ck * 64;
    const bf16* qkv = (const bf16*)(ws + WS_QKV);
#pragma unroll
    for (int k = 0; k < 2; ++k) { const int idx = tid + 512 * k, row = idx >> 4, c16 = idx & 15; const bf16* p = qkv + (R0 + row) * 3072 + h * 128 + 8 * c16; r.a[k] = *(const v4u*)(p + colA); r.b[k] = *(const v4u*)(p + colB); }
    if (want_ab && tid >= 448) { const float* ab = (const float*)(ws + WS_AB) + (R0 + (tid - 448)) * 16; r.ab0 = ab[h]; r.ab1 = ab[8 + h]; }
}
DI void prep_stage(LAS unsigned char* lds, const PrepRegs& r, int tid) {
#pragma unroll
    for (int k = 0; k < 2; ++k) { const int idx = tid + 512 * k, row = idx >> 4, c16 = idx & 15;
        *(LAS v4u*)((LAS bf16*)(lds + PR_XQ) + row * 136 + 8 * c16) = r.a[k]; *(LAS v4u*)((LAS bf16*)(lds + PR_XK) + row * 136 + 8 * c16) = r.b[k]; }
}
DI void prep_front(const Args& a, LAS unsigned char* lds, int unit, int slot, const PrepRegs& R, int tid, int wave, int lane, const bool dry) {
    unsigned char* ws = a.ws;
    const int ck = unit & 255, h = (unit >> 8) & 7, b = unit >> 11, g = lane >> 4, c = lane & 15;
    const size_t R0 = (size_t)b * SEQ + (size_t)ck * 64;
    bf16* qkv = (bf16*)(ws + WS_QKV);
    LAS bf16* XQ = (LAS bf16*)(lds + PR_XQ); LAS bf16* XK = (LAS bf16*)(lds + PR_XK);
    LAS float* Ls = (LAS float*)(lds + PR_SLOT + slot * PR_SLOTB);
    LAS float* Gs = (LAS float*)(lds + PR_VEC + slot * PR_VECB); LAS float* Bs = Gs + 64; LAS float* Rq = Gs + 128; LAS float* Rk = Gs + 192; LAS float* SK = Gs + 256; LAS float* SD = Gs + 320;
    prep_stage(lds, R, tid);
    if (wave == 7) {
        const float xin = R.ab0 + a.in[I_DTB][h]; const float sp = xin > 20.f ? xin : log1pf(expf(xin));
        float G = -expf(a.in[I_ALOG][h]) * sp;
#pragma unroll
        for (int o = 1; o < 64; o <<= 1) { const float v = __shfl_up(G, o); if (lane >= o) G += v; }
        Gs[lane] = G; Bs[lane] = sigmoid_f(R.ab1);
        if (lane == 63 && !dry) ((float*)(ws + MS_GLAST))[unit] = expf(G);
    }
    __syncthreads();
    { const int row = tid >> 2, qtr = tid & 3; const LAS bf16* s = (row < 64 ? XQ + row * 136 : XK + (row - 64) * 136) + 32 * qtr; float ss = 0.f;
#pragma unroll
      for (int q = 0; q < 4; ++q) { const v4u v = *(const LAS v4u*)(s + 8 * q); const unsigned vw[4] = {v.x, v.y, v.z, v.w};
#pragma unroll
          for (int e = 0; e < 4; ++e) { const float l = bflo(vw[e]), hh = bfhi(vw[e]); ss += l * l + hh * hh; } }
      ss += __shfl_xor(ss, 1); ss += __shfl_xor(ss, 2);
      const float rn = __builtin_amdgcn_rsqf(ss + EPS);
      if (qtr == 0) { if (row < 64) Rq[row] = rn * 0.08838834764831845f; else { const int j = row - 64; Rk[j] = rn; const float Gj = Gs[j]; SK[j] = -Bs[j] * rn * __expf(Gj); SD[j] = rn * __expf(Gs[63] - Gj); } } }
    __syncthreads();
    bf16* aq = (bf16*)(ws + WS_AQK) + (size_t)unit * 4096;
    for (int job = wave; job < 26; job += 8) {
        int it, jt; const bool isk = job < 10;
        if (isk) { it = job >= 6 ? 3 : (job >= 3 ? 2 : (job >= 1 ? 1 : 0)); jt = job - it * (it + 1) / 2; } else { it = (job - 10) >> 2; jt = (job - 10) & 3; }
        const int i = 16 * it + c, j0 = 16 * jt + 4 * g;
        if (it < jt) { const v2u z = {0u, 0u}; if (!dry) *(v2u*)(aq + i * 64 + j0) = z; continue; }
        const LAS bf16* ap = XK + (16 * jt + c) * 136 + 8 * g; const LAS bf16* bp = (isk ? XK : XQ) + (16 * it + c) * 136 + 8 * g;
        f32x4 acc = {0.f, 0.f, 0.f, 0.f};
#pragma unroll
        for (int ks = 0; ks < 4; ++ks) acc = MFMA16(*(const LAS bf16x8*)(ap + 32 * ks), *(const LAS bf16x8*)(bp + 32 * ks), acc);
        const float Gi = Gs[i], ri = isk ? Bs[i] * Rk[i] : Rq[i]; f32x4 o;
#pragma unroll
        for (int r = 0; r < 4; ++r) { const int j = j0 + r; const bool ok = isk ? (i > j) : (i >= j); const float dcy = __expf(fminf(Gi - Gs[j], 0.f)); o[r] = ok ? acc[r] * ri * Rk[j] * dcy : 0.f; }
        if (isk) { LAS float* lp = Ls + lrow_off(i) + j0;
#pragma unroll
            for (int r = 0; r < 4; ++r) if (j0 + r < i) lp[r] = o[r]; }
        else { v2u w; w.x = pk2(o[0], o[1]); w.y = pk2(o[2], o[3]); if (!dry) *(v2u*)(aq + i * 64 + j0) = w; }
    }
#pragma unroll
    for (int k = 0; k < 2; ++k) { const int task = tid + 512 * k, i = task >> 4, dc = task & 15; const float sc = Rq[i] * __expf(Gs[i]);
        const v4u v = *(const LAS v4u*)(XQ + i * 136 + 8 * dc); v4u o;
        o.x = pk2(bflo(v.x) * sc, bfhi(v.x) * sc); o.y = pk2(bflo(v.y) * sc, bfhi(v.y) * sc); o.z = pk2(bflo(v.z) * sc, bfhi(v.z) * sc); o.w = pk2(bflo(v.w) * sc, bfhi(v.w) * sc);
        if (!dry) *(v4u*)(qkv + (R0 + i) * 3072 + h * 128 + 8 * dc) = o; }
    __syncthreads();
}
DI void prep_invert(LAS unsigned char* lds, int slot, int lane) {
    LAS float* Ls = (LAS float*)(lds + PR_SLOT + slot * PR_SLOTB);
    float t[64]; int ln = lane; asm volatile("" : "+v"(ln));
#pragma unroll
    for (int i = 0; i < 64; ++i) { float a0 = (i == ln) ? 1.f : 0.f, a1 = 0.f, a2 = 0.f, a3 = 0.f;
#pragma unroll
        for (int k4 = 0; k4 < (i + 3) / 4; ++k4) { const f32x4 l = *(const LAS f32x4*)(Ls + lrow_off(i) + 4 * k4);
            if (4 * k4 + 0 < i) a0 -= l[0] * t[4 * k4 + 0]; if (4 * k4 + 1 < i) a1 -= l[1] * t[4 * k4 + 1]; if (4 * k4 + 2 < i) a2 -= l[2] * t[4 * k4 + 2]; if (4 * k4 + 3 < i) a3 -= l[3] * t[4 * k4 + 3]; }
        t[i] = (a0 + a1) + (a2 + a3); }
    LDS_WAIT();
    LAS bf16* Tb = (LAS bf16*)Ls;
#pragma unroll
    for (int i = 0; i < 64; ++i) Tb[i * 72 + lane] = (bf16)f2bf(t[i]);
}
DI void prep_back(const Args& a, LAS unsigned char* lds, int unit, int slot, const PrepRegs& R, int tid, int wave, int lane, const bool dry) {
    unsigned char* ws = a.ws;
    const int ck = unit & 255, h = (unit >> 8) & 7, b = unit >> 11, g = lane >> 4, c = lane & 15;
    const size_t R0 = (size_t)b * SEQ + (size_t)ck * 64;
    bf16* qkv = (bf16*)(ws + WS_QKV);
    LAS bf16* KT = (LAS bf16*)(lds + PR_KT); LAS bf16* VT = (LAS bf16*)(lds + PR_VT); const LAS bf16* Tb = (const LAS bf16*)(lds + PR_SLOT + slot * PR_SLOTB);
    const LAS float* Gs = (const LAS float*)(lds + PR_VEC + slot * PR_VECB); const LAS float* Bs = Gs + 64; const LAS float* SK = Gs + 256; const LAS float* SD = Gs + 320;
    prep_stage(lds, R, tid);
    __syncthreads();
    {   const int part = tid >> 8, half = (tid >> 7) & 1, ch = tid & 127;
        const LAS bf16* rw = (const LAS bf16*)(lds + (part ? PR_XK : PR_XQ)) + (32 * half) * 136 + ch; LAS bf16* to = (part ? VT : KT) + ch * 72 + 32 * half;
        const LAS float* s0 = (part ? Bs : SK) + 32 * half; const LAS float* s1 = SD + 32 * half;
        bf16* kd = qkv + (R0 + (ch >> 1)) * 3072 + 2048 + h * 128 + (ch & 1) * 64 + 32 * half;
#pragma unroll
        for (int j8 = 0; j8 < 4; ++j8) { float x[8];
#pragma unroll
            for (int e = 0; e < 8; ++e) x[e] = bf2f(rw[(8 * j8 + e) * 136]);
            const f32x4 sa = *(const LAS f32x4*)(s0 + 8 * j8), sb = *(const LAS f32x4*)(s0 + 8 * j8 + 4);
            v4u w; w.x = pk2(x[0] * sa[0], x[1] * sa[1]); w.y = pk2(x[2] * sa[2], x[3] * sa[3]); w.z = pk2(x[4] * sb[0], x[5] * sb[1]); w.w = pk2(x[6] * sb[2], x[7] * sb[3]); *(LAS v4u*)(to + 8 * j8) = w;
            if (part == 0) { const f32x4 da = *(const LAS f32x4*)(s1 + 8 * j8), db = *(const LAS f32x4*)(s1 + 8 * j8 + 4);
                v4u o; o.x = pk2(x[0] * da[0], x[1] * da[1]); o.y = pk2(x[2] * da[2], x[3] * da[3]); o.z = pk2(x[4] * db[0], x[5] * db[1]); o.w = pk2(x[6] * db[2], x[7] * db[3]); if (!dry) *(v4u*)(kd + 8 * j8) = o; } }
    }
    __syncthreads();
    bf16* uT = (bf16*)(ws + WS_UT) + (size_t)unit * 8192;
    for (int job = wave; job < 64; job += 8) {
        f32x4 acc = {0.f, 0.f, 0.f, 0.f};
        if (job < 32) { const int it = job >> 3, et = job & 7; const LAS bf16* ap = Tb + (16 * it + c) * 72 + 8 * g; const LAS bf16* bp = VT + (16 * et + c) * 72 + 8 * g;
#pragma unroll
            for (int ks = 0; ks < 2; ++ks) acc = MFMA16(*(const LAS bf16x8*)(ap + 32 * ks), *(const LAS bf16x8*)(bp + 32 * ks), acc);
            v2u w; w.x = pk2(acc[0], acc[1]); w.y = pk2(acc[2], acc[3]); if (!dry) *(v2u*)(uT + (16 * et + c) * 64 + 16 * it + 4 * g) = w;
        } else { const int dt = (job - 32) >> 2, it = (job - 32) & 3; const LAS bf16* ap = KT + (16 * dt + c) * 72 + 8 * g; const LAS bf16* bp = Tb + (16 * it + c) * 72 + 8 * g;
#pragma unroll
            for (int ks = 0; ks < 2; ++ks) acc = MFMA16(*(const LAS bf16x8*)(ap + 32 * ks), *(const LAS bf16x8*)(bp + 32 * ks), acc);
            v2u w; w.x = pk2(acc[0], acc[1]); w.y = pk2(acc[2], acc[3]); if (!dry) *(v2u*)(qkv + (R0 + 16 * it + c) * 3072 + 1024 + h * 128 + 16 * dt + 4 * g) = w; }
    }
}
#ifndef MK_SUBSTAMP
#define MK_SUBSTAMP 0
#endif
DI void prep_phase(const Args& a, LAS unsigned char* lds, int first, int stride, int n, int tid, int wave, int lane, const bool dry, unsigned long long& st_acc) {
    const unsigned char* ws = a.ws; unsigned long long t0 = 0ull; (void)t0;
#define PSB(i) do { if (MK_SUBSTAMP == (i)) t0 = __builtin_amdgcn_s_memrealtime(); } while (0)
#define PSE(i) do { if (MK_SUBSTAMP == (i)) st_acc += __builtin_amdgcn_s_memrealtime() - t0; } while (0)
    for (int b0 = 0; b0 < n; b0 += 8) {
        const int nb = (n - b0) < 8 ? (n - b0) : 8;
        PrepRegs R;
        PSB(3);
        prep_load(ws, R, first + b0 * stride, 0, 1024, tid, true);
        for (int s = 0; s < nb; ++s) {
            const int unit = first + (b0 + s) * stride; PrepRegs Rc = R;
            if (s + 1 < nb) prep_load(ws, R, unit + stride, 0, 1024, tid, true);
            prep_front(a, lds, unit, s, Rc, tid, wave, lane, dry);
        }
        PSE(3); PSB(4);
        if (wave < nb) prep_invert(lds, wave, lane);
        prep_load(ws, R, first + b0 * stride, 1024, 2048, tid, false);
        __syncthreads();
        PSE(4); PSB(5);
        for (int s = 0; s < nb; ++s) {
            const int unit = first + (b0 + s) * stride; PrepRegs Rc = R;
            if (s + 1 < nb) prep_load(ws, R, unit + stride, 1024, 2048, tid, false);
            prep_back(a, lds, unit, s, Rc, tid, wave, lane, dry);
        }
        __syncthreads();
        PSE(5);
    }
#undef PSB
#undef PSE
}

constexpr int SC_CRB = 34816, SC_W = 0, SC_K = 16384, SC_U = 32768;
constexpr int SC_OR0 = 3 * SC_CRB, SC_ORB = 24576, SC_Q = 0, SC_A = 16384;
constexpr int SC_DUMP = SC_OR0 + 2 * SC_ORB, SC_XS = SC_DUMP + 1024, SC_XV = SC_XS + 4096, SC_FLAG = SC_XV + 2048;
static_assert(SC_FLAG + 128 <= LDSCTL_OFF, "scan LDS map");
DI const LAS v2u* sw256(const LAS unsigned char* base, int row, int j, int half) { return (const LAS v2u*)(base + row * 256 + ((j ^ (row & 15)) << 4) + half * 8); }
DI const LAS v2u* sw128(const LAS unsigned char* base, int row, int j, int half) { return (const LAS v2u*)(base + row * 128 + ((j ^ ((row >> 1) & 7)) << 4) + half * 8); }
#define SCAN_BAR() do { asm volatile("s_waitcnt lgkmcnt(0)" ::: "memory"); __builtin_amdgcn_s_barrier(); asm volatile("" ::: "memory"); } while (0)
DI void scan_chain(const Args& a, LAS unsigned char* lds, int chain, int tid, int wave, int lane, const bool dry) {
    unsigned char* ws = a.ws;
    const int es = chain & 7, h = (chain >> 3) & 7, b = chain >> 6, g = lane >> 4, c = lane & 15, gh = g >> 1, gl1 = g & 1;
    LAS v4u* XS = (LAS v4u*)(lds + SC_XS); LAS v4u* XV = (LAS v4u*)(lds + SC_XV); volatile LAS int* flag = (volatile LAS int*)(lds + SC_FLAG); volatile LAS int* ack = flag + 16;
    __syncthreads();
    if (wave == 0) {
        const float* glast = (const float*)(ws + MS_GLAST) + (b * GH + h) * NCH;
        { const v4u z = {0u, 0u, 0u, 0u};
#pragma unroll
          for (int s = 0; s < 4; ++s) XS[s * 64 + lane] = z;
          if (lane == 0) { *flag = 0; *ack = 0; } }
        SCAN_BAR();
        f32x4 S[8]; bf16x8 Sb[4];
#pragma unroll
        for (int i = 0; i < 8; ++i) S[i] = (f32x4){0.f, 0.f, 0.f, 0.f};
#pragma unroll
        for (int i = 0; i < 4; ++i) Sb[i] = (bf16x8){0, 0, 0, 0, 0, 0, 0, 0};
        int slot = 0;
        for (int ck = 0; ck < NCH; ++ck) {
            const LAS unsigned char* cur = lds + slot * SC_CRB; slot = slot == 2 ? 0 : slot + 1;
            const float gl = glast[ck]; f32x4 vn[4]; bf16x8 wf[4][4], kf[8][2]; v2u uf[4];
#pragma unroll
            for (int jt = 0; jt < 4; ++jt) { uf[jt] = *sw128(cur + SC_U, c, 2 * jt + gh, gl1);
#pragma unroll
                for (int s = 0; s < 4; ++s) wf[jt][s] = mk8(*sw256(cur + SC_W, 16 * jt + c, 4 * s + gh, gl1), *sw256(cur + SC_W, 16 * jt + c, 4 * s + 2 + gh, gl1)); }
#pragma unroll
            for (int dt = 0; dt < 8; ++dt)
#pragma unroll
                for (int s = 0; s < 2; ++s) kf[dt][s] = mk8(*sw128(cur + SC_K, 16 * dt + c, 4 * s + gh, gl1), *sw128(cur + SC_K, 16 * dt + c, 4 * s + 2 + gh, gl1));
#pragma unroll
            for (int jt = 0; jt < 4; ++jt) { f32x4 acc = {bflo(uf[jt].x), bfhi(uf[jt].x), bflo(uf[jt].y), bfhi(uf[jt].y)};
#pragma unroll
                for (int s = 0; s < 4; ++s) acc = MFMA16(wf[jt][s], Sb[s], acc);
                vn[jt] = acc; }
            bf16x8 vb[2]; vb[0] = pack_acc2(vn[0], vn[1]); vb[1] = pack_acc2(vn[2], vn[3]);
            XV[lane] = __builtin_bit_cast(v4u, vb[0]); XV[64 + lane] = __builtin_bit_cast(v4u, vb[1]); LDS_WAIT(); if (lane == 0) *flag = ck + 1;
#pragma unroll
            for (int dt = 0; dt < 8; ++dt) { f32x4 acc = S[dt] * gl;
#pragma unroll
                for (int s = 0; s < 2; ++s) acc = MFMA16(kf[dt][s], vb[s], acc);
                S[dt] = acc; }
            while (*ack < ck + 1) __builtin_amdgcn_s_sleep(1);
#pragma unroll
            for (int s = 0; s < 4; ++s) { Sb[s] = pack_acc2(S[2 * s], S[2 * s + 1]); XS[s * 64 + lane] = __builtin_bit_cast(v4u, Sb[s]); }
            SCAN_BAR();
        }
    } else if (wave == 1) {
        bf16* oT = (bf16*)(ws + WS_UT) + (size_t)((b * GH + h) * NCH) * 8192 + (16 * es + c) * 64 + 4 * g;
        SCAN_BAR();
        for (int ck = 0; ck < NCH; ++ck) {
            const LAS unsigned char* cur = lds + SC_OR0 + (ck & 1) * SC_ORB;
            bf16x8 So[4], qf[4][4], af[4][2]; f32x4 acc[4];
#pragma unroll
            for (int s = 0; s < 4; ++s) So[s] = __builtin_bit_cast(bf16x8, XS[s * 64 + lane]);
#pragma unroll
            for (int jt = 0; jt < 4; ++jt) {
#pragma unroll
                for (int s = 0; s < 4; ++s) qf[jt][s] = mk8(*sw256(cur + SC_Q, 16 * jt + c, 4 * s + gh, gl1), *sw256(cur + SC_Q, 16 * jt + c, 4 * s + 2 + gh, gl1));
#pragma unroll
                for (int s = 0; s < 2; ++s) af[jt][s] = mk8(*sw128(cur + SC_A, 16 * jt + c, 4 * s + gh, gl1), *sw128(cur + SC_A, 16 * jt + c, 4 * s + 2 + gh, gl1)); }
            LDS_WAIT(); if (lane == 0) *ack = ck + 1;
#pragma unroll
            for (int jt = 0; jt < 4; ++jt) { acc[jt] = (f32x4){0.f, 0.f, 0.f, 0.f};
#pragma unroll
                for (int s = 0; s < 4; ++s) acc[jt] = MFMA16(qf[jt][s], So[s], acc[jt]); }
            while (*flag < ck + 1) __builtin_amdgcn_s_sleep(1);
            bf16x8 vb[2]; vb[0] = __builtin_bit_cast(bf16x8, XV[lane]); vb[1] = __builtin_bit_cast(bf16x8, XV[64 + lane]);
#pragma unroll
            for (int jt = 0; jt < 4; ++jt) {
#pragma unroll
                for (int s = 0; s < 2; ++s) acc[jt] = MFMA16(af[jt][s], vb[s], acc[jt]);
                v2u w; w.x = pk2(acc[jt][0], acc[jt][1]); w.y = pk2(acc[jt][2], acc[jt][3]); if (!dry) *(v2u*)(oT + (size_t)ck * 8192 + 16 * jt) = w; }
            SCAN_BAR();
        }
    } else {
        const size_t R0 = (size_t)b * SEQ; const int unit0 = (b * GH + h) * NCH, lw = wave - 2;
        unsigned gc[6], ic[6], lc[6], go[4], io[4], lo4[4];
#pragma unroll
        for (int k = 0; k < 6; ++k) { const int r = 6 * lw + k; size_t gg; unsigned gi, ll;
            if (r < 16) { const int row = 4 * r + (lane >> 4), j = (lane & 15) ^ (row & 15); gg = WS_QKV + ((R0 + row) * 3072 + 1024 + h * 128 + 8 * j) * 2; gi = 64u * 3072u * 2u; ll = SC_W + r * 1024; }
            else if (r < 32) { const int d = 8 * (r - 16) + (lane >> 3), j = (lane & 7) ^ ((d >> 1) & 7); gg = WS_QKV + ((R0 + (d >> 1)) * 3072 + 2048 + h * 128 + (d & 1) * 64 + 8 * j) * 2; gi = 64u * 3072u * 2u; ll = SC_K + (r - 16) * 1024; }
            else if (r < 34) { const int e = 8 * (r - 32) + (lane >> 3), j = (lane & 7) ^ ((e >> 1) & 7); gg = WS_UT + ((size_t)unit0 * 8192 + (16 * es + e) * 64 + 8 * j) * 2; gi = 16384u; ll = SC_U + (r - 32) * 1024; }
            else { gg = WS_UT + ((size_t)unit0 * 8192 + lane * 8) * 2; gi = 16384u; ll = 0xffffffffu; }
            gc[k] = (unsigned)gg; ic[k] = gi; lc[k] = ll; }
#pragma unroll
        for (int k = 0; k < 4; ++k) { const int r = 4 * lw + k; size_t gg; unsigned gi, ll;
            if (r < 16) { const int row = 4 * r + (lane >> 4), j = (lane & 15) ^ (row & 15); gg = WS_QKV + ((R0 + row) * 3072 + h * 128 + 8 * j) * 2; gi = 64u * 3072u * 2u; ll = SC_Q + r * 1024; }
            else { const int i = 8 * (r - 16) + (lane >> 3), j = (lane & 7) ^ ((i >> 1) & 7); gg = WS_AQK + ((size_t)unit0 * 4096 + i * 64 + 8 * j) * 2; gi = 8192u; ll = SC_A + (r - 16) * 1024; }
            go[k] = (unsigned)gg; io[k] = gi; lo4[k] = ll; }
#define DMA_C(ck, slot) do { _Pragma("unroll") for (int k = 0; k < 6; ++k) \
            __builtin_amdgcn_global_load_lds((const unsigned*)(ws + (gc[k] + (unsigned)(ck) * ic[k])), (LAS unsigned*)(lds + (lc[k] == 0xffffffffu ? (unsigned)SC_DUMP : (unsigned)(slot) * SC_CRB + lc[k])), 16, 0, 0); } while (0)
#define DMA_O(ck, slot) do { _Pragma("unroll") for (int k = 0; k < 4; ++k) \
            __builtin_amdgcn_global_load_lds((const unsigned*)(ws + (go[k] + (unsigned)(ck) * io[k])), (LAS unsigned*)(lds + SC_OR0 + (unsigned)(slot) * SC_ORB + lo4[k]), 16, 0, 0); } while (0)
        DMA_C(0, 0); DMA_O(0, 0); DMA_C(1, 1);
        asm volatile("s_waitcnt vmcnt(0)" ::: "memory");
        SCAN_BAR();
        int s2 = 2;
        for (int ck = 0; ck < NCH; ++ck) {
            if (ck + 2 < NCH) { DMA_O(ck + 1, (ck + 1) & 1); asm volatile("" ::: "memory"); DMA_C(ck + 2, s2); asm volatile("s_waitcnt vmcnt(6)" ::: "memory"); }
            else { if (ck + 1 < NCH) DMA_O(ck + 1, (ck + 1) & 1); asm volatile("s_waitcnt vmcnt(0)" ::: "memory"); }
            s2 = s2 == 2 ? 0 : s2 + 1;
            SCAN_BAR();
        }
#undef DMA_C
#undef DMA_O
    }
    __syncthreads();
}

DI void onorm_unit(const Args& a, LAS float* red  , int unit, int it, int wave, int lane) {
    unsigned char* ws = a.ws;
    const int ck = unit & 255, h = (unit >> 8) & 7, b = unit >> 11; const size_t row = (size_t)b * SEQ + (size_t)ck * 64 + lane;
    const bf16* oT = (const bf16*)(ws + WS_UT) + (size_t)unit * 8192 + (16 * wave) * 64 + lane;
    float v[16]; float ss = 0.f;
#pragma unroll
    for (int k = 0; k < 16; ++k) { v[k] = bf2f(oT[k * 64]); ss += v[k] * v[k]; }
    LAS float* rb = red + (it & 1) * 512; rb[wave * 64 + lane] = ss;
    const bf16* gp = (const bf16*)(ws + WS_GATE) + row * D + h * 128 + 16 * wave; const v4u g0 = *(const v4u*)gp, g1 = *(const v4u*)(gp + 8);
    __syncthreads();
    float tot = 0.f;
#pragma unroll
    for (int w = 0; w < 8; ++w) tot += rb[w * 64 + lane];
    const float rs = __builtin_amdgcn_rsqf(tot * (1.0f / 128.0f) + EPS);
    const unsigned gw[8] = {g0.x, g0.y, g0.z, g0.w, g1.x, g1.y, g1.z, g1.w}; unsigned o[8];
    const float* on = a.in[I_ONORM] + 16 * wave;
#pragma unroll
    for (int k = 0; k < 8; ++k) { const float ga = bflo(gw[k]), gb = bfhi(gw[k]); o[k] = pk2(v[2 * k] * rs * on[2 * k] * silu_f(ga), v[2 * k + 1] * rs * on[2 * k + 1] * silu_f(gb)); }
    bf16* op = (bf16*)(ws + WS_ON) + row * D + h * 128 + 16 * wave;
    v4u w0, w1; w0.x = o[0]; w0.y = o[1]; w0.z = o[2]; w0.w = o[3]; w1.x = o[4]; w1.y = o[5]; w1.z = o[6]; w1.w = o[7]; *(v4u*)op = w0; *(v4u*)(op + 8) = w1;
}

DI void route_unit(const Args& a, LAS int* esel, int unit, int wave, int lane) {
    unsigned char* ws = a.ws;
    const float* rt = (const float*)(ws + MS_ROUT);
    f32x4 rr[4][4][2];
#pragma unroll
    for (int j = 0; j < 4; ++j)
#pragma unroll
        for (int i = 0; i < 4; ++i) { const f32x4* p = (const f32x4*)(rt + (size_t)(4 * (64 * j + lane) + i) * 8); rr[j][i][0] = p[0]; rr[j][i][1] = p[1]; }
    for (int tl = 16 * wave; tl < 16 * wave + 16; ++tl) {
        const int tok = unit * 128 + tl;
        const v2u* xr = (const v2u*)((const bf16*)(ws + WS_HB) + (size_t)tok * D) + lane;
        float acc[8] = {0.f, 0.f, 0.f, 0.f, 0.f, 0.f, 0.f, 0.f};
#pragma unroll
        for (int j = 0; j < 4; ++j) { const v2u xw = xr[64 * j]; const f32x4 x = {bflo(xw.x), bfhi(xw.x), bflo(xw.y), bfhi(xw.y)};
#pragma unroll
            for (int i = 0; i < 4; ++i)
#pragma unroll
                for (int e = 0; e < 8; ++e) acc[e] += x[i] * rr[j][i][e >> 2][e & 3]; }
#pragma unroll
        for (int e = 0; e < 8; ++e) acc[e] = wave_sum(acc[e]);
        const float rs = pg8::rstd16((const float*)(ws + WS_STB), tok);
        int e1 = 0; float l1 = acc[0];
#pragma unroll
        for (int e = 1; e < 8; ++e) if (acc[e] > l1) { l1 = acc[e]; e1 = e; }
        int e2 = -1; float l2 = -3.0e38f;
#pragma unroll
        for (int e = 0; e < 8; ++e) if (e != e1 && acc[e] > l2) { l2 = acc[e]; e2 = e; }
        const float w1 = __builtin_amdgcn_rcpf(1.0f + __expf((l2 - l1) * rs));
        if (lane == 0) { ((int*)(ws + MS_TOKE))[tok] = e1 | (e2 << 8); ((float*)(ws + MS_TOKW))[2 * tok] = w1; ((float*)(ws + MS_TOKW))[2 * tok + 1] = 1.0f - w1; esel[2 * tl] = e1; esel[2 * tl + 1] = e2; }
    }
    __syncthreads();
    { int base = 0;
      for (int i = 0; i < 4; ++i) { const bool m = esel[64 * i + lane] == wave; const unsigned long long mask = __ballot(m);
          if (m) ((int*)(ws + MS_RANK))[unit * 256 + 64 * i + lane] = base + __popcll(mask & ((1ull << lane) - 1ull)); base += __popcll(mask); }
      if (lane == 0) ((int*)(ws + MS_CNT))[unit * 8 + wave] = base; }
    __syncthreads();
}

DI void gather_unit(const Args& a, LAS int* sm  , int unit, int tid, int wave, int lane) {
    unsigned char* ws = a.ws;
    const int* cnt = (const int*)(ws + MS_CNT);
    if (tid < 8) { int tot = 0, off = 0; for (int u = 0; u < 256; ++u) { const int v = cnt[u * 8 + tid]; tot += v; if (u < unit) off += v; } sm[tid] = tot; sm[8 + tid] = off; }
    __syncthreads();
    if (tid == 0) { int s = 0; for (int e = 0; e < 8; ++e) { sm[16 + e] = s; s += ((sm[e] + 255) >> 8) << 8; } sm[24] = s;
        if (unit == 0) { int* te = (int*)(ws + MS_TILEE); for (int e = 0; e < 8; ++e) for (int t = sm[16 + e] >> 8; t < (sm[16 + e + 1] >> 8); ++t) te[t] = e; te[MAXTILES] = s >> 8; } }
    __syncthreads();
    const bf16* hb3 = (const bf16*)(ws + WS_HB); bf16* xg = (bf16*)(ws + WS_XG); float* rg = (float*)(ws + MS_RG);
    for (int s0 = 32 * wave; s0 < 32 * wave + 32; s0 += 4) { int dest[4]; v4u r0[4], r1[4];
#pragma unroll
        for (int q = 0; q < 4; ++q) { const int s = s0 + q, tok = unit * 128 + (s >> 1), k = s & 1; const int e = (((const int*)(ws + MS_TOKE))[tok] >> (8 * k)) & 0xff;
            dest[q] = sm[16 + e] + sm[8 + e] + ((const int*)(ws + MS_RANK))[unit * 256 + s];
            const v4u* src = (const v4u*)(hb3 + (size_t)tok * D) + lane; r0[q] = src[0]; r1[q] = src[64]; }
#pragma unroll
        for (int q = 0; q < 4; ++q) { const int s = s0 + q, tok = unit * 128 + (s >> 1), k = s & 1;
            if (lane == 0) { ((int*)(ws + MS_DEST))[2 * tok + k] = dest[q]; rg[dest[q]] = pg8::rstd16((const float*)(ws + WS_STB), tok); }
            v4u* dst = (v4u*)(xg + (size_t)dest[q] * D) + lane; dst[0] = r0[q]; dst[64] = r1[q]; }
    }
    if (unit < 8) {
        const int e = unit, r0 = sm[16 + e] + sm[e], r1 = sm[16 + e + 1]; const v4u z = {0u, 0u, 0u, 0u};
        for (int r = r0 + wave; r < r1; r += 8) { v4u* dst = (v4u*)(xg + (size_t)r * D) + lane; dst[0] = z; dst[64] = z; if (lane == 0) rg[r] = 0.f; }
    }
    __syncthreads();
}

DI void combine_row(const Args& a, int tok, int lane) {
    unsigned char* ws = a.ws;
    const int d1 = ((const int*)(ws + MS_DEST))[2 * tok], d2 = ((const int*)(ws + MS_DEST))[2 * tok + 1];
    const float w1 = ((const float*)(ws + MS_TOKW))[2 * tok], w2 = ((const float*)(ws + MS_TOKW))[2 * tok + 1];
    const bf16* y = (const bf16*)(ws + WS_XG);
    f32x4* o = (f32x4*)(a.out + (size_t)tok * D) + 4 * lane;
    const v4u* y1 = (const v4u*)(y + (size_t)d1 * D) + 2 * lane; const v4u* y2 = (const v4u*)(y + (size_t)d2 * D) + 2 * lane; const v4u* hh = (const v4u*)((const bf16*)(ws + WS_HB) + (size_t)tok * D) + 2 * lane;
#pragma unroll
    for (int q = 0; q < 2; ++q) { const v4u p1 = y1[q], p2 = y2[q], p0 = hh[q]; const unsigned a1[4] = {p1.x, p1.y, p1.z, p1.w}, a2[4] = {p2.x, p2.y, p2.z, p2.w}, a0[4] = {p0.x, p0.y, p0.z, p0.w};
#pragma unroll
        for (int e = 0; e < 2; ++e) { f32x4 v;
            v[0] = bflo(a0[2 * e]) + w1 * bflo(a1[2 * e]) + w2 * bflo(a2[2 * e]); v[1] = bfhi(a0[2 * e]) + w1 * bfhi(a1[2 * e]) + w2 * bfhi(a2[2 * e]);
            v[2] = bflo(a0[2 * e + 1]) + w1 * bflo(a1[2 * e + 1]) + w2 * bflo(a2[2 * e + 1]); v[3] = bfhi(a0[2 * e + 1]) + w1 * bfhi(a1[2 * e + 1]) + w2 * bfhi(a2[2 * e + 1]); o[2 * q + e] = v; } }
}

DI void combine_rows4(const Args& a, int tok0, int stride, int lane) {
    unsigned char* ws = a.ws; const bf16* y = (const bf16*)(ws + WS_XG);
    int d1[4], d2[4]; float w1[4], w2[4]; v4u p0[4][2], p1[4][2], p2[4][2];
#pragma unroll
    for (int r = 0; r < 4; ++r) { const int tok = tok0 + r * stride < T ? tok0 + r * stride : tok0;
        d1[r] = ((const int*)(ws + MS_DEST))[2 * tok]; d2[r] = ((const int*)(ws + MS_DEST))[2 * tok + 1]; w1[r] = ((const float*)(ws + MS_TOKW))[2 * tok]; w2[r] = ((const float*)(ws + MS_TOKW))[2 * tok + 1];
        const v4u* hh = (const v4u*)((const bf16*)(ws + WS_HB) + (size_t)tok * D) + 2 * lane; p0[r][0] = hh[0]; p0[r][1] = hh[1]; }
#pragma unroll
    for (int r = 0; r < 4; ++r) { const v4u* y1 = (const v4u*)(y + (size_t)d1[r] * D) + 2 * lane; const v4u* y2 = (const v4u*)(y + (size_t)d2[r] * D) + 2 * lane; p1[r][0] = y1[0]; p1[r][1] = y1[1]; p2[r][0] = y2[0]; p2[r][1] = y2[1]; }
#pragma unroll
    for (int r = 0; r < 4; ++r) { const int tok = tok0 + r * stride; if (tok >= T) break;
        f32x4* o = (f32x4*)(a.out + (size_t)tok * D) + 4 * lane;
#pragma unroll
        for (int q = 0; q < 2; ++q) { const unsigned a0[4] = {p0[r][q].x, p0[r][q].y, p0[r][q].z, p0[r][q].w}, a1[4] = {p1[r][q].x, p1[r][q].y, p1[r][q].z, p1[r][q].w}, a2[4] = {p2[r][q].x, p2[r][q].y, p2[r][q].z, p2[r][q].w};
#pragma unroll
            for (int e = 0; e < 2; ++e) { f32x4 v;
                v[0] = bflo(a0[2 * e]) + w1[r] * bflo(a1[2 * e]) + w2[r] * bflo(a2[2 * e]); v[1] = bfhi(a0[2 * e]) + w1[r] * bfhi(a1[2 * e]) + w2[r] * bfhi(a2[2 * e]);
                v[2] = bflo(a0[2 * e + 1]) + w1[r] * bflo(a1[2 * e + 1]) + w2[r] * bflo(a2[2 * e + 1]); v[3] = bfhi(a0[2 * e + 1]) + w1[r] * bfhi(a1[2 * e + 1]) + w2[r] * bfhi(a2[2 * e + 1]); o[2 * q + e] = v; } } }
}
constexpr int NPHASE = 23;
#ifndef MK_SUB
#define MK_SUB 3
#endif
#ifndef MK_ONE_LAUNCH
#define MK_ONE_LAUNCH 1
#endif
template <int P> DI void moe_pass(const Args& args, LAS unsigned char* lds, int G, int which  ) {
    unsigned char* ws = args.ws;
    const int* te = (const int*)(ws + MS_TILEE); const int ntiles = te[MAXTILES];
    const int lo = PASS_TILES * P, hi = (P == 3) ? ntiles : (ntiles < PASS_TILES * (P + 1) ? ntiles : PASS_TILES * (P + 1));
    if (lo >= hi) return;
    if (which == 0) {
        pg8::Gemm g{(const bf16*)(ws + WS_XG), (const bf16*)args.out, MAXTILES * 256, 2 * FFE, D};
        pg8::MoeOrder S{lo, hi, 2 * FFE / 256, G, (int)blockIdx.x, te};
        pg8::EpiSwiGLU<true> E{(bf16*)(ws + WS_ACT), FFE, (const float*)(ws + MS_RG), 2 * FFE / 256, lo};
        pg8::gemm_phase<pg8::EpiSwiGLU<true>, pg8::MoeOrder, true, true>(lds, g, S, E);
    } else {
        pg8::Gemm g{(const bf16*)(ws + WS_ACT) - (size_t)lo * 256 * FFE, (const bf16*)(ws + WS_WMD), MAXTILES * 256, D, FFE};
        pg8::MoeOrder S{lo, hi, D / 256, G, (int)blockIdx.x, te};
        pg8::EpiPlain E{(bf16*)(ws + WS_XG)};
        pg8::gemm_phase<pg8::EpiPlain, pg8::MoeOrder, true, true>(lds, g, S, E);
    }
}

__global__ void __launch_bounds__(NTHREADS, 2) fwd(Args args) {
    extern __shared__ __attribute__((aligned(16))) unsigned char lds_raw[];
    LAS unsigned char* lds = (LAS unsigned char*)lds_raw;
    volatile LAS unsigned* MISC = (volatile LAS unsigned*)(lds + MISC_OFF);
    const int tid = threadIdx.x, lane = tid & 63, wave = __builtin_amdgcn_readfirstlane(tid >> 6);
    const int G = gridDim.x, bx = blockIdx.x;
    const int vcu = (G % 8 == 0) ? (bx % 8) * (G / 8) + bx / 8 : bx;
    const int gw = vcu * NWAVES + wave, NGW = G * NWAVES;
    unsigned char* ws = args.ws;
    gu32* ctl = (gu32*)(ws + WS_CTL);
    for (int u = tid; u < (LDS_BYTES - LDSCTL_OFF) / 4; u += NTHREADS) ((LAS unsigned*)(lds + LDSCTL_OFF))[u] = 0u;
    __syncthreads();
    const int lo = args.ph_lo, hi = args.ph_hi;
    XcdBarrier bar; bar.bar = (unsigned*)(ctl + CW_BAR); bar.x = 0; bar.st = nullptr;
    if (hi - lo > 1) bar = xcd_barrier_post((unsigned*)(ctl + CW_BAR), MISC + 8);
#ifndef MK_PHMASK
#define MK_PHMASK 0x7fffffu
#endif
#define IN(k) ((((MK_PHMASK) >> (k)) & 1u) && lo <= (k) && (k) < hi)
#ifndef MK_STAMPMASK
#define MK_STAMPMASK 0u
#endif
    unsigned long long st_acc = 0ull, st_t0 = 0ull;
#ifndef MK_SUBSTAMP
#define MK_SUBSTAMP 0
#endif
#define SUBSTAMP_BEGIN(i) do { if (MK_SUBSTAMP == (i)) st_t0 = __builtin_amdgcn_s_memrealtime(); } while (0)
#define SUBSTAMP_END(i) do { if (MK_SUBSTAMP == (i)) st_acc += __builtin_amdgcn_s_memrealtime() - st_t0; } while (0)
#define STAMPED(k) ((((MK_STAMPMASK) >> (k)) & 1u) != 0u)
#define SEAM(k) do { if (IN(k) && IN((k) + 1)) xcd_barrier(bar); if (STAMPED(k)) st_acc += __builtin_amdgcn_s_memrealtime() - st_t0; } while (0)
#ifndef MK_DUP
#define MK_DUP -1
#endif
#define PH(k, ...) if (STAMPED(k)) st_t0 = __builtin_amdgcn_s_memrealtime(); if (IN(k)) { if (MK_DUP == (k)) { int o_tid = tid; asm volatile("" : "+v"(o_tid)); unsigned long long o_ws = (unsigned long long)ws; asm volatile("" : "+s"(o_ws)); \
        { const int tid = o_tid, lane = tid & 63, wave = __builtin_amdgcn_readfirstlane(tid >> 6); unsigned char* const ws = (unsigned char*)o_ws; const int gw = vcu * NWAVES + wave; (void)lane; (void)gw; (void)ws; \
          const bool dry = (args.ph_hi > 0); (void)dry; __VA_ARGS__ } xcd_barrier(bar); } \
        { const bool dry = false; (void)dry; __VA_ARGS__ } } SEAM(k);

    PH(0,  phase_prologue(args, lds, gw, NGW, wave, lane); __syncthreads(); )

    PH(1,
        pg8::Gemm g{(const bf16*)(ws + WS_HB), (const bf16*)(ws + W0_IN), T, E_IN, D}; pg8::StaticOrder S; S.init(T, E_IN, G, bx);
        pg8::rstd_prepass(S, (const float*)(ws + WS_STA), (float*)(ws + MS_RC));
        pg8::EpiProj<0> E{(bf16*)(ws + WS_PROJ0), E_IN, (const float*)(ws + MS_RC), nullptr, nullptr};
        pg8::gemm_phase<pg8::EpiProj<0>, pg8::StaticOrder, true, true>(lds, g, S, E);
    )

    PH(2,
        if (MK_SUB & 1) { LruFrags LF; lru_frags(args, lds, LF, wave, lane); __syncthreads(); for (int u = vcu; u < NB * 128; u += G) lru_unit(args, lds, LF, u, wave, lane); }
        __syncthreads();
        if (MK_SUB & 2) for (int u = vcu; u < NB * 128 * 2; u += G) attn_unit(args, lds, u, tid, wave, lane);
    )

    PH(3,  for (int u = vcu; u < NB * 128; u += G) lrufix_unit(args, u, tid); )

    PH(4,
        pg8::Gemm g{(const bf16*)(ws + WS_YMIX), (const bf16*)(ws + W0_OUT), T, D, D}; pg8::StaticOrder S; S.init(T, D, G, bx);
        pg8::EpiResid E{(bf16*)(ws + WS_HB), (float*)(ws + WS_STB)};
        pg8::gemm_phase<pg8::EpiResid, pg8::StaticOrder, true, true>(lds, g, S, E);
    )

    PH(5,
        pg8::Gemm g{(const bf16*)(ws + WS_HB), (const bf16*)(ws + W0_GU), T, 2 * FF0, D}; pg8::StaticOrder S; S.init(T, 2 * FF0, G, bx);
        pg8::rstd_prepass(S, (const float*)(ws + WS_STB), (float*)(ws + MS_RC));
        pg8::EpiSwiGLU<false> E{(bf16*)(ws + WS_ACT0), FF0, (const float*)(ws + MS_RC), 0, 0};
        pg8::gemm_phase<pg8::EpiSwiGLU<false>, pg8::StaticOrder, true, true>(lds, g, S, E);
    )

    PH(6,
        pg8::Gemm g{(const bf16*)(ws + WS_ACT0), (const bf16*)(ws + W0_DN), T, D, FF0}; pg8::StaticOrder S; S.init(T, D, G, bx);
        pg8::EpiResid E{(bf16*)(ws + WS_HB), (float*)(ws + WS_STA)};
        pg8::gemm_phase<pg8::EpiResid, pg8::StaticOrder, true, true>(lds, g, S, E);
    )

    PH(7,
        pg8::Gemm g{(const bf16*)(ws + WS_HB), (const bf16*)(ws + W1_IN), T, 4096, D}; pg8::StaticOrder S; S.init(T, 4096, G, bx);
        pg8::rstd_prepass(S, (const float*)(ws + WS_STA), (float*)(ws + MS_RC));
        pg8::EpiProj<1> E{(bf16*)(ws + WS_QKV), 3072, (const float*)(ws + MS_RC), (bf16*)(ws + WS_GATE), (bf16*)(ws + WS_HALO)};
        pg8::gemm_phase<pg8::EpiProj<1>, pg8::StaticOrder, true, true>(lds, g, S, E);
        for (int t = gw; t < T / 16; t += NGW) skinny_tile(args, t, lane);
    )

    PH(8,  SUBSTAMP_BEGIN(1); for (int u = vcu; u < NB * NCH; u += G) conv_unit(args, u, tid);
        if (hi - lo > 1) xcd_barrier(bar); SUBSTAMP_END(1);
        SUBSTAMP_BEGIN(2); prep_phase(args, lds, vcu, G, (NUNIT - vcu + G - 1) / G, tid, wave, lane, dry, st_acc); SUBSTAMP_END(2); )

    PH(9,
        volatile LAS int* sq = (volatile LAS int*)(lds + LDSCTL_OFF + 64);
        if (tid == 0) { const unsigned x = xb_xcc_id() & 7u; const unsigned t = __hip_atomic_fetch_add((unsigned*)(ctl + CW_SCANQ + 64 * x), 1u, __ATOMIC_RELAXED, __HIP_MEMORY_SCOPE_AGENT);
            unsigned n[8]; unsigned tot = 0;
            for (int j = 0; j < 8; ++j) { n[j] = __hip_atomic_load((unsigned*)(ctl + CW_BAR) + XB_XCNT(j), __ATOMIC_RELAXED, __HIP_MEMORY_SCOPE_AGENT); tot += n[j]; }
            int chain = -1, wrank = 0, nwork = 0;
            if (tot != (unsigned)G || hi - lo <= 1) { chain = vcu < 128 ? vcu : -1; wrank = vcu - 128; nwork = G - 128; }
            else if (t < 16u) chain = (int)((2u * x + (t >> 3)) * 8u + (t & 7u));
            else { unsigned w = t - 16u, nl = 0, nw = 0;
                for (int j = 0; j < 8; ++j) { if ((unsigned)j < x && n[j] > 16u) w += n[j] - 16u; nl += n[j] < 16u ? 16u - n[j] : 0u; nw += n[j] > 16u ? n[j] - 16u : 0u; }
                if (w < nl) { unsigned r = w;
                    for (int j = 0; j < 8; ++j) { const unsigned lj = n[j] < 16u ? 16u - n[j] : 0u; if (chain < 0) { if (r < lj) { const unsigned tt = n[j] + r; chain = (int)((2u * j + (tt >> 3)) * 8u + (tt & 7u)); } else r -= lj; } } }
                else { wrank = (int)(w - nl); nwork = (int)(nw - nl); } }
            sq[0] = chain; sq[1] = wrank; sq[2] = nwork; }
        __syncthreads();
        const int chain = sq[0]; const int wrank = sq[1]; const int nwork = sq[2];
        __syncthreads();
        SUBSTAMP_BEGIN(6); if (chain >= 0) scan_chain(args, lds, chain, tid, wave, lane, dry); SUBSTAMP_END(6);
        SUBSTAMP_BEGIN(7); if (chain < 0 && nwork > 0) { moe_convert(args, wrank * NWAVES + wave, nwork * NWAVES, lane); } SUBSTAMP_END(7);
        if (G < 128 + 1) { moe_convert(args, gw, NGW, lane); }
    )

    PH(10,
        LAS float* red = (LAS float*)lds; int it = 0;
        for (int u = vcu; u < NUNIT; u += G, ++it) onorm_unit(args, red, u, it, wave, lane);
        __syncthreads();
    )

    PH(11,
        pg8::Gemm g{(const bf16*)(ws + WS_ON), (const bf16*)(ws + W1_OUT), T, D, D}; pg8::StaticOrder S; S.init(T, D, G, bx);
        pg8::EpiResid E{(bf16*)(ws + WS_HB), (float*)(ws + WS_STB)};
        pg8::gemm_phase<pg8::EpiResid, pg8::StaticOrder, true, true>(lds, g, S, E);
    )

    PH(12,  for (int u = vcu; u < 256; u += G) route_unit(args, (LAS int*)lds, u, wave, lane); )
    PH(13,  for (int u = vcu; u < 256; u += G) gather_unit(args, (LAS int*)lds, u, tid, wave, lane); )

    PH(14, moe_pass<0>(args, lds, G, 0);)
    PH(15, moe_pass<0>(args, lds, G, 1);)
    PH(16, moe_pass<1>(args, lds, G, 0);)
    PH(17, moe_pass<1>(args, lds, G, 1);)
    PH(18, moe_pass<2>(args, lds, G, 0);)
    PH(19, moe_pass<2>(args, lds, G, 1);)
    PH(20, moe_pass<3>(args, lds, G, 0);)
    PH(21, moe_pass<3>(args, lds, G, 1);)

    PH(22, for (int t = gw; t < T; t += 4 * NGW) combine_rows4(args, t, NGW, lane); )
    if ((MK_STAMPMASK != 0u || MK_SUBSTAMP != 0) && blockIdx.x == 0 && tid == 0) { const unsigned long long t1 = __builtin_amdgcn_s_memrealtime(); while (__builtin_amdgcn_s_memrealtime() - t1 < st_acc) __builtin_amdgcn_s_sleep(8); }
#undef IN
#undef SEAM
#undef PH
}

extern "C" void kernel_launch(void* const* d_in, const int* in_sizes, int n_in, void* d_out, int out_size, void* d_ws, size_t ws_size, hipStream_t stream) {
    static int grid = 0;
    if (grid == 0) {
        if (n_in != 28 || out_size != T * D || ws_size < WS_END) { fprintf(stderr, "kernel_launch: unexpected problem (n_in %d, out %d, ws %zu)\n", n_in, out_size, ws_size); grid = -1; return; }
        int dev = 0, cus = 0, per_cu = 0;
        if (hipGetDevice(&dev) != hipSuccess || hipDeviceGetAttribute(&cus, hipDeviceAttributeMultiprocessorCount, dev) != hipSuccess) { grid = -1; return; }
        if (hipFuncSetAttribute((const void*)fwd, hipFuncAttributeMaxDynamicSharedMemorySize, LDS_BYTES) != hipSuccess) { fprintf(stderr, "kernel_launch: hipFuncSetAttribute failed\n"); grid = -1; return; }
        if (hipOccupancyMaxActiveBlocksPerMultiprocessor(&per_cu, (const void*)fwd, NTHREADS, LDS_BYTES) != hipSuccess || per_cu < 1) fprintf(stderr, "kernel_launch: occupancy query says %d\n", per_cu);
        (void)hipGetLastError();
        grid = cus;
    }
    if (grid < 0) return;
    if (hipMemsetAsync((char*)d_ws + WS_CTL, 0, CTL_ZERO_BYTES, stream) != hipSuccess) return;
    Args a{};
    for (int i = 0; i < 28; ++i) a.in[i] = (const float*)d_in[i];
    a.out = (float*)d_out; a.ws = (unsigned char*)d_ws;
#if MK_ONE_LAUNCH
    a.ph_lo = 0; a.ph_hi = NPHASE;
    hipLaunchKernelGGL(fwd, dim3(grid), dim3(NTHREADS), LDS_BYTES, stream, a);
#else
    for (int p = 0; p < NPHASE; ++p) { a.ph_lo = p; a.ph_hi = p + 1; hipLaunchKernelGGL(fwd, dim3(grid), dim3(NTHREADS), LDS_BYTES, stream, a); }
#endif
}
```

```cpp
#include <hip/hip_runtime.h>
#include <cstdio>
#include <cstdint>
#include <cmath>
namespace pg8 {
#define PG8_LAS __attribute__((address_space(3)))
typedef unsigned short bf16_t;
typedef short bf16x8 __attribute__((ext_vector_type(8)));
typedef float f32x4 __attribute__((ext_vector_type(4)));
typedef unsigned u32x4 __attribute__((ext_vector_type(4)));
constexpr int BM = 256, BK = 64, HALF = 128, HTB = HALF * BK * 2  , STAGE_BYTES = 8 * HTB, NXCD = 8, WGM = 8;

__host__ __device__ __forceinline__ int lds_byte(int r, int c) { const int st = (r >> 4) * 2 + (c >> 5), rr = r & 15, cc = c & 31, ob = rr * 64 + cc * 2; return st * 1024 + (ob ^ (((ob >> 9) & 1) << 5)); }
__host__ __device__ __forceinline__ void stage_rc(int b, int& R, int& C) { const int st = b / 1024, sb = b % 1024, swz = sb ^ (((sb >> 9) & 1) << 5); R = (st >> 1) * 16 + swz / 64; C = (st & 1) * 32 + (swz % 64) / 2; }
__host__ __device__ __forceinline__ int perm32(int rho) { const int n = rho >> 4, i = rho & 15; return 8 * (i >> 2) + 4 * n + (i & 3); }

struct Unit { int pm, pn; };
struct Gemm { const bf16_t* A; const bf16_t* Bt; int M, N, K; };

struct StaticOrder {
    int nM, nN, nwg, G, c;
    __host__ __device__ void init(int M, int N, int G_, int c_) { nM = M / BM; nN = N / BM; nwg = nM * nN; G = G_; c = c_; }
    __host__ __device__ bool next(int i, Unit& u) const {
        const long L = (long)i * G + c; if (L >= nwg) return false;
        int wgid = (int)L; { const int q = nwg / NXCD, r = nwg % NXCD, xcd = wgid % NXCD, off = wgid / NXCD; wgid = (xcd < r ? xcd * (q + 1) : r * (q + 1) + (xcd - r) * q) + off; }
        const int nig = WGM * nN, gid = wgid / nig, fm = gid * WGM, gsz = (nM - fm) < WGM ? (nM - fm) : WGM;
        u.pm = fm + ((wgid % nig) % gsz); u.pn = (wgid % nig) / gsz; return true;
    }
    __device__ __forceinline__ void a_ready(const Unit&) const {}
    __device__ __forceinline__ void done(const Unit&) const {}
};

__device__ __forceinline__ unsigned cvt_pk_bf16(float lo, float hi) { unsigned r; asm volatile("v_cvt_pk_bf16_f32 %0, %1, %2" : "=v"(r) : "v"(lo), "v"(hi)); return r; }
typedef float f32x2 __attribute__((ext_vector_type(2)));
__device__ __forceinline__ float rstd16(const float* st, int row) {
    const f32x4* p = (const f32x4*)(st + (size_t)row * 16); const f32x4 a = p[0], b = p[1], c = p[2], d = p[3];
    const float s = ((a[0] + a[1]) + (a[2] + a[3])) + ((b[0] + b[1]) + (b[2] + b[3])) + ((c[0] + c[1]) + (c[2] + c[3])) + ((d[0] + d[1]) + (d[2] + d[3]));
    return __builtin_amdgcn_rsqf(s * (1.0f / 1024.0f) + 1e-6f);
}
__device__ __forceinline__ u32x4 pack8(const f32x4 v0, const f32x4 v1) { u32x4 w; w.x = cvt_pk_bf16(v0[0], v0[1]); w.y = cvt_pk_bf16(v0[2], v0[3]); w.z = cvt_pk_bf16(v1[0], v1[1]); w.w = cvt_pk_bf16(v1[2], v1[3]); return w; }
__device__ __forceinline__ float silu_f(float x) { return x * __builtin_amdgcn_rcpf(1.0f + __expf(-x)); }

template <int MODE> struct EpiProj {
    static constexpr bool PERM = true, AFTER_DRAIN = false;
    bf16_t* O; int ldo; const float* stats; bf16_t* gate; bf16_t* halo;
    __device__ __forceinline__ void operator()(const f32x4 (&acc)[2][2][4][2], const Unit& u, int wr, int wc, int fr, int fq) const {
        const int row0 = u.pm * BM + wr * 64 + fr, col0 = u.pn * BM + wc * 32 + 8 * fq;
#pragma unroll
        for (int ai = 0; ai < 2; ++ai)
#pragma unroll
            for (int m = 0; m < 4; ++m) { const int row = row0 + ai * HALF + m * 16; const float rs = stats[row];
#pragma unroll
                for (int bj = 0; bj < 2; ++bj) { const int col = col0 + bj * HALF; const u32x4 w = pack8(acc[ai][bj][m][0] * rs, acc[ai][bj][m][1] * rs);
                    if (MODE == 0) { *(u32x4*)(O + (size_t)row * ldo + col) = w; }
                    else { if (col < 3072) { *(u32x4*)(O + (size_t)row * 3072 + col) = w; const int t = row & 63; if (t >= 61) *(u32x4*)(halo + ((size_t)(row >> 6) * 3 + (t - 61)) * 3072 + col) = w; }
                           else *(u32x4*)(gate + (size_t)row * 1024 + (col - 3072)) = w; } } }
    }
};
struct EpiResid {
    static constexpr bool PERM = true, AFTER_DRAIN = false;
    bf16_t* hb; float* stats;
    __device__ __forceinline__ void operator()(const f32x4 (&acc)[2][2][4][2], const Unit& u, int wr, int wc, int fr, int fq) const {
        const int row0 = u.pm * BM + wr * 64 + fr, col0 = u.pn * BM + wc * 32 + 8 * fq;
#pragma unroll
        for (int ai = 0; ai < 2; ++ai)
#pragma unroll
            for (int m = 0; m < 4; ++m) { const int row = row0 + ai * HALF + m * 16; float ss = 0.f;
#pragma unroll
                for (int bj = 0; bj < 2; ++bj) { const size_t off = (size_t)row * 1024 + col0 + bj * HALF;
                    const u32x4 r = *(const u32x4*)(hb + off);
                    const f32x4 r0 = {__builtin_bit_cast(float, r.x << 16), __builtin_bit_cast(float, r.x & 0xffff0000u), __builtin_bit_cast(float, r.y << 16), __builtin_bit_cast(float, r.y & 0xffff0000u)};
                    const f32x4 r1 = {__builtin_bit_cast(float, r.z << 16), __builtin_bit_cast(float, r.z & 0xffff0000u), __builtin_bit_cast(float, r.w << 16), __builtin_bit_cast(float, r.w & 0xffff0000u)};
                    const f32x4 v0 = acc[ai][bj][m][0] + r0, v1 = acc[ai][bj][m][1] + r1;
                    *(u32x4*)(hb + off) = pack8(v0, v1);
                    ss += ((v0[0] * v0[0] + v0[1] * v0[1]) + (v0[2] * v0[2] + v0[3] * v0[3])) + ((v1[0] * v1[0] + v1[1] * v1[1]) + (v1[2] * v1[2] + v1[3] * v1[3])); }
                ss += __shfl_xor(ss, 16); ss += __shfl_xor(ss, 32);
                if (fq == 0) stats[(size_t)row * 16 + (u.pn & 3) * 4 + wc] = ss; }
    }
};
template <bool MOE> struct EpiSwiGLU {
    static constexpr bool PERM = true, AFTER_DRAIN = false;
    bf16_t* O; int ldo; const float* stats; int ntn, pm_lo;
    __device__ __forceinline__ void operator()(const f32x4 (&acc)[2][2][4][2], const Unit& u, int wr, int wc, int fr, int fq) const {
        const int pnl = MOE ? (u.pn % ntn) : u.pn;
        const int row0 = u.pm * BM + wr * 64 + fr, col = pnl * HALF + wc * 32 + 8 * fq;
#pragma unroll
        for (int ai = 0; ai < 2; ++ai)
#pragma unroll
            for (int m = 0; m < 4; ++m) { const int row = row0 + ai * HALF + m * 16; const float rs = MOE ? 1.0f : stats[row];
                const f32x4 g0 = acc[ai][0][m][0] * rs, g1 = acc[ai][0][m][1] * rs, u0 = acc[ai][1][m][0] * rs, u1 = acc[ai][1][m][1] * rs; f32x4 a0, a1;
#pragma unroll
                for (int i = 0; i < 4; ++i) { a0[i] = silu_f(g0[i]) * u0[i]; a1[i] = silu_f(g1[i]) * u1[i]; }
                *(u32x4*)(O + (size_t)(row - pm_lo * BM) * ldo + col) = pack8(a0, a1); }
    }
};
struct EpiPlain {
    static constexpr bool PERM = true, AFTER_DRAIN = false;
    bf16_t* O;
    __device__ __forceinline__ void operator()(const f32x4 (&acc)[2][2][4][2], const Unit& u, int wr, int wc, int fr, int fq) const {
        const int row0 = u.pm * BM + wr * 64 + fr, col0 = (u.pn & 3) * BM + wc * 32 + 8 * fq;
#pragma unroll
        for (int ai = 0; ai < 2; ++ai)
#pragma unroll
            for (int m = 0; m < 4; ++m) { const int row = row0 + ai * HALF + m * 16;
#pragma unroll
                for (int bj = 0; bj < 2; ++bj) *(u32x4*)(O + (size_t)row * 1024 + col0 + bj * HALF) = pack8(acc[ai][bj][m][0], acc[ai][bj][m][1]); }
    }
};
template <class Sched> __device__ __forceinline__ void rstd_prepass(const Sched& S, const float* st, float* rc) {
    Unit u; const int tid = threadIdx.x;
    for (int i = 0; S.next(i, u); ++i) { const int row = u.pm * BM + (tid >> 1); const f32x4* p = (const f32x4*)(st + (size_t)row * 16) + 2 * (tid & 1); const f32x4 a = p[0], b = p[1];
        float s = ((a[0] + a[1]) + (a[2] + a[3])) + ((b[0] + b[1]) + (b[2] + b[3])); s += __shfl_xor(s, 1);
        if ((tid & 1) == 0) rc[row] = __builtin_amdgcn_rsqf(s * (1.0f / 1024.0f) + 1e-6f); }
    asm volatile("s_waitcnt vmcnt(0)" ::: "memory"); __syncthreads();
}
struct GroupOrder {
    int nM, nN, G, c;
    __device__ __forceinline__ void init(int M, int N, int G_, int c_) { nM = M / BM; nN = N / BM; G = G_; c = c_; }
    __device__ __forceinline__ bool next(int i, Unit& u) const {
        const long L = (long)i * G + c; if (L >= (long)nM * nN) return false;
        const int grp = (int)(L / (8 * nN)), fm = grp * 8, gsz = (nM - fm) < 8 ? (nM - fm) : 8, w = (int)(L - (long)grp * 8 * nN);
        u.pm = fm + (w % gsz); u.pn = w / gsz; return true;
    }
    __device__ __forceinline__ void a_ready(const Unit&) const {}
    __device__ __forceinline__ void done(const Unit&) const {}
};
struct MoeOrder {
    int lo, hi, NT, G, c; const int* tile_e;
    __device__ __forceinline__ bool next(int i, Unit& u) const {
        const long L = (long)i * G + c; const int nt = hi - lo; if (L >= (long)nt * NT) return false;
        const int grp = (int)(L / (8 * NT)), fm = grp * 8, gsz = (nt - fm) < 8 ? (nt - fm) : 8, w = (int)(L - (long)grp * 8 * NT), rt = lo + fm + (w % gsz);
        u.pm = rt; u.pn = tile_e[rt] * NT + (w / gsz); return true;
    }
    __device__ __forceinline__ void a_ready(const Unit&) const {}
    __device__ __forceinline__ void done(const Unit&) const {}
};
template <class Epi, class Sched, bool ALIGN_EPI = false, bool SP2 = false>
__device__ __forceinline__ void gemm_phase(PG8_LAS unsigned char* lds, const Gemm g, const Sched& S, const Epi& E) {
    const int tid = threadIdx.x, wid = __builtin_amdgcn_readfirstlane(tid >> 6), lane = tid & 63, wr = wid >> 2, wc = wid & 3, fr = lane & 15, fq = lane >> 4;
    const int K = g.K, nt = K / BK;
    unsigned voffA[2], voffB[2];
#pragma unroll
    for (int i = 0; i < 2; ++i) { int R, C; stage_rc(tid * 16 + i * 8192, R, C); const int Rb = Epi::PERM ? ((R & ~31) + perm32(R & 31)) : R;
        voffA[i] = (unsigned)(R * K + C) * 2u; voffB[i] = (unsigned)(Rb * K + C) * 2u; }
    const size_t kstep = (size_t)(BK * 2);
    const size_t hstep = (size_t)HALF * K * 2;
    const size_t tstep = 2 * hstep;
    const unsigned ldsw = (unsigned)wid * 1024u;
    const int aoff = lds_byte(wr * 64 + fr, fq * 8), boff = lds_byte(wc * 32 + fr, fq * 8);
#define PG8_SA(b, h) (((b) * 2 + (h)) * HTB)
#define PG8_SB(b, h) ((4 + (b) * 2 + (h)) * HTB)
#define PG8_STAGE(bufoff, gbase, voff) do { _Pragma("unroll") for (int _i = 0; _i < 2; ++_i) \
        __builtin_amdgcn_global_load_lds((const unsigned*)((const char*)(gbase) + (voff)[_i]), (PG8_LAS unsigned*)(lds + (bufoff) + ldsw + _i * 8192), 16, 0, 0); } while (0)
#define PG8_LDA(dst, b, h) do { _Pragma("unroll") for (int m = 0; m < 4; ++m) _Pragma("unroll") for (int k = 0; k < 2; ++k) dst[m][k] = *(const PG8_LAS bf16x8*)(lds + PG8_SA(b, h) + aoff + m * 2048 + k * 1024); } while (0)
#define PG8_LDB(dst, b, h) do { _Pragma("unroll") for (int n = 0; n < 2; ++n) _Pragma("unroll") for (int k = 0; k < 2; ++k) dst[n][k] = *(const PG8_LAS bf16x8*)(lds + PG8_SB(b, h) + boff + n * 2048 + k * 1024); } while (0)
#define PG8_MMA(ai, bj, At, Bt) do { __builtin_amdgcn_s_setprio(1); _Pragma("unroll") for (int m = 0; m < 4; ++m) _Pragma("unroll") for (int n = 0; n < 2; ++n) _Pragma("unroll") for (int k = 0; k < 2; ++k) \
        acc[ai][bj][m][n] = __builtin_amdgcn_mfma_f32_16x16x32_bf16(Bt[n][k], At[m][k], acc[ai][bj][m][n], 0, 0, 0); __builtin_amdgcn_s_setprio(0); } while (0)
#define PG8_WAIT_V(n) asm volatile("s_waitcnt vmcnt(" #n ")" ::: "memory")
#define PG8_WAIT_L(n) asm volatile("s_waitcnt lgkmcnt(" #n ")" ::: "memory")
#define PG8_BAR __builtin_amdgcn_s_barrier()
#define PG8_SCHED __builtin_amdgcn_sched_barrier(0)
    Unit cur, nxt; int ui = 0;
    if (!S.next(0, cur)) return;
    f32x4 acc[2][2][4][2];
#pragma unroll
    for (int a = 0; a < 2; ++a)
#pragma unroll
        for (int b = 0; b < 2; ++b)
#pragma unroll
            for (int m = 0; m < 4; ++m)
#pragma unroll
                for (int n = 0; n < 2; ++n) acc[a][b][m][n] = (f32x4){0.f, 0.f, 0.f, 0.f};
    bf16x8 At[4][2], B0[2][2], B1[2][2];
    const char* cA = (const char*)g.A + (size_t)cur.pm * tstep; const char* cB = (const char*)g.Bt + (size_t)cur.pn * tstep;
    S.a_ready(cur);
    if constexpr (SP2) {
        PG8_STAGE(PG8_SB(0, 0), cB, voffB); PG8_STAGE(PG8_SB(0, 1), cB + hstep, voffB); PG8_STAGE(PG8_SA(0, 0), cA, voffA); PG8_STAGE(PG8_SA(0, 1), cA + hstep, voffA);
        if (wr == 1) PG8_BAR;
        PG8_WAIT_V(2); PG8_BAR;
        PG8_STAGE(PG8_SB(1, 0), cB + kstep, voffB); PG8_STAGE(PG8_SA(1, 0), cA + kstep, voffA); PG8_STAGE(PG8_SB(1, 1), cB + hstep + kstep, voffB);
        PG8_WAIT_V(6); PG8_BAR;
    } else {
        PG8_STAGE(PG8_SB(0, 0), cB, voffB); PG8_STAGE(PG8_SA(0, 0), cA, voffA); PG8_STAGE(PG8_SB(0, 1), cB + hstep, voffB); PG8_STAGE(PG8_SA(0, 1), cA + hstep, voffA);
        if (wr == 1) PG8_BAR;
        PG8_WAIT_V(4); PG8_BAR;
        PG8_STAGE(PG8_SB(1, 0), cB + kstep, voffB); PG8_STAGE(PG8_SA(1, 0), cA + kstep, voffA); PG8_STAGE(PG8_SB(1, 1), cB + hstep + kstep, voffB);
        PG8_WAIT_V(6); PG8_BAR;
    }
    for (;;) {
        const bool has_next = S.next(ui + 1, nxt);
        const char* nA = has_next ? (const char*)g.A + (size_t)nxt.pm * tstep : cA; const char* nB = has_next ? (const char*)g.Bt + (size_t)nxt.pn * tstep : cB;
        for (int t = 0; t < nt; t += 2) {
            const bool last = (t == nt - 2);
            const char* a1 = cA + (size_t)(t + 1) * kstep;
            const char* a2 = last ? nA : cA + (size_t)(t + 2) * kstep; const char* b2 = last ? nB : cB + (size_t)(t + 2) * kstep;
            const char* a3 = a2 + kstep; const char* b3 = b2 + kstep;
            if (last && has_next) S.a_ready(nxt);
            if constexpr (SP2) {
            PG8_LDB(B0, 0, 0); PG8_LDB(B1, 0, 1); PG8_SCHED; PG8_LDA(At, 0, 0); PG8_STAGE(PG8_SA(1, 1), a1 + hstep, voffA);
            PG8_WAIT_V(8); PG8_WAIT_L(0); PG8_BAR; PG8_MMA(0, 0, At, B0); PG8_MMA(0, 1, At, B1); PG8_BAR; PG8_SCHED;
            PG8_LDA(At, 0, 1); PG8_STAGE(PG8_SB(0, 0), b2, voffB); PG8_STAGE(PG8_SB(0, 1), b2 + hstep, voffB); PG8_STAGE(PG8_SA(0, 0), a2, voffA);
            PG8_WAIT_V(8); PG8_WAIT_L(0); PG8_BAR; PG8_MMA(1, 0, At, B0); PG8_MMA(1, 1, At, B1); PG8_BAR; PG8_SCHED;
            PG8_LDB(B0, 1, 0); PG8_LDB(B1, 1, 1); PG8_SCHED; PG8_LDA(At, 1, 0); PG8_STAGE(PG8_SA(0, 1), a2 + hstep, voffA);
            PG8_WAIT_V(8); PG8_WAIT_L(0); PG8_BAR; PG8_MMA(0, 0, At, B0); PG8_MMA(0, 1, At, B1); PG8_BAR; PG8_SCHED;
            PG8_LDA(At, 1, 1); PG8_STAGE(PG8_SB(1, 0), b3, voffB); PG8_STAGE(PG8_SB(1, 1), b3 + hstep, voffB); PG8_STAGE(PG8_SA(1, 0), a3, voffA);
            PG8_WAIT_V(8); PG8_WAIT_L(0); PG8_BAR; PG8_MMA(1, 0, At, B0); PG8_MMA(1, 1, At, B1); PG8_BAR; PG8_SCHED;
            } else {
            PG8_LDB(B0, 0, 0); PG8_SCHED; PG8_LDA(At, 0, 0); PG8_STAGE(PG8_SA(1, 1), a1 + hstep, voffA);
            PG8_WAIT_L(8); PG8_BAR; PG8_WAIT_L(0); PG8_MMA(0, 0, At, B0); PG8_BAR; PG8_SCHED;
            PG8_LDB(B1, 0, 1); PG8_STAGE(PG8_SB(0, 0), b2, voffB);
            PG8_BAR; PG8_WAIT_L(0); PG8_MMA(0, 1, At, B1); PG8_BAR;
            PG8_LDA(At, 0, 1); PG8_STAGE(PG8_SA(0, 0), a2, voffA);
            PG8_BAR; PG8_WAIT_L(0); PG8_MMA(1, 0, At, B0); PG8_BAR; PG8_SCHED;
            PG8_STAGE(PG8_SB(0, 1), b2 + hstep, voffB);
            PG8_WAIT_V(6); PG8_BAR; PG8_MMA(1, 1, At, B1); PG8_BAR;
            PG8_LDB(B0, 1, 0); PG8_SCHED; PG8_LDA(At, 1, 0); PG8_STAGE(PG8_SA(0, 1), a2 + hstep, voffA);
            PG8_WAIT_L(8); PG8_BAR; PG8_WAIT_L(0); PG8_MMA(0, 0, At, B0); PG8_BAR; PG8_SCHED;
            PG8_LDB(B1, 1, 1); PG8_STAGE(PG8_SB(1, 0), b3, voffB);
            PG8_BAR; PG8_WAIT_L(0); PG8_MMA(0, 1, At, B1); PG8_BAR;
            PG8_LDA(At, 1, 1); PG8_STAGE(PG8_SA(1, 0), a3, voffA);
            PG8_BAR; PG8_WAIT_L(0); PG8_MMA(1, 0, At, B0); PG8_BAR; PG8_SCHED;
            PG8_STAGE(PG8_SB(1, 1), b3 + hstep, voffB);
            PG8_WAIT_V(6); PG8_BAR; PG8_MMA(1, 1, At, B1); PG8_BAR;
            }
        }
        if constexpr (ALIGN_EPI) { if (wr == 0) PG8_BAR; }
        if constexpr (!Epi::AFTER_DRAIN) { E(acc, cur, wr, wc, fr, fq); S.done(cur); }
        if (!has_next) break;
#pragma unroll
        for (int a = 0; a < 2; ++a)
#pragma unroll
            for (int b = 0; b < 2; ++b)
#pragma unroll
                for (int m = 0; m < 4; ++m)
#pragma unroll
                    for (int n = 0; n < 2; ++n) acc[a][b][m][n] = (f32x4){0.f, 0.f, 0.f, 0.f};
        cur = nxt; cA = nA; cB = nB; ++ui;
        if constexpr (ALIGN_EPI) { if (wr == 1) PG8_BAR; }
    }
    PG8_WAIT_V(0);
    if constexpr (!ALIGN_EPI) { if (wr == 0) PG8_BAR; }
    PG8_BAR;
    if constexpr (Epi::AFTER_DRAIN) { E.fused(acc, cur, wr, wc, fr, fq, lds, wid, lane); S.done(cur); }
#undef PG8_SA
#undef PG8_SB
#undef PG8_STAGE
#undef PG8_LDA
#undef PG8_LDB
#undef PG8_MMA
#undef PG8_WAIT_V
#undef PG8_WAIT_L
#undef PG8_BAR
#undef PG8_SCHED
}
}
constexpr int NWAVES = 8, NTHREADS = 512;
constexpr int SEQ = 16384, NB = 2, T = NB * SEQ, D = 1024;
constexpr int E_IN = 1792, LRU_W = 512, FF0 = 2816;
constexpr int O_IN = 4112, GH = 8, GD = 128, GC = 64, NCH = SEQ / GC  , NUNIT = NB * GH * NCH  ;
constexpr int NE = 8, FFE = 3584;
constexpr int MAXTILES = 264, PASS_TILES = 64;
constexpr float EPS = 1e-6f;

constexpr size_t MiB = 1u << 20;
constexpr size_t WS_CTL = 0, CTL_ZERO_BYTES = 1 * MiB;
constexpr size_t WS_ROPE = 1 * MiB;
constexpr size_t WS_STA = 5 * MiB, WS_STB = 7 * MiB;
constexpr size_t WS_MISC = 9 * MiB;
constexpr size_t MS_LRU_A = WS_MISC, MS_LRU_H = WS_MISC + 512 * 1024;
constexpr size_t MS_TOKE = WS_MISC + 1 * MiB;
constexpr size_t MS_TOKW = MS_TOKE + 128 * 1024;
constexpr size_t MS_RANK = MS_TOKW + 256 * 1024;
constexpr size_t MS_DEST = MS_RANK + 256 * 1024;
constexpr size_t MS_CNT = MS_DEST + 256 * 1024;
constexpr size_t MS_TILEE = MS_CNT + 8 * 1024;
constexpr size_t MS_RG = MS_TILEE + 2 * 1024;
constexpr size_t MS_GLAST = WS_MISC + 3 * MiB;
constexpr size_t MS_WSK = MS_GLAST + 16 * 1024;
constexpr size_t MS_ROUT = MS_WSK + 32 * 1024;
constexpr size_t MS_RC = MS_ROUT + 32 * 1024;
constexpr size_t MS_AB = MS_RC + 128 * 1024;
constexpr size_t WS_W0 = 13 * MiB;
constexpr size_t W0_IN = WS_W0, W0_OUT = W0_IN + (size_t)E_IN * D * 2, W0_GU = W0_OUT + (size_t)D * D * 2, W0_DN = W0_GU + (size_t)2 * FF0 * D * 2;
constexpr size_t WS_HALO = 13 * MiB;
constexpr size_t W1_OUT = 35 * MiB;
constexpr size_t WS_AB = 37 * MiB;
constexpr size_t WS_HB = 40 * MiB;
constexpr size_t WS_PROJ0 = 104 * MiB;
constexpr size_t WS_LRUH = 216 * MiB, WS_LRUP = 280 * MiB;
constexpr size_t WS_YMIX = 344 * MiB;
constexpr size_t W1_IN = 408 * MiB;
constexpr size_t WS_ACT0 = 104 * MiB;
constexpr size_t WS_QKV = 104 * MiB;
constexpr size_t WS_GATE = 296 * MiB;
constexpr size_t WS_UT = 360 * MiB;
constexpr size_t WS_AQK = 424 * MiB;
constexpr size_t WS_WMD = 456 * MiB;
constexpr size_t WS_ON = 104 * MiB;
constexpr size_t WS_XG = 168 * MiB;
constexpr size_t WS_ACT = 300 * MiB;
constexpr size_t WS_END = 512 * MiB;
static_assert(W0_DN + (size_t)D * FF0 * 2 <= W1_OUT && MS_AB <= WS_W0 && WS_HALO + (size_t)NB * NCH * 3 * 3072 * 2 <= W1_OUT, "ws map");
static_assert(WS_XG + (size_t)MAXTILES * 256 * 1024 * 2 <= WS_ACT && WS_ACT + (size_t)(PASS_TILES + 8) * 256 * FFE * 2 <= WS_WMD && WS_WMD + (size_t)NE * D * FFE * 2 <= WS_END, "ws map (MoE)");
constexpr int CW_TMO = 0, CW_BAR = 4096, CW_SCANQ = 8192, CW_SCANP = 12288;

constexpr int RING_BYTES = 131072;
constexpr int LDSCTL_OFF = 161024, MISC_OFF = LDSCTL_OFF + 320;
constexpr int LDS_BYTES = 162048;

#define GAS __attribute__((address_space(1)))
#define LAS __attribute__((address_space(3)))
#define DI __device__ __forceinline__
typedef unsigned short bf16;
typedef unsigned v4u __attribute__((ext_vector_type(4)));
typedef unsigned v2u __attribute__((ext_vector_type(2)));
typedef float f32x4 __attribute__((ext_vector_type(4)));
typedef float f32x2 __attribute__((ext_vector_type(2)));
typedef short bf16x8 __attribute__((ext_vector_type(8)));
typedef short bf16x4 __attribute__((ext_vector_type(4)));
typedef GAS unsigned gu32;
#define LDS_WAIT() asm volatile("s_waitcnt lgkmcnt(0)" ::: "memory")
#define VM_WAIT() asm volatile("s_waitcnt vmcnt(0)" ::: "memory")
#define MFMA16(a, b, c) __builtin_amdgcn_mfma_f32_16x16x32_bf16((a), (b), (c), 0, 0, 0)
typedef __bf16 bf16v2_t __attribute__((ext_vector_type(2)));
DI unsigned pk2(float lo, float hi) { const f32x2 v = {lo, hi}; return __builtin_bit_cast(unsigned, __builtin_convertvector(v, bf16v2_t)); }
DI unsigned f2bf(float f) { return pk2(f, 0.f) & 0xffffu; }
DI float bflo(unsigned w) { return __builtin_bit_cast(float, w << 16); }
DI float bfhi(unsigned w) { return __builtin_bit_cast(float, w & 0xffff0000u); }
DI float bf2f(bf16 v) { return __builtin_bit_cast(float, (unsigned)v << 16); }
DI float sigmoid_f(float x) { return __builtin_amdgcn_rcpf(1.0f + __expf(-x)); }
DI float silu_f(float x) { return x * sigmoid_f(x); }
DI float wave_sum(float v) {
#pragma unroll
    for (int o = 1; o < 64; o <<= 1) v += __shfl_xor(v, o);
    return v;
}
DI bf16x8 mk8(v2u lo, v2u hi) { v4u w; w.x = lo.x; w.y = lo.y; w.z = hi.x; w.w = hi.y; return __builtin_bit_cast(bf16x8, w); }
DI bf16x8 pack_acc2(const f32x4 a, const f32x4 b) { v4u w; w.x = pk2(a[0], a[1]); w.y = pk2(a[2], a[3]); w.z = pk2(b[0], b[1]); w.w = pk2(b[2], b[3]); return __builtin_bit_cast(bf16x8, w); }
#define XB_TMO      128
#define XB_XCNT(j)  (256  + 64 * (j))
#define XB_XSUB(j)  (1280 + 64 * (j))
#define XB_XGEN(j)  (2304 + 64 * (j))
#define XB_TOP      3328
#define XB_TOPGEN   3392
#define XCD_BAR_WORDS 3456
#define XB_SPIN_CAP (1u << 18)

__device__ __forceinline__ unsigned xb_ld(unsigned* p)              { return __hip_atomic_load(p, __ATOMIC_RELAXED, __HIP_MEMORY_SCOPE_AGENT); }
__device__ __forceinline__ unsigned xb_add(unsigned* p, unsigned v) { return __hip_atomic_fetch_add(p, v, __ATOMIC_RELAXED, __HIP_MEMORY_SCOPE_AGENT); }
__device__ __forceinline__ unsigned xb_xcc_id() { return (unsigned)__builtin_amdgcn_s_getreg((3 << 11) | 20) & 0xFu; }
#define XB_SPIN(cond, bar) do { unsigned _sp = 0; while (cond) { __builtin_amdgcn_s_sleep(1); \
    if ((++_sp & 255u) == 0u) { if (xb_ld(&(bar)[XB_TMO])) break; if (_sp > XB_SPIN_CAP) { atomicAdd(&(bar)[XB_TMO], 1u); break; } } } } while (0)

struct XcdBarrier {
    unsigned* bar; unsigned x;
    volatile LAS unsigned* st;
};

__device__ __forceinline__ XcdBarrier xcd_barrier_post(unsigned* bar, volatile LAS unsigned* st) {
    XcdBarrier b; b.bar = bar; b.x = xb_xcc_id(); b.st = st;
    if (threadIdx.x == 0) (void)xb_add(&bar[XB_XCNT(b.x)], 1u);
    return b;
}
__device__ __forceinline__ void xcd_barrier_complete(unsigned* bar, unsigned x, unsigned& nloc, unsigned& nx) {
    const unsigned G = gridDim.x * gridDim.y * gridDim.z;
    unsigned sum, cnt, mine, sp = 0u;
    for (;;) {
        sum = 0u; cnt = 0u; mine = 0u;
#pragma unroll
        for (unsigned j = 0; j < 16; ++j) { const unsigned c = xb_ld(&bar[XB_XCNT(j)]); sum += c; cnt += (c > 0u) ? 1u : 0u; mine = (j == x) ? c : mine; }
        if (sum == G) break;
        __builtin_amdgcn_s_sleep(1);
        if ((++sp & 255u) == 0u) { if (xb_ld(&bar[XB_TMO])) break; if (sp > XB_SPIN_CAP) { atomicAdd(&bar[XB_TMO], 1u); break; } }
    }
    nloc = mine > 0u ? mine : 1u; nx = cnt > 0u ? cnt : 1u;
}

__device__ __forceinline__ void xcd_barrier(const XcdBarrier& b) {
    asm volatile("s_waitcnt vmcnt(0)" ::: "memory");
    __syncthreads();
    if (threadIdx.x == 0) {
        unsigned* bar = b.bar;
        __builtin_amdgcn_s_waitcnt(0);
        unsigned nloc = b.st[0], nx = b.st[1];
        if (nloc == 0u) { xcd_barrier_complete(bar, b.x, nloc, nx); b.st[0] = nloc; b.st[1] = nx; }
        const unsigned old = xb_add(&bar[XB_XSUB(b.x)], 1u);
        const unsigned gen = old / nloc;
        if (old + 1u == (gen + 1u) * nloc) {
            __builtin_amdgcn_fence(__ATOMIC_RELEASE, "agent");
            asm volatile("s_waitcnt vmcnt(0)" ::: "memory");
            const unsigned og = xb_add(&bar[XB_TOP], 1u);
            const unsigned tg = og / nx;
            if (og + 1u == (tg + 1u) * nx) xb_add(&bar[XB_TOPGEN], 1u);
            else XB_SPIN(xb_ld(&bar[XB_TOPGEN]) == tg, bar);
            __builtin_amdgcn_fence(__ATOMIC_ACQUIRE, "agent");
            xb_add(&bar[XB_XGEN(b.x)], 1u);
            asm volatile("s_waitcnt vmcnt(0)" ::: "memory");
        } else {
            XB_SPIN(xb_ld(&bar[XB_XGEN(b.x)]) == gen, bar);
            __builtin_amdgcn_fence(__ATOMIC_ACQUIRE, "agent");
            asm volatile("s_waitcnt vmcnt(0)" ::: "memory");
        }
    }
    __syncthreads();
}
struct CvtJob { const float* src; const float* gain; bf16* dst; int ldw, K; };
DI CvtJob cvt_job(const float* W, int ldw, int K, const float* gain, bf16* WT, int drow0, int k0, int n0, int lane) {
    const int kg = lane >> 3, c = lane & 7; CvtJob j; j.src = W + (size_t)(k0 + 8 * kg) * ldw + n0 + 4 * c; j.gain = gain ? gain + k0 + 8 * kg : nullptr; j.dst = WT + (size_t)(drow0 + 4 * c) * K + k0 + 8 * kg; j.ldw = ldw; j.K = K; return j;
}
struct CvtRegs { f32x4 v[8]; };
DI void cvt_ld(const CvtJob& j, CvtRegs& r) {
#pragma unroll
    for (int i = 0; i < 8; ++i) r.v[i] = *(const f32x4*)(j.src + (size_t)i * j.ldw);
}
DI void cvt_st(const CvtJob& j, CvtRegs& r) {
    if (j.gain) { const f32x4 g0 = *(const f32x4*)j.gain, g1 = *(const f32x4*)(j.gain + 4);
#pragma unroll
        for (int i = 0; i < 4; ++i) { r.v[i] = r.v[i] * g0[i]; r.v[4 + i] = r.v[4 + i] * g1[i]; } }
#pragma unroll
    for (int q = 0; q < 4; ++q) { v4u o; o.x = pk2(r.v[0][q], r.v[1][q]); o.y = pk2(r.v[2][q], r.v[3][q]); o.z = pk2(r.v[4][q], r.v[5][q]); o.w = pk2(r.v[6][q], r.v[7][q]); *(v4u*)(j.dst + (size_t)q * j.K) = o; }
}
DI void cvt_item(const float* W, int ldw, int K, const float* gain, bf16* WT, int drow0, int k0, int n0, LAS float* scr, int lane) {
    (void)scr; const CvtJob j = cvt_job(W, ldw, K, gain, WT, drow0, k0, n0, lane); CvtRegs r; cvt_ld(j, r); cvt_st(j, r);
}
DI void cvt_plain(const float* W, int ldw, int K, int N, const float* gain, bf16* WT, int it, LAS float* scr, int lane) {
    const int nblk = N / 32, kb = it / nblk, nb = it % nblk; cvt_item(W, ldw, K, gain, WT, 32 * nb, 64 * kb, 32 * nb, scr, lane);
}
DI void cvt_gu(const float* W, int K, int N, const float* gain, bf16* WT, int up, int it, LAS float* scr, int lane) {
    const int nblk = N / 32, kb = it / nblk, nb = it % nblk, n0 = 32 * nb; cvt_item(W, N, K, gain, WT, (n0 >> 7) * 256 + up * 128 + (n0 & 127), 64 * kb, n0, scr, lane);
}
struct Args { const float* in[28]; float* out; unsigned char* ws; int ph_lo, ph_hi; };
enum { I_X = 0, I_LNMIX, I_LNFFN, I_EWIN, I_CONVW, I_CONVB, I_WA, I_BA, I_WI, I_BI, I_LAM, I_QN, I_KN, I_SINK, I_EWOUT, I_FG, I_FU, I_FD,
       I_OWIN, I_OCONV, I_ALOG, I_DTB, I_ONORM, I_OWOUT, I_ROUT, I_MG, I_MU, I_MD };

DI void phase_prologue(const Args& a, LAS unsigned char* lds, int gw, int NGW, int wave, int lane) {
    unsigned char* ws = a.ws;
    LAS float* scr = (LAS float*)(lds + wave * 16384);
    constexpr int I1 = 16 * 56, I2 = 16 * 32, I3 = 16 * 88, I5 = 44 * 32, I6 = 16 * 128, I7 = 16 * 32, NIT = I1 + I2 + 2 * I3 + I5 + I6 + I7;
    for (int it = gw; it < NIT; it += NGW) {
        int r = it;
        if (r < I1) { cvt_plain(a.in[I_EWIN], E_IN, D, E_IN, a.in[I_LNMIX], (bf16*)(ws + W0_IN), r, scr, lane); continue; } r -= I1;
        if (r < I2) { cvt_plain(a.in[I_EWOUT], D, D, D, nullptr, (bf16*)(ws + W0_OUT), r, scr, lane); continue; } r -= I2;
        if (r < I3) { cvt_gu(a.in[I_FG], D, FF0, a.in[I_LNFFN], (bf16*)(ws + W0_GU), 0, r, scr, lane); continue; } r -= I3;
        if (r < I3) { cvt_gu(a.in[I_FU], D, FF0, a.in[I_LNFFN], (bf16*)(ws + W0_GU), 1, r, scr, lane); continue; } r -= I3;
        if (r < I5) { cvt_plain(a.in[I_FD], D, FF0, D, nullptr, (bf16*)(ws + W0_DN), r, scr, lane); continue; } r -= I5;
        if (r < I6) { cvt_plain(a.in[I_OWIN], O_IN, D, 4096, a.in[I_LNMIX] + D, (bf16*)(ws + W1_IN), r, scr, lane); continue; } r -= I6;
        cvt_plain(a.in[I_OWOUT], D, D, D, nullptr, (bf16*)(ws + W1_OUT), r, scr, lane);
    }
    const int gt = gw * 64 + lane, NGT = NGW * 64;
    for (int i = gt; i < 16 * D; i += NGT) { const int c = i >> 10, k = i & 1023; ((bf16*)(ws + MS_WSK))[i] = (bf16)f2bf(a.in[I_OWIN][(size_t)k * O_IN + 4096 + c] * a.in[I_LNMIX][D + k]); }
    for (int i = gt; i < 8 * D; i += NGT) { const int k = i >> 3; ((float*)(ws + MS_ROUT))[i] = a.in[I_ROUT][i] * a.in[I_LNFFN][D + k]; }
    for (int i = gt; i < SEQ * 32; i += NGT) { const int pos = i >> 5, f = i & 31;
        const float inv = powf(10000.0f, -(float)f * (1.0f / 32.0f)); const float ang = (float)pos * inv;
        const double tt = (double)ang * 0.15915494309189535; const float fr = (float)(tt - rint(tt));
        f32x2 cs; cs.x = __builtin_amdgcn_cosf(fr); cs.y = __builtin_amdgcn_sinf(fr); ((f32x2*)(ws + WS_ROPE))[i] = cs; }
    for (int m0 = gw; m0 < T; m0 += 4 * NGW) { f32x4 v[4][4];
#pragma unroll
        for (int r = 0; r < 4; ++r) { const int m = m0 + r * NGW < T ? m0 + r * NGW : m0; const f32x4* xr = (const f32x4*)(a.in[I_X] + (size_t)m * D) + lane;
#pragma unroll
            for (int j = 0; j < 4; ++j) v[r][j] = xr[64 * j]; }
#pragma unroll
        for (int r = 0; r < 4; ++r) { const int m = m0 + r * NGW; if (m >= T) break; float s = 0.f;
#pragma unroll
            for (int j = 0; j < 4; ++j) s += (v[r][j].x * v[r][j].x + v[r][j].y * v[r][j].y) + (v[r][j].z * v[r][j].z + v[r][j].w * v[r][j].w);
            s = wave_sum(s);
            v2u* o8 = (v2u*)((bf16*)(ws + WS_HB) + (size_t)m * D) + lane;
#pragma unroll
            for (int j = 0; j < 4; ++j) { v2u w; w.x = pk2(v[r][j].x, v[r][j].y); w.y = pk2(v[r][j].z, v[r][j].w); o8[64 * j] = w; }
            if (lane < 16) ((float*)(ws + WS_STA))[(size_t)m * 16 + lane] = lane == 0 ? s : 0.f; }
    }
}
constexpr int MOE_D_ITEMS = NE * 56 * 32, MOE_GU_ITEMS = NE * 2 * 16 * 112;
DI CvtJob moe_job(const Args& a, int it, int lane) {
    if (it < MOE_D_ITEMS) { const int e = it / (56 * 32), r = it % (56 * 32), kb = r / 32, nb = r % 32;
        return cvt_job(a.in[I_MD] + (size_t)e * FFE * D, D, FFE, nullptr, (bf16*)(a.ws + WS_WMD) + (size_t)e * D * FFE, 32 * nb, 64 * kb, 32 * nb, lane); }
    const int i2 = it - MOE_D_ITEMS, e = i2 / (2 * 16 * 112), r0 = i2 % (2 * 16 * 112), up = r0 / (16 * 112), r = r0 % (16 * 112), kb = r / 112, nb = r % 112, n0 = 32 * nb;
    return cvt_job((up ? a.in[I_MU] : a.in[I_MG]) + (size_t)e * D * FFE, FFE, D, a.in[I_LNFFN] + D, (bf16*)a.out + (size_t)e * 2 * FFE * D, (n0 >> 7) * 256 + up * 128 + (n0 & 127), 64 * kb, n0, lane);
}
DI void moe_convert(const Args& a, int first, int stride, int lane) {
    constexpr int N = MOE_D_ITEMS + MOE_GU_ITEMS;
    for (int it = first; it < N; it += 4 * stride) {
        CvtJob j0 = moe_job(a, it, lane); CvtRegs r0, r1, r2, r3; cvt_ld(j0, r0);
        const bool h1 = it + stride < N, h2 = it + 2 * stride < N, h3 = it + 3 * stride < N;
        CvtJob j1 = moe_job(a, h1 ? it + stride : it, lane), j2 = moe_job(a, h2 ? it + 2 * stride : it, lane), j3 = moe_job(a, h3 ? it + 3 * stride : it, lane);
        cvt_ld(j1, r1); cvt_ld(j2, r2); cvt_ld(j3, r3);
        cvt_st(j0, r0); if (h1) cvt_st(j1, r1); if (h2) cvt_st(j2, r2); if (h3) cvt_st(j3, r3);
    }
}

struct LruFrags { bf16x8 wa[4][2], wi[4][2]; };
DI void lru_frags(const Args& a, LAS unsigned char* lds, LruFrags& F, int wave, int lane) {
    const int g = lane >> 4, c16 = lane & 15;
    LAS float* scr = (LAS float*)(lds + wave * 16384);
#pragma unroll
    for (int gate = 0; gate < 2; ++gate) {
        const f32x4* W = (const f32x4*)((gate ? a.in[I_WI] : a.in[I_WA]) + wave * 4096);
#pragma unroll
        for (int q = 0; q < 16; ++q) ((LAS f32x4*)scr)[q * 64 + lane] = W[q * 64 + lane];
        LDS_WAIT();
        const LAS float* sp = scr + (8 * g) * 64 + c16;
#pragma unroll
        for (int jt = 0; jt < 4; ++jt)
#pragma unroll
            for (int ks = 0; ks < 2; ++ks) { float t[8];
#pragma unroll
                for (int e = 0; e < 8; ++e) t[e] = sp[(32 * ks + e) * 64 + 16 * jt];
                v4u p; p.x = pk2(t[0], t[1]); p.y = pk2(t[2], t[3]); p.z = pk2(t[4], t[5]); p.w = pk2(t[6], t[7]);
                if (gate) F.wi[jt][ks] = __builtin_bit_cast(bf16x8, p); else F.wa[jt][ks] = __builtin_bit_cast(bf16x8, p); }
        LDS_WAIT();
    }
}
DI void lru_unit(const Args& a, LAS unsigned char* lds, const LruFrags& F, int unit, int wave, int lane) {
    unsigned char* ws = a.ws;
    const int b = unit >> 7, chk = unit & 127, t0 = chk * 128, g = lane >> 4, c16 = lane & 15;
    const size_t rowb = (size_t)b * SEQ;
    const bf16* proj0 = (const bf16*)(ws + WS_PROJ0);
    unsigned* hp = (unsigned*)(ws + WS_LRUH);
    const int c = wave * 64 + lane;
    const float w0 = a.in[I_CONVW][c], w1 = a.in[I_CONVW][512 + c], w2 = a.in[I_CONVW][1024 + c], w3 = a.in[I_CONVW][1536 + c], cb = a.in[I_CONVB][c];
    const float ba = a.in[I_BA][c], bi = a.in[I_BI][c], lam = a.in[I_LAM][c];
    const float sp8 = 8.0f * (lam < -20.f ? -lam : log1pf(expf(-lam)));
    LAS bf16* XC = (LAS bf16*)(lds + wave * 11264);
    LAS float* GA = (LAS float*)(lds + wave * 11264 + 2304);
    LAS float* GI = GA + 16 * 68;
    float x1 = 0.f, x2 = 0.f, x3 = 0.f;
    if (t0 > 0) { x1 = bf2f(proj0[(rowb + t0 - 1) * E_IN + c]); x2 = bf2f(proj0[(rowb + t0 - 2) * E_IN + c]); x3 = bf2f(proj0[(rowb + t0 - 3) * E_IN + c]); }
    float h = 0.f, P = 1.f;
    bf16 xr[16];
#pragma unroll
    for (int tt = 0; tt < 16; ++tt) xr[tt] = proj0[(rowb + t0 + tt) * E_IN + c];
#pragma unroll 1
    for (int st = 0; st < 8; ++st) {
        float xc[16]; bf16 xcur[16];
#pragma unroll
        for (int tt = 0; tt < 16; ++tt) xcur[tt] = xr[tt];
        if (st < 7) {
#pragma unroll
            for (int tt = 0; tt < 16; ++tt) xr[tt] = proj0[(rowb + t0 + 16 * (st + 1) + tt) * E_IN + c]; }
#pragma unroll
        for (int tt = 0; tt < 16; ++tt) { const float xn = bf2f(xcur[tt]);
            xc[tt] = w0 * x3 + w1 * x2 + w2 * x1 + w3 * xn + cb; x3 = x2; x2 = x1; x1 = xn; XC[tt * 72 + lane] = (bf16)f2bf(xc[tt]); }
        LDS_WAIT();
        bf16x8 bx[2];
#pragma unroll
        for (int ks = 0; ks < 2; ++ks) bx[ks] = *(const LAS bf16x8*)(XC + c16 * 72 + 32 * ks + 8 * g);
#pragma unroll
        for (int jt = 0; jt < 4; ++jt) { f32x4 ca = {0.f, 0.f, 0.f, 0.f}, ci = {0.f, 0.f, 0.f, 0.f};
#pragma unroll
            for (int ks = 0; ks < 2; ++ks) { ca = MFMA16(F.wa[jt][ks], bx[ks], ca); ci = MFMA16(F.wi[jt][ks], bx[ks], ci); }
            *(LAS f32x4*)(GA + c16 * 68 + 16 * jt + 4 * g) = ca; *(LAS f32x4*)(GI + c16 * 68 + 16 * jt + 4 * g) = ci; }
        LDS_WAIT();
#pragma unroll
        for (int tt = 0; tt < 16; ++tt) {
            const float r = sigmoid_f(GA[tt * 68 + lane] + ba), gi = sigmoid_f(GI[tt * 68 + lane] + bi);
            const float la = -sp8 * r, av = __expf(la), mult = sqrtf(fmaxf(1.0f - av * av, 0.f));
            h = av * h + mult * gi * xc[tt]; P *= av;
            const size_t o = (rowb + t0 + 16 * st + tt) * LRU_W + c; hp[o] = pk2(h, P); }
        LDS_WAIT();
    }
    ((float*)(ws + MS_LRU_A))[(size_t)unit * 512 + c] = P; ((float*)(ws + MS_LRU_H))[(size_t)unit * 512 + c] = h;
}

DI void attn_unit(const Args& a, LAS unsigned char* lds, int unit, int tid, int wave, int lane) {
    unsigned char* ws = a.ws;
    const int kvh = unit & 1, blk = (unit >> 1) & 127, b = unit >> 8, t0 = blk * 128, g = lane >> 4, c = lane & 15;
    const size_t rowb = (size_t)b * SEQ;
    const bf16* proj0 = (const bf16*)(ws + WS_PROJ0); const f32x2* rope = (const f32x2*)(ws + WS_ROPE);
    LAS bf16* Ks = (LAS bf16*)lds;
    LAS bf16* Vt = (LAS bf16*)(lds + 36864);
    {
        const int key = tid >> 1, p = tid & 1, pos = t0 - 128 + key;
        if (pos >= 0) {
            const bf16* src = proj0 + (rowb + pos) * E_IN + 1536 + kvh * 64;
            const v4u q0 = *(const v4u*)(src + 16 * p), q1 = *(const v4u*)(src + 16 * p + 8), q2 = *(const v4u*)(src + 32 + 16 * p), q3 = *(const v4u*)(src + 32 + 16 * p + 8);
            float xa[16], xb[16];
            xa[0] = bflo(q0.x); xa[1] = bfhi(q0.x); xa[2] = bflo(q0.y); xa[3] = bfhi(q0.y); xa[4] = bflo(q0.z); xa[5] = bfhi(q0.z); xa[6] = bflo(q0.w); xa[7] = bfhi(q0.w);
            xa[8] = bflo(q1.x); xa[9] = bfhi(q1.x); xa[10] = bflo(q1.y); xa[11] = bfhi(q1.y); xa[12] = bflo(q1.z); xa[13] = bfhi(q1.z); xa[14] = bflo(q1.w); xa[15] = bfhi(q1.w);
            xb[0] = bflo(q2.x); xb[1] = bfhi(q2.x); xb[2] = bflo(q2.y); xb[3] = bfhi(q2.y); xb[4] = bflo(q2.z); xb[5] = bfhi(q2.z); xb[6] = bflo(q2.w); xb[7] = bfhi(q2.w);
            xb[8] = bflo(q3.x); xb[9] = bfhi(q3.x); xb[10] = bflo(q3.y); xb[11] = bfhi(q3.y); xb[12] = bflo(q3.z); xb[13] = bfhi(q3.z); xb[14] = bflo(q3.w); xb[15] = bfhi(q3.w);
            float ss = 0.f;
#pragma unroll
            for (int e = 0; e < 16; ++e) ss += xa[e] * xa[e] + xb[e] * xb[e];
            ss += __shfl_xor(ss, 1);
            const float rn = __builtin_amdgcn_rsqf(ss * (1.0f / 64.0f) + EPS);
            unsigned oa[8], ob[8];
#pragma unroll
            for (int e = 0; e < 16; e += 2) { float r1[2], r2[2];
#pragma unroll
                for (int k = 0; k < 2; ++k) { const int d = 16 * p + e + k; const f32x2 cs = rope[(size_t)pos * 32 + d];
                    const float y1 = xa[e + k] * rn * a.in[I_KN][d], y2 = xb[e + k] * rn * a.in[I_KN][32 + d]; r1[k] = y1 * cs.x - y2 * cs.y; r2[k] = y2 * cs.x + y1 * cs.y; }
                oa[e >> 1] = pk2(r1[0], r1[1]); ob[e >> 1] = pk2(r2[0], r2[1]); }
            v4u w; w.x = oa[0]; w.y = oa[1]; w.z = oa[2]; w.w = oa[3]; *(LAS v4u*)(Ks + key * 72 + 16 * p) = w;
            w.x = oa[4]; w.y = oa[5]; w.z = oa[6]; w.w = oa[7]; *(LAS v4u*)(Ks + key * 72 + 16 * p + 8) = w;
            w.x = ob[0]; w.y = ob[1]; w.z = ob[2]; w.w = ob[3]; *(LAS v4u*)(Ks + key * 72 + 32 + 16 * p) = w;
            w.x = ob[4]; w.y = ob[5]; w.z = ob[6]; w.w = ob[7]; *(LAS v4u*)(Ks + key * 72 + 32 + 16 * p + 8) = w;
            const bf16* vs = proj0 + (rowb + pos) * E_IN + 1664 + kvh * 64 + 32 * p;
#pragma unroll
            for (int q = 0; q < 4; ++q) { const v4u vv = *(const v4u*)(vs + 8 * q); const unsigned vw[4] = {vv.x, vv.y, vv.z, vv.w};
#pragma unroll
                for (int e = 0; e < 4; ++e) { Vt[(32 * p + 8 * q + 2 * e) * 264 + key] = (bf16)(vw[e] & 0xffffu); Vt[(32 * p + 8 * q + 2 * e + 1) * 264 + key] = (bf16)(vw[e] >> 16); } }
        } else {
            const v4u z = {0u, 0u, 0u, 0u};
            *(LAS v4u*)(Ks + key * 72 + 16 * p) = z; *(LAS v4u*)(Ks + key * 72 + 16 * p + 8) = z; *(LAS v4u*)(Ks + key * 72 + 32 + 16 * p) = z; *(LAS v4u*)(Ks + key * 72 + 32 + 16 * p + 8) = z;
#pragma unroll
            for (int e = 0; e < 32; ++e) Vt[(32 * p + e) * 264 + key] = (bf16)0;
        }
    }
    __syncthreads();
    const int hq = kvh * 4 + (wave >> 1), qh = wave & 1; const float sink = a.in[I_SINK][hq];
    bf16* ymix = (bf16*)(ws + WS_YMIX);
    v4u qr0[4], qr1[4];
#pragma unroll
    for (int qt = 0; qt < 4; ++qt) { const bf16* src = proj0 + (rowb + t0 + 64 * qh + 16 * qt + c) * E_IN + 1024 + hq * 64; qr0[qt] = *(const v4u*)(src + 8 * g); qr1[qt] = *(const v4u*)(src + 32 + 8 * g); }
#pragma unroll
    for (int qt = 0; qt < 4; ++qt) {
        const int q0 = 64 * qh + 16 * qt, kt0 = 4 * qh + qt; const int tok = t0 + q0 + c;
        bf16x8 bq[2];
        {   const v4u r0 = qr0[qt], r1 = qr1[qt];
            const unsigned u0[4] = {r0.x, r0.y, r0.z, r0.w}, u1[4] = {r1.x, r1.y, r1.z, r1.w}; float xa[8], xb[8]; float ss = 0.f;
#pragma unroll
            for (int e = 0; e < 4; ++e) { xa[2 * e] = bflo(u0[e]); xa[2 * e + 1] = bfhi(u0[e]); xb[2 * e] = bflo(u1[e]); xb[2 * e + 1] = bfhi(u1[e]); }
#pragma unroll
            for (int e = 0; e < 8; ++e) ss += xa[e] * xa[e] + xb[e] * xb[e];
            ss += __shfl_xor(ss, 16); ss += __shfl_xor(ss, 32);
            const float rn = __builtin_amdgcn_rsqf(ss * (1.0f / 64.0f) + EPS) * 0.125f;
            float o1[8], o2[8];
#pragma unroll
            for (int e = 0; e < 8; ++e) { const int d = 8 * g + e; const f32x2 cs = rope[(size_t)tok * 32 + d];
                const float y1 = xa[e] * rn * a.in[I_QN][d], y2 = xb[e] * rn * a.in[I_QN][32 + d]; o1[e] = y1 * cs.x - y2 * cs.y; o2[e] = y2 * cs.x + y1 * cs.y; }
            v4u w; w.x = pk2(o1[0], o1[1]); w.y = pk2(o1[2], o1[3]); w.z = pk2(o1[4], o1[5]); w.w = pk2(o1[6], o1[7]); bq[0] = __builtin_bit_cast(bf16x8, w);
            w.x = pk2(o2[0], o2[1]); w.y = pk2(o2[2], o2[3]); w.z = pk2(o2[4], o2[5]); w.w = pk2(o2[6], o2[7]); bq[1] = __builtin_bit_cast(bf16x8, w);
        }
        f32x4 s[9]; float mx = -1e30f;
        const int qi = 128 + q0 + c;
#pragma unroll
        for (int kt = 0; kt < 9; ++kt) {
            const LAS bf16* kp = Ks + (16 * (kt0 + kt) + c) * 72 + 8 * g;
            f32x4 acc = {0.f, 0.f, 0.f, 0.f};
            acc = MFMA16(*(const LAS bf16x8*)kp, bq[0], acc); acc = MFMA16(*(const LAS bf16x8*)(kp + 32), bq[1], acc);
#pragma unroll
            for (int r = 0; r < 4; ++r) { const int kj = 16 * (kt0 + kt) + 4 * g + r; const bool ok = (kj <= qi) && (qi - kj < 128) && (blk > 0 || kj >= 128);
                acc[r] = ok ? acc[r] : -1e30f; mx = fmaxf(mx, acc[r]); }
            s[kt] = acc;
        }
        mx = fmaxf(mx, __shfl_xor(mx, 16)); mx = fmaxf(mx, __shfl_xor(mx, 32)); mx = fmaxf(mx, sink);
        float sum = 0.f;
#pragma unroll
        for (int kt = 0; kt < 9; ++kt)
#pragma unroll
            for (int r = 0; r < 4; ++r) { const float p = (s[kt][r] > -1e29f) ? __expf(s[kt][r] - mx) : 0.f; s[kt][r] = p; sum += p; }
        sum += __shfl_xor(sum, 16); sum += __shfl_xor(sum, 32); sum += __expf(sink - mx);
        const float inv = __builtin_amdgcn_rcpf(sum);
        bf16x8 bp[5];
#pragma unroll
        for (int pp = 0; pp < 4; ++pp) bp[pp] = pack_acc2(s[2 * pp] * inv, s[2 * pp + 1] * inv);
        { const f32x4 z = {0.f, 0.f, 0.f, 0.f}; bp[4] = pack_acc2(s[8] * inv, z); }
#pragma unroll
        for (int dt = 0; dt < 4; ++dt) { f32x4 o = {0.f, 0.f, 0.f, 0.f};
#pragma unroll
            for (int pp = 0; pp < 5; ++pp) { const LAS bf16* vp = Vt + (16 * dt + c) * 264 + 16 * (kt0 + 2 * pp) + 4 * g;
                const v2u lo = *(const LAS v2u*)vp, hi = *(const LAS v2u*)(vp + (pp < 4 ? 16 : 0)); o = MFMA16(mk8(lo, hi), bp[pp], o); }
            v2u w; w.x = pk2(o[0], o[1]); w.y = pk2(o[2], o[3]); *(v2u*)(ymix + (rowb + tok) * D + 512 + hq * 64 + 16 * dt + 4 * g) = w; }
    }
    __syncthreads();
}

DI void lrufix_unit(const Args& a, int unit, int tid) {
    unsigned char* ws = a.ws;
    const int b = unit >> 7, chk = unit & 127, c = tid;
    const float* At = (const float*)(ws + MS_LRU_A); const float* Ht = (const float*)(ws + MS_LRU_H);
    float hin = 0.f;
    for (int c0 = 0; c0 < chk; c0 += 8) { float av[8], hv[8];
#pragma unroll
        for (int e = 0; e < 8; ++e) { const int cc = c0 + e < chk ? c0 + e : chk - 1; const size_t o = (size_t)(b * 128 + cc) * 512 + c; av[e] = At[o]; hv[e] = Ht[o]; }
#pragma unroll
        for (int e = 0; e < 8; ++e) if (c0 + e < chk) hin = av[e] * hin + hv[e]; }
    const unsigned* hp = (const unsigned*)(ws + WS_LRUH);
    const bf16* proj0 = (const bf16*)(ws + WS_PROJ0); bf16* ymix = (bf16*)(ws + WS_YMIX);
    for (int t0 = 0; t0 < 128; t0 += 8) { float hl[8], pc[8], xg[8];
#pragma unroll
        for (int e = 0; e < 8; ++e) { const size_t row = (size_t)b * SEQ + chk * 128 + t0 + e; const unsigned w = hp[row * LRU_W + c]; hl[e] = bflo(w); pc[e] = bfhi(w); xg[e] = bf2f(proj0[row * E_IN + 512 + c]); }
#pragma unroll
        for (int e = 0; e < 8; ++e) { const size_t row = (size_t)b * SEQ + chk * 128 + t0 + e; const float h = hl[e] + pc[e] * hin, x = xg[e];
            const float z = 0.7978845608028654f * (x + 0.044715f * x * x * x); const float th = 1.0f - 2.0f * __builtin_amdgcn_rcpf(1.0f + __expf(2.0f * z));
            ymix[row * D + c] = (bf16)f2bf(h * 0.5f * x * (1.0f + th)); } }
}
DI void skinny_tile(const Args& a, int tile, int lane) {
    unsigned char* ws = a.ws; const int g = lane >> 4, c = lane & 15;
    const bf16* wsk = (const bf16*)(ws + MS_WSK) + c * D + 8 * g; const bf16* hb = (const bf16*)(ws + WS_HB) + (size_t)(tile * 16 + c) * D + 8 * g;
    f32x4 acc = {0.f, 0.f, 0.f, 0.f};
#pragma unroll 8
    for (int ks = 0; ks < 32; ++ks) acc = MFMA16(*(const bf16x8*)(wsk + 32 * ks), *(const bf16x8*)(hb + 32 * ks), acc);
    const int row = tile * 16 + c; const float rs = pg8::rstd16((const float*)(ws + WS_STA), row);
    *(f32x4*)((float*)(ws + WS_AB) + (size_t)row * 16 + 4 * g) = acc * rs;
}

DI void conv_unit(const Args& a, int unit, int tid) {
    if (tid >= 384) return;
    unsigned char* ws = a.ws; const int b = unit >> 8, ck = unit & 255, col = 8 * tid;
    bf16* p = (bf16*)(ws + WS_QKV) + ((size_t)b * SEQ + (size_t)ck * 64) * 3072 + col;
    float w[4][8];
#pragma unroll
    for (int j = 0; j < 4; ++j) { const f32x4 w0 = *(const f32x4*)(a.in[I_OCONV] + j * 3072 + col), w1 = *(const f32x4*)(a.in[I_OCONV] + j * 3072 + col + 4);
#pragma unroll
        for (int e = 0; e < 4; ++e) { w[j][e] = w0[e]; w[j][4 + e] = w1[e]; } }
    float x1[8], x2[8], x3[8];
    if (ck > 0) { const bf16* hp = (const bf16*)(ws + WS_HALO) + (size_t)(b * NCH + ck - 1) * 3 * 3072 + col; const v4u h3 = *(const v4u*)hp, h2 = *(const v4u*)(hp + 3072), h1 = *(const v4u*)(hp + 6144);
        const unsigned u3[4] = {h3.x, h3.y, h3.z, h3.w}, u2[4] = {h2.x, h2.y, h2.z, h2.w}, u1[4] = {h1.x, h1.y, h1.z, h1.w};
#pragma unroll
        for (int e = 0; e < 4; ++e) { x3[2 * e] = bflo(u3[e]); x3[2 * e + 1] = bfhi(u3[e]); x2[2 * e] = bflo(u2[e]); x2[2 * e + 1] = bfhi(u2[e]); x1[2 * e] = bflo(u1[e]); x1[2 * e + 1] = bfhi(u1[e]); } }
    else {
#pragma unroll
        for (int e = 0; e < 8; ++e) { x1[e] = 0.f; x2[e] = 0.f; x3[e] = 0.f; } }
    for (int j0 = 0; j0 < 64; j0 += 8) { v4u raw[8];
#pragma unroll
        for (int t = 0; t < 8; ++t) raw[t] = *(const v4u*)(p + (size_t)(j0 + t) * 3072);
#pragma unroll
        for (int t = 0; t < 8; ++t) { const unsigned uw[4] = {raw[t].x, raw[t].y, raw[t].z, raw[t].w}; float y[8];
#pragma unroll
            for (int e = 0; e < 8; ++e) { const float xn = (e & 1) ? bfhi(uw[e >> 1]) : bflo(uw[e >> 1]); const float v = w[0][e] * x3[e] + w[1][e] * x2[e] + w[2][e] * x1[e] + w[3][e] * xn; x3[e] = x2[e]; x2[e] = x1[e]; x1[e] = xn; y[e] = silu_f(v); }
            v4u o; o.x = pk2(y[0], y[1]); o.y = pk2(y[2], y[3]); o.z = pk2(y[4], y[5]); o.w = pk2(y[6], y[7]); *(v4u*)(p + (size_t)(j0 + t) * 3072) = o; }
    }
}

constexpr int PR_XQ = 0, PR_XK = 17408;
constexpr int PR_KT = 36448, PR_VT = 54880;
constexpr int PR_SLOT = 73728, PR_SLOTB = 9216, PR_VEC = 147456, PR_VECB = 1536;
DI int lrow_off(int i) { const int m = (i - 1) >> 2; return i <= 0 ? 0 : 8 * m * (m + 1) + (i - 1 - 4 * m) * 4 * (m + 1); }
struct PrepRegs { v4u a[2], b[2]; float ab0, ab1; };
DI void prep_load(const unsigned char* ws, PrepRegs& r, int unit, int colA, int colB, int tid_, bool want_ab) {
    int tid = tid_; asm volatile("" : "+v"(tid));
    const int ck = unit & 255, h = (unit >> 8) & 7, b = unit >> 11; const size_t R0 = (size_t)b * SEQ + (size_t)ck * 64;
    const bf16* qkv = (const bf16*)(ws + WS_QKV);
#pragma unroll
    for (int k = 0; k < 2; ++k) { const int idx = tid + 512 * k, row = idx >> 4, c16 = idx & 15; const bf16* p = qkv + (R0 + row) * 3072 + h * 128 + 8 * c16; r.a[k] = *(const v4u*)(p + colA); r.b[k] = *(const v4u*)(p + colB); }
    if (want_ab && tid >= 448) { const float* ab = (const float*)(ws + WS_AB) + (R0 + (tid - 448)) * 16; r.ab0 = ab[h]; r.ab1 = ab[8 + h]; }
}
DI void prep_stage(LAS unsigned char* lds, const PrepRegs& r, int tid_) {
    int tid = tid_; asm volatile("" : "+v"(tid));
#pragma unroll
    for (int k = 0; k < 2; ++k) { const int idx = tid + 512 * k, row = idx >> 4, c16 = idx & 15;
        *(LAS v4u*)((LAS bf16*)(lds + PR_XQ) + row * 136 + 8 * c16) = r.a[k]; *(LAS v4u*)((LAS bf16*)(lds + PR_XK) + row * 136 + 8 * c16) = r.b[k]; }
}
DI void prep_front_a(const Args& a, LAS unsigned char* lds, int unit, int slot, const PrepRegs& R, int tid, int wave, int lane, const bool dry) {
    unsigned char* ws = a.ws;
    const int ck = unit & 255, h = (unit >> 8) & 7, b = unit >> 11, g = lane >> 4, c = lane & 15;
    const size_t R0 = (size_t)b * SEQ + (size_t)ck * 64;
    bf16* qkv = (bf16*)(ws + WS_QKV);
    LAS bf16* XQ = (LAS bf16*)(lds + PR_XQ); LAS bf16* XK = (LAS bf16*)(lds + PR_XK);
    LAS float* Ls = (LAS float*)(lds + PR_SLOT + slot * PR_SLOTB);
    LAS float* Gs = (LAS float*)(lds + PR_VEC + slot * PR_VECB); LAS float* Bs = Gs + 64; LAS float* Rq = Gs + 128; LAS float* Rk = Gs + 192; LAS float* SK = Gs + 256; LAS float* SD = Gs + 320;
    prep_stage(lds, R, tid);
    if (wave == 7) {
        const float xin = R.ab0 + a.in[I_DTB][h]; const float sp = xin > 20.f ? xin : log1pf(expf(xin));
        float G = -expf(a.in[I_ALOG][h]) * sp;
#pragma unroll
        for (int o = 1; o < 64; o <<= 1) { const float v = __shfl_up(G, o); if (lane >= o) G += v; }
        Gs[lane] = G; Bs[lane] = sigmoid_f(R.ab1);
        if (lane == 63 && !dry) ((float*)(ws + MS_GLAST))[unit] = expf(G);
    }
}
DI void prep_front_b(const Args& a, LAS unsigned char* lds, int unit, int slot, int tid_, int wave, int lane_, const bool dry) {
    unsigned char* ws = a.ws; int tid = tid_; asm volatile("" : "+v"(tid)); const int lane = tid & 63; (void)lane_;
    const int ck = unit & 255, h = (unit >> 8) & 7, b = unit >> 11, g = lane >> 4, c = lane & 15;
    const size_t R0 = (size_t)b * SEQ + (size_t)ck * 64;
    bf16* qkv = (bf16*)(ws + WS_QKV);
    LAS bf16* XQ = (LAS bf16*)(lds + PR_XQ); LAS bf16* XK = (LAS bf16*)(lds + PR_XK);
    LAS float* Ls = (LAS float*)(lds + PR_SLOT + slot * PR_SLOTB);
    LAS float* Gs = (LAS float*)(lds + PR_VEC + slot * PR_VECB); LAS float* Bs = Gs + 64; LAS float* Rq = Gs + 128; LAS float* Rk = Gs + 192; LAS float* SK = Gs + 256; LAS float* SD = Gs + 320;
    __syncthreads();
    { const int row = tid >> 2, qtr = tid & 3; const LAS bf16* s = (row < 64 ? XQ + row * 136 : XK + (row - 64) * 136) + 32 * qtr; float ss = 0.f;
#pragma unroll
      for (int q = 0; q < 4; ++q) { const v4u v = *(const LAS v4u*)(s + 8 * q); const unsigned vw[4] = {v.x, v.y, v.z, v.w};
#pragma unroll
          for (int e = 0; e < 4; ++e) { const float l = bflo(vw[e]), hh = bfhi(vw[e]); ss += l * l + hh * hh; } }
      ss += __shfl_xor(ss, 1); ss += __shfl_xor(ss, 2);
      const float rn = __builtin_amdgcn_rsqf(ss + EPS);
      if (qtr == 0) { if (row < 64) Rq[row] = rn * 0.08838834764831845f; else { const int j = row - 64; Rk[j] = rn; const float Gj = Gs[j]; SK[j] = -Bs[j] * rn * __expf(Gj); SD[j] = rn * __expf(Gs[63] - Gj); } } }
    __syncthreads();
    bf16* aq = (bf16*)(ws + WS_AQK) + (size_t)unit * 4096;
    for (int job = wave; job < 26; job += 8) {
        int it, jt; const bool isk = job < 10;
        if (isk) { it = job >= 6 ? 3 : (job >= 3 ? 2 : (job >= 1 ? 1 : 0)); jt = job - it * (it + 1) / 2; } else { it = (job - 10) >> 2; jt = (job - 10) & 3; }
        const int i = 16 * it + c, j0 = 16 * jt + 4 * g;
        bf16* aqf = aq + ((it * 2 + (jt >> 1)) * 64 + lane) * 8 + (jt & 1) * 4;
        if (it < jt) { const v2u z = {0u, 0u}; if (!dry && !isk) *(v2u*)aqf = z; continue; }
        const LAS bf16* ap = XK + (16 * jt + c) * 136 + 8 * g; const LAS bf16* bp = (isk ? XK : XQ) + (16 * it + c) * 136 + 8 * g;
        f32x4 acc = {0.f, 0.f, 0.f, 0.f};
#pragma unroll
        for (int ks = 0; ks < 4; ++ks) acc = MFMA16(*(const LAS bf16x8*)(ap + 32 * ks), *(const LAS bf16x8*)(bp + 32 * ks), acc);
        const float Gi = Gs[i], ri = isk ? Bs[i] * Rk[i] : Rq[i]; f32x4 o;
#pragma unroll
        for (int r = 0; r < 4; ++r) { const int j = j0 + r; const bool ok = isk ? (i > j) : (i >= j); const float dcy = __expf(fminf(Gi - Gs[j], 0.f)); o[r] = ok ? acc[r] * ri * Rk[j] * dcy : 0.f; }
        if (isk) { LAS float* lp = Ls + lrow_off(i) + j0;
#pragma unroll
            for (int r = 0; r < 4; ++r) if (j0 + r < i) lp[r] = o[r]; }
        else { v2u w; w.x = pk2(o[0], o[1]); w.y = pk2(o[2], o[3]); if (!dry) *(v2u*)aqf = w; }
    }
#pragma unroll
    for (int k = 0; k < 2; ++k) { const int task = tid + 512 * k, i = task >> 4, dc = task & 15; const float sc = Rq[i] * __expf(Gs[i]);
        const v4u v = *(const LAS v4u*)(XQ + i * 136 + 8 * dc); v4u o;
        o.x = pk2(bflo(v.x) * sc, bfhi(v.x) * sc); o.y = pk2(bflo(v.y) * sc, bfhi(v.y) * sc); o.z = pk2(bflo(v.z) * sc, bfhi(v.z) * sc); o.w = pk2(bflo(v.w) * sc, bfhi(v.w) * sc);
        if (!dry) *(v4u*)(qkv + (R0 + i) * 3072 + h * 128 + 8 * dc) = o; }
    __syncthreads();
}
DI void prep_invert(LAS unsigned char* lds, int slot, int lane) {
    LAS float* Ls = (LAS float*)(lds + PR_SLOT + slot * PR_SLOTB);
    float t[64]; int ln = lane; asm volatile("" : "+v"(ln));
#pragma unroll
    for (int i = 0; i < 64; ++i) { float a0 = (i == ln) ? 1.f : 0.f, a1 = 0.f, a2 = 0.f, a3 = 0.f;
#pragma unroll
        for (int k4 = 0; k4 < (i + 3) / 4; ++k4) { const f32x4 l = *(const LAS f32x4*)(Ls + lrow_off(i) + 4 * k4);
            if (4 * k4 + 0 < i) a0 -= l[0] * t[4 * k4 + 0]; if (4 * k4 + 1 < i) a1 -= l[1] * t[4 * k4 + 1]; if (4 * k4 + 2 < i) a2 -= l[2] * t[4 * k4 + 2]; if (4 * k4 + 3 < i) a3 -= l[3] * t[4 * k4 + 3];
            if ((k4 & 3) == 3) asm volatile("" ::: "memory"); }
        t[i] = (a0 + a1) + (a2 + a3); asm volatile("" ::: "memory"); }
    LDS_WAIT();
    LAS bf16* Tb = (LAS bf16*)Ls;
#pragma unroll
    for (int i = 0; i < 64; ++i) Tb[i * 72 + lane] = (bf16)f2bf(t[i]);
}
DI void prep_back(const Args& a, LAS unsigned char* lds, int unit, int slot, int tid_, int wave, int lane_, const bool dry) {
    unsigned char* ws = a.ws; int tid = tid_; asm volatile("" : "+v"(tid)); const int lane = tid & 63; (void)lane_;
    const int ck = unit & 255, h = (unit >> 8) & 7, b = unit >> 11, g = lane >> 4, c = lane & 15;
    const size_t R0 = (size_t)b * SEQ + (size_t)ck * 64;
    bf16* qkv = (bf16*)(ws + WS_QKV);
    LAS bf16* KT = (LAS bf16*)(lds + PR_KT); LAS bf16* VT = (LAS bf16*)(lds + PR_VT); const LAS bf16* Tb = (const LAS bf16*)(lds + PR_SLOT + slot * PR_SLOTB);
    const LAS float* Gs = (const LAS float*)(lds + PR_VEC + slot * PR_VECB); const LAS float* Bs = Gs + 64; const LAS float* SK = Gs + 256; const LAS float* SD = Gs + 320;
    __syncthreads();
    {   const int part = tid >> 8, half = (tid >> 7) & 1, ch = tid & 127;
        const LAS bf16* rw = (const LAS bf16*)(lds + (part ? PR_XK : PR_XQ)) + (32 * half) * 136 + ch; LAS bf16* to = (part ? VT : KT) + ch * 72 + 32 * half;
        const LAS float* s0 = (part ? Bs : SK) + 32 * half; const LAS float* s1 = SD + 32 * half;
        bf16* kd = qkv + (R0 + (ch >> 1)) * 3072 + 2048 + h * 128 + (ch & 1) * 64 + 32 * half;
#pragma unroll
        for (int j8 = 0; j8 < 4; ++j8) { float x[8];
#pragma unroll
            for (int e = 0; e < 8; ++e) x[e] = bf2f(rw[(8 * j8 + e) * 136]);
            const f32x4 sa = *(const LAS f32x4*)(s0 + 8 * j8), sb = *(const LAS f32x4*)(s0 + 8 * j8 + 4);
            v4u w; w.x = pk2(x[0] * sa[0], x[1] * sa[1]); w.y = pk2(x[2] * sa[2], x[3] * sa[3]); w.z = pk2(x[4] * sb[0], x[5] * sb[1]); w.w = pk2(x[6] * sb[2], x[7] * sb[3]); *(LAS v4u*)(to + 8 * j8) = w;
            if (part == 0) { const f32x4 da = *(const LAS f32x4*)(s1 + 8 * j8), db = *(const LAS f32x4*)(s1 + 8 * j8 + 4);
                v4u o; o.x = pk2(x[0] * da[0], x[1] * da[1]); o.y = pk2(x[2] * da[2], x[3] * da[3]); o.z = pk2(x[4] * db[0], x[5] * db[1]); o.w = pk2(x[6] * db[2], x[7] * db[3]); if (!dry) *(v4u*)(kd + 8 * j8) = o; } }
    }
    __syncthreads();
    bf16* uT = (bf16*)(ws + WS_UT) + (size_t)unit * 8192;
    for (int job = wave; job < 64; job += 8) {
        f32x4 acc = {0.f, 0.f, 0.f, 0.f};
        if (job < 32) { const int it = job >> 3, et = job & 7; const LAS bf16* ap = Tb + (16 * it + c) * 72 + 8 * g; const LAS bf16* bp = VT + (16 * et + c) * 72 + 8 * g;
#pragma unroll
            for (int ks = 0; ks < 2; ++ks) acc = MFMA16(*(const LAS bf16x8*)(ap + 32 * ks), *(const LAS bf16x8*)(bp + 32 * ks), acc);
            v2u w; w.x = pk2(acc[0], acc[1]); w.y = pk2(acc[2], acc[3]); if (!dry) *(v2u*)(uT + (16 * et + c) * 64 + 16 * it + 4 * g) = w;
        } else { const int dt = (job - 32) >> 2, it = (job - 32) & 3; const LAS bf16* ap = KT + (16 * dt + c) * 72 + 8 * g; const LAS bf16* bp = Tb + (16 * it + c) * 72 + 8 * g;
#pragma unroll
            for (int ks = 0; ks < 2; ++ks) acc = MFMA16(*(const LAS bf16x8*)(ap + 32 * ks), *(const LAS bf16x8*)(bp + 32 * ks), acc);
            v2u w; w.x = pk2(acc[0], acc[1]); w.y = pk2(acc[2], acc[3]); if (!dry) *(v2u*)(qkv + (R0 + 16 * it + c) * 3072 + 1024 + h * 128 + 16 * dt + 4 * g) = w; }
    }
}
#ifndef MK_SUBSTAMP
#define MK_SUBSTAMP 0
#endif
DI void prep_phase(const Args& a, LAS unsigned char* lds, int first, int stride, int n, int tid, int wave, int lane, const bool dry, unsigned long long& st_acc) {
    const unsigned char* ws = a.ws; unsigned long long t0 = 0ull; (void)t0;
#define PSB(i) do { if (MK_SUBSTAMP == (i)) t0 = __builtin_amdgcn_s_memrealtime(); } while (0)
#define PSE(i) do { if (MK_SUBSTAMP == (i)) st_acc += __builtin_amdgcn_s_memrealtime() - t0; } while (0)
    for (int b0 = 0; b0 < n; b0 += 8) {
        const int nb = (n - b0) < 8 ? (n - b0) : 8;
        PrepRegs R;
        PSB(3);
        prep_load(ws, R, first + b0 * stride, 0, 1024, tid, true);
        for (int s = 0; s < nb; ++s) {
            const int unit = first + (b0 + s) * stride;
            prep_front_a(a, lds, unit, s, R, tid, wave, lane, dry);
            if (s + 1 < nb) prep_load(ws, R, unit + stride, 0, 1024, tid, true);
            prep_front_b(a, lds, unit, s, tid, wave, lane, dry);
        }
        PSE(3); PSB(4);
#ifndef NO_INV
        if (wave < nb) prep_invert(lds, wave, lane);
#endif
        prep_load(ws, R, first + b0 * stride, 1024, 2048, tid, false);
        __syncthreads();
        PSE(4); PSB(5);
        for (int s = 0; s < nb; ++s) {
            const int unit = first + (b0 + s) * stride;
            prep_stage(lds, R, tid);
            if (s + 1 < nb) prep_load(ws, R, unit + stride, 1024, 2048, tid, false);
            prep_back(a, lds, unit, s, tid, wave, lane, dry);
        }
        __syncthreads();
        PSE(5);
    }
#undef PSB
#undef PSE
}

#ifndef MK_SUBSTAMP
#define MK_SUBSTAMP 0
#endif
constexpr int SC_SLOT = 51200, SC_W = 0, SC_K = 16384, SC_U = 32768, SC_Q = 34816;
constexpr int SC_DUMP = 3 * SC_SLOT, SC_XS = SC_DUMP + 1024, SC_XV = SC_XS + 4096, SC_FLAG = SC_XV + 2048;
static_assert(SC_FLAG + 128 <= LDSCTL_OFF, "scan LDS map");
DI const LAS v2u* sw256(const LAS unsigned char* base, int row, int j, int half) { return (const LAS v2u*)(base + row * 256 + ((j ^ (row & 15)) << 4) + half * 8); }
DI const LAS v2u* sw128(const LAS unsigned char* base, int row, int j, int half) { return (const LAS v2u*)(base + row * 128 + ((j ^ ((row >> 1) & 7)) << 4) + half * 8); }
#define SCAN_BAR() do { asm volatile("s_waitcnt lgkmcnt(0)" ::: "memory"); __builtin_amdgcn_s_barrier(); asm volatile("" ::: "memory"); } while (0)
struct AFrag { v4u v[8]; };
DI void af_load(AFrag& f, const unsigned char* ws, unsigned off) {
#pragma unroll
    for (int k = 0; k < 8; ++k) asm volatile("global_load_dwordx4 %0, %1, %2" : "=v"(f.v[k]) : "v"(off + (unsigned)k * 1024u), "s"(ws) : "memory");
}
#define AF_WAIT(N, f) asm volatile("s_waitcnt vmcnt(" #N ")" : "+v"(f.v[0]), "+v"(f.v[1]), "+v"(f.v[2]), "+v"(f.v[3]), "+v"(f.v[4]), "+v"(f.v[5]), "+v"(f.v[6]), "+v"(f.v[7]) :: "memory")
template <int w> DI void scan_crit(const unsigned char* ws, LAS unsigned char* lds, int b, int h, int lane) {
    const int g = lane >> 4, c = lane & 15, gh = g >> 1, gl1 = g & 1;
    LAS v4u* XS = (LAS v4u*)(lds + SC_XS); LAS v4u* XV = (LAS v4u*)(lds + SC_XV);
        const float* glast = (const float*)(ws + MS_GLAST) + (b * GH + h) * NCH;
        { const v4u z = {0u, 0u, 0u, 0u}; XS[(2 * w) * 64 + lane] = z; XS[(2 * w + 1) * 64 + lane] = z; }
        SCAN_BAR();
        f32x4 S[4]; bf16x8 Sb[4];
#pragma unroll
        for (int i = 0; i < 4; ++i) { S[i] = (f32x4){0.f, 0.f, 0.f, 0.f}; Sb[i] = (bf16x8){0, 0, 0, 0, 0, 0, 0, 0}; }
        int slot = 0;
        const unsigned lw = (unsigned)((32 * w + c) * 256 + gl1 * 8), lk = (unsigned)((64 * w + c) * 128 + gl1 * 8), lu = (unsigned)(c * 128 + gl1 * 8), kx = (unsigned)((c >> 1) & 7);
        unsigned xw[4][2], xk[2][2], xu[2];
#pragma unroll
        for (int s = 0; s < 4; ++s)
#pragma unroll
            for (int t = 0; t < 2; ++t) xw[s][t] = (unsigned)(((4 * s + 2 * t + gh) ^ c) << 4);
#pragma unroll
        for (int s = 0; s < 2; ++s)
#pragma unroll
            for (int t = 0; t < 2; ++t) xk[s][t] = (((unsigned)(4 * s + 2 * t + gh)) ^ kx) << 4;
#pragma unroll
        for (int j = 0; j < 2; ++j) xu[j] = (((unsigned)(2 * (2 * w + j) + gh)) ^ kx) << 4;
        for (int ck = 0; ck < NCH; ++ck) {
            const LAS unsigned char* cur = lds + slot * SC_SLOT; slot = slot == 2 ? 0 : slot + 1;
            const float gl = glast[ck]; f32x4 vn[2]; bf16x8 wf[2][4], kf[4][2]; v2u uf[2];
#pragma unroll
            for (int s = 0; s < 4; ++s) { const LAS unsigned char* p0 = cur + SC_W + lw + xw[s][0]; const LAS unsigned char* p1 = cur + SC_W + lw + xw[s][1];
#pragma unroll
                for (int j = 0; j < 2; ++j) wf[j][s] = mk8(*(const LAS v2u*)(p0 + j * 4096), *(const LAS v2u*)(p1 + j * 4096)); }
#pragma unroll
            for (int j = 0; j < 2; ++j) uf[j] = *(const LAS v2u*)(cur + SC_U + lu + xu[j]);
#pragma unroll
            for (int s = 0; s < 2; ++s) { const LAS unsigned char* p0 = cur + SC_K + lk + xk[s][0]; const LAS unsigned char* p1 = cur + SC_K + lk + xk[s][1];
#pragma unroll
                for (int d = 0; d < 4; ++d) kf[d][s] = mk8(*(const LAS v2u*)(p0 + d * 2048), *(const LAS v2u*)(p1 + d * 2048)); }
            if (ck > 0) { Sb[2 - 2 * w] = __builtin_bit_cast(bf16x8, XS[(2 - 2 * w) * 64 + lane]); Sb[3 - 2 * w] = __builtin_bit_cast(bf16x8, XS[(3 - 2 * w) * 64 + lane]); }
#pragma unroll
            for (int j = 0; j < 2; ++j) { f32x4 acc = {bflo(uf[j].x), bfhi(uf[j].x), bflo(uf[j].y), bfhi(uf[j].y)};
#pragma unroll
                for (int s = 0; s < 4; ++s) acc = MFMA16(wf[j][s], Sb[s], acc);
                vn[j] = acc; }
            bf16x8 vb[2]; vb[w] = pack_acc2(vn[0], vn[1]);
            XV[w * 64 + lane] = __builtin_bit_cast(v4u, vb[w]);
            SCAN_BAR();
            vb[1 - w] = __builtin_bit_cast(bf16x8, XV[(1 - w) * 64 + lane]);
#pragma unroll
            for (int d = 0; d < 4; ++d) { f32x4 acc = S[d] * gl;
#pragma unroll
                for (int s = 0; s < 2; ++s) acc = MFMA16(kf[d][s], vb[s], acc);
                S[d] = acc; }
            Sb[2 * w] = pack_acc2(S[0], S[1]); Sb[2 * w + 1] = pack_acc2(S[2], S[3]);
            XS[(2 * w) * 64 + lane] = __builtin_bit_cast(v4u, Sb[2 * w]); XS[(2 * w + 1) * 64 + lane] = __builtin_bit_cast(v4u, Sb[2 * w + 1]);
            SCAN_BAR();
        }
}
DI void scan_chain(const Args& a, LAS unsigned char* lds, int chain, int tid, int wave, int lane, const bool dry, unsigned long long& st_acc) {
    unsigned char* ws = a.ws; (void)st_acc;
    const int es = chain & 7, h = (chain >> 3) & 7, b = chain >> 6, g = lane >> 4, c = lane & 15, gh = g >> 1, gl1 = g & 1;
    LAS v4u* XS = (LAS v4u*)(lds + SC_XS); LAS v4u* XV = (LAS v4u*)(lds + SC_XV);
    __syncthreads();
    if (wave == 0) scan_crit<0>(ws, lds, b, h, lane); else if (wave == 1) scan_crit<1>(ws, lds, b, h, lane);
    else if (wave == 2) {
        const int unit0 = (b * GH + h) * NCH;
        bf16* oT = (bf16*)(ws + WS_UT) + (size_t)unit0 * 8192 + (16 * es + c) * 64 + 4 * g;
        const unsigned aoff = (unsigned)(WS_AQK + ((size_t)unit0 * 4096 + lane * 8) * 2);
        AFrag F0, F1, F2;
        const unsigned lw = (unsigned)(c * 256 + gl1 * 8); unsigned xw[4][2];
#pragma unroll
        for (int s = 0; s < 4; ++s)
#pragma unroll
            for (int t = 0; t < 2; ++t) xw[s][t] = (unsigned)(((4 * s + 2 * t + gh) ^ c) << 4);
        af_load(F0, ws, aoff); af_load(F1, ws, aoff + 8192u);
        unsigned anext = aoff + 2u * 8192u; bf16* onext = oT;
        SCAN_BAR();
#define OUT_STEP(ck, FX, FZ) do { \
            const LAS unsigned char* cur = lds + ((ck) % 3) * SC_SLOT; \
            if ((ck) + 2 < NCH) { af_load(FZ, ws, anext); anext += 8192u; } \
            bf16x8 So[4], qf[4][4]; f32x4 acc[4]; \
            _Pragma("unroll") for (int s = 0; s < 4; ++s) So[s] = __builtin_bit_cast(bf16x8, XS[s * 64 + lane]); \
            _Pragma("unroll") for (int s = 0; s < 4; ++s) { const LAS unsigned char* p0 = cur + SC_Q + lw + xw[s][0]; const LAS unsigned char* p1 = cur + SC_Q + lw + xw[s][1]; \
                _Pragma("unroll") for (int jt = 0; jt < 4; ++jt) qf[jt][s] = mk8(*(const LAS v2u*)(p0 + jt * 4096), *(const LAS v2u*)(p1 + jt * 4096)); } \
            _Pragma("unroll") for (int jt = 0; jt < 4; ++jt) { acc[jt] = (f32x4){0.f, 0.f, 0.f, 0.f}; \
                _Pragma("unroll") for (int s = 0; s < 4; ++s) acc[jt] = MFMA16(qf[jt][s], So[s], acc[jt]); } \
            SCAN_BAR(); \
            bf16x8 vb[2]; vb[0] = __builtin_bit_cast(bf16x8, XV[lane]); vb[1] = __builtin_bit_cast(bf16x8, XV[64 + lane]); \
            if ((ck) + 2 >= NCH) AF_WAIT(0, FX); else if ((ck) == 0) AF_WAIT(16, FX); else if ((ck) == 1) AF_WAIT(20, FX); else AF_WAIT(24, FX); \
            _Pragma("unroll") for (int jt = 0; jt < 4; ++jt) { \
                _Pragma("unroll") for (int s = 0; s < 2; ++s) acc[jt] = MFMA16(__builtin_bit_cast(bf16x8, FX.v[jt * 2 + s]), vb[s], acc[jt]); \
                v2u w; w.x = pk2(acc[jt][0], acc[jt][1]); w.y = pk2(acc[jt][2], acc[jt][3]); \
                if (!dry) asm volatile("global_store_dwordx2 %0, %1, off" :: "v"(onext + 16 * jt), "v"(w) : "memory"); } \
            onext += 8192; \
            SCAN_BAR(); } while (0)
        for (int c0 = 0; c0 < NCH; c0 += 3) {
            OUT_STEP(c0, F0, F2);
            if (c0 + 1 < NCH) OUT_STEP(c0 + 1, F1, F0);
            if (c0 + 2 < NCH) OUT_STEP(c0 + 2, F2, F1);
        }
#undef OUT_STEP
        asm volatile("s_waitcnt vmcnt(0)" ::: "memory");
    } else if (wave == 6) {
        SCAN_BAR();
        for (int ck = 0; ck < NCH; ++ck) { SCAN_BAR(); SCAN_BAR(); }
    } else {
        const size_t R0 = (size_t)b * SEQ; const int unit0 = (b * GH + h) * NCH, lw = wave == 7 ? 3 : wave - 3;
        unsigned gc[13], ic[13], lc[13];
#pragma unroll
        for (int k = 0; k < 13; ++k) { int r = lw + 4 * k; const bool pad = r >= 50; if (pad) r = lw; size_t gg; unsigned gi, ll;
            if (r < 16) { const int row = 4 * r + (lane >> 4), j = (lane & 15) ^ (row & 15); gg = WS_QKV + ((R0 + row) * 3072 + 1024 + h * 128 + 8 * j) * 2; gi = 64u * 3072u * 2u; ll = SC_W + r * 1024; }
            else if (r < 32) { const int d = 8 * (r - 16) + (lane >> 3), j = (lane & 7) ^ ((d >> 1) & 7); gg = WS_QKV + ((R0 + (d >> 1)) * 3072 + 2048 + h * 128 + (d & 1) * 64 + 8 * j) * 2; gi = 64u * 3072u * 2u; ll = SC_K + (r - 16) * 1024; }
            else if (r < 34) { const int e = 8 * (r - 32) + (lane >> 3), j = (lane & 7) ^ ((e >> 1) & 7); gg = WS_UT + ((size_t)unit0 * 8192 + (16 * es + e) * 64 + 8 * j) * 2; gi = 16384u; ll = SC_U + (r - 32) * 1024; }
            else { const int row = 4 * (r - 34) + (lane >> 4), j = (lane & 15) ^ (row & 15); gg = WS_QKV + ((R0 + row) * 3072 + h * 128 + 8 * j) * 2; gi = 64u * 3072u * 2u; ll = SC_Q + (r - 34) * 1024; }
            gc[k] = (unsigned)gg; ic[k] = gi; lc[k] = pad ? 0xffffffffu : ll; }
#define DMA_C(slot) do { _Pragma("unroll") for (int k = 0; k < 13; ++k) { \
            __builtin_amdgcn_global_load_lds((const unsigned*)(ws + gc[k]), (LAS unsigned*)(lds + (lc[k] == 0xffffffffu ? (unsigned)SC_DUMP : (unsigned)(slot) * SC_SLOT + lc[k])), 16, 0, 0); gc[k] += ic[k]; } } while (0)
        DMA_C(0); DMA_C(1);
        asm volatile("s_waitcnt vmcnt(0)" ::: "memory");
        SCAN_BAR();
        int s2 = 2;
        for (int ck = 0; ck < NCH; ++ck) {
            if (ck + 2 < NCH) DMA_C(s2);
            s2 = s2 == 2 ? 0 : s2 + 1;
            SCAN_BAR();
            if (ck + 2 < NCH) asm volatile("s_waitcnt vmcnt(13)" ::: "memory"); else asm volatile("s_waitcnt vmcnt(0)" ::: "memory");
            SCAN_BAR();
        }
#undef DMA_C
    }
    __syncthreads();
}

DI void onorm_unit(const Args& a, LAS float* red  , int unit, int it, int wave, int lane) {
    unsigned char* ws = a.ws;
    const int ck = unit & 255, h = (unit >> 8) & 7, b = unit >> 11; const size_t row = (size_t)b * SEQ + (size_t)ck * 64 + lane;
    const bf16* oT = (const bf16*)(ws + WS_UT) + (size_t)unit * 8192 + (16 * wave) * 64 + lane;
    float v[16]; float ss = 0.f;
#pragma unroll
    for (int k = 0; k < 16; ++k) { v[k] = bf2f(oT[k * 64]); ss += v[k] * v[k]; }
    LAS float* rb = red + (it & 1) * 512; rb[wave * 64 + lane] = ss;
    const bf16* gp = (const bf16*)(ws + WS_GATE) + row * D + h * 128 + 16 * wave; const v4u g0 = *(const v4u*)gp, g1 = *(const v4u*)(gp + 8);
    __syncthreads();
    float tot = 0.f;
#pragma unroll
    for (int w = 0; w < 8; ++w) tot += rb[w * 64 + lane];
    const float rs = __builtin_amdgcn_rsqf(tot * (1.0f / 128.0f) + EPS);
    const unsigned gw[8] = {g0.x, g0.y, g0.z, g0.w, g1.x, g1.y, g1.z, g1.w}; unsigned o[8];
    const float* on = a.in[I_ONORM] + 16 * wave;
#pragma unroll
    for (int k = 0; k < 8; ++k) { const float ga = bflo(gw[k]), gb = bfhi(gw[k]); o[k] = pk2(v[2 * k] * rs * on[2 * k] * silu_f(ga), v[2 * k + 1] * rs * on[2 * k + 1] * silu_f(gb)); }
    bf16* op = (bf16*)(ws + WS_ON) + row * D + h * 128 + 16 * wave;
    v4u w0, w1; w0.x = o[0]; w0.y = o[1]; w0.z = o[2]; w0.w = o[3]; w1.x = o[4]; w1.y = o[5]; w1.z = o[6]; w1.w = o[7]; *(v4u*)op = w0; *(v4u*)(op + 8) = w1;
}

DI void route_unit(const Args& a, LAS int* esel, int unit, int wave, int lane) {
    unsigned char* ws = a.ws;
    const float* rt = (const float*)(ws + MS_ROUT);
    f32x4 rr[4][4][2];
#pragma unroll
    for (int j = 0; j < 4; ++j)
#pragma unroll
        for (int i = 0; i < 4; ++i) { const f32x4* p = (const f32x4*)(rt + (size_t)(4 * (64 * j + lane) + i) * 8); rr[j][i][0] = p[0]; rr[j][i][1] = p[1]; }
    for (int tl = 16 * wave; tl < 16 * wave + 16; ++tl) {
        const int tok = unit * 128 + tl;
        const v2u* xr = (const v2u*)((const bf16*)(ws + WS_HB) + (size_t)tok * D) + lane;
        float acc[8] = {0.f, 0.f, 0.f, 0.f, 0.f, 0.f, 0.f, 0.f};
#pragma unroll
        for (int j = 0; j < 4; ++j) { const v2u xw = xr[64 * j]; const f32x4 x = {bflo(xw.x), bfhi(xw.x), bflo(xw.y), bfhi(xw.y)};
#pragma unroll
            for (int i = 0; i < 4; ++i)
#pragma unroll
                for (int e = 0; e < 8; ++e) acc[e] += x[i] * rr[j][i][e >> 2][e & 3]; }
#pragma unroll
        for (int e = 0; e < 8; ++e) acc[e] = wave_sum(acc[e]);
        const float rs = pg8::rstd16((const float*)(ws + WS_STB), tok);
        int e1 = 0; float l1 = acc[0];
#pragma unroll
        for (int e = 1; e < 8; ++e) if (acc[e] > l1) { l1 = acc[e]; e1 = e; }
        int e2 = -1; float l2 = -3.0e38f;
#pragma unroll
        for (int e = 0; e < 8; ++e) if (e != e1 && acc[e] > l2) { l2 = acc[e]; e2 = e; }
        const float w1 = __builtin_amdgcn_rcpf(1.0f + __expf((l2 - l1) * rs));
        if (lane == 0) { ((int*)(ws + MS_TOKE))[tok] = e1 | (e2 << 8); ((float*)(ws + MS_TOKW))[2 * tok] = w1; ((float*)(ws + MS_TOKW))[2 * tok + 1] = 1.0f - w1; esel[2 * tl] = e1; esel[2 * tl + 1] = e2; }
    }
    __syncthreads();
    { int base = 0;
      for (int i = 0; i < 4; ++i) { const bool m = esel[64 * i + lane] == wave; const unsigned long long mask = __ballot(m);
          if (m) ((int*)(ws + MS_RANK))[unit * 256 + 64 * i + lane] = base + __popcll(mask & ((1ull << lane) - 1ull)); base += __popcll(mask); }
      if (lane == 0) ((int*)(ws + MS_CNT))[unit * 8 + wave] = base; }
    __syncthreads();
}

DI void gather_unit(const Args& a, LAS int* sm  , int unit, int tid, int wave, int lane) {
    unsigned char* ws = a.ws;
    const int* cnt = (const int*)(ws + MS_CNT);
    if (tid < 8) { int tot = 0, off = 0; for (int u = 0; u < 256; ++u) { const int v = cnt[u * 8 + tid]; tot += v; if (u < unit) off += v; } sm[tid] = tot; sm[8 + tid] = off; }
    __syncthreads();
    if (tid == 0) { int s = 0; for (int e = 0; e < 8; ++e) { sm[16 + e] = s; s += ((sm[e] + 255) >> 8) << 8; } sm[24] = s;
        if (unit == 0) { int* te = (int*)(ws + MS_TILEE); for (int e = 0; e < 8; ++e) for (int t = sm[16 + e] >> 8; t < (sm[16 + e + 1] >> 8); ++t) te[t] = e; te[MAXTILES] = s >> 8; } }
    __syncthreads();
    const bf16* hb3 = (const bf16*)(ws + WS_HB); bf16* xg = (bf16*)(ws + WS_XG); float* rg = (float*)(ws + MS_RG);
    for (int s0 = 32 * wave; s0 < 32 * wave + 32; s0 += 4) { int dest[4]; v4u r0[4], r1[4];
#pragma unroll
        for (int q = 0; q < 4; ++q) { const int s = s0 + q, tok = unit * 128 + (s >> 1), k = s & 1; const int e = (((const int*)(ws + MS_TOKE))[tok] >> (8 * k)) & 0xff;
            dest[q] = sm[16 + e] + sm[8 + e] + ((const int*)(ws + MS_RANK))[unit * 256 + s];
            const v4u* src = (const v4u*)(hb3 + (size_t)tok * D) + lane; r0[q] = src[0]; r1[q] = src[64]; }
#pragma unroll
        for (int q = 0; q < 4; ++q) { const int s = s0 + q, tok = unit * 128 + (s >> 1), k = s & 1; const float rs = pg8::rstd16((const float*)(ws + WS_STB), tok);
            if (lane == 0) ((int*)(ws + MS_DEST))[2 * tok + k] = dest[q];
            v4u a0 = r0[q], a1 = r1[q];
            a0.x = pk2(bflo(a0.x) * rs, bfhi(a0.x) * rs); a0.y = pk2(bflo(a0.y) * rs, bfhi(a0.y) * rs); a0.z = pk2(bflo(a0.z) * rs, bfhi(a0.z) * rs); a0.w = pk2(bflo(a0.w) * rs, bfhi(a0.w) * rs);
            a1.x = pk2(bflo(a1.x) * rs, bfhi(a1.x) * rs); a1.y = pk2(bflo(a1.y) * rs, bfhi(a1.y) * rs); a1.z = pk2(bflo(a1.z) * rs, bfhi(a1.z) * rs); a1.w = pk2(bflo(a1.w) * rs, bfhi(a1.w) * rs);
            v4u* dst = (v4u*)(xg + (size_t)dest[q] * D) + lane; dst[0] = a0; dst[64] = a1; }
    }
    if (unit < 8) {
        const int e = unit, r0 = sm[16 + e] + sm[e], r1 = sm[16 + e + 1]; const v4u z = {0u, 0u, 0u, 0u};
        for (int r = r0 + wave; r < r1; r += 8) { v4u* dst = (v4u*)(xg + (size_t)r * D) + lane; dst[0] = z; dst[64] = z; }
    }
    __syncthreads();
}

DI void combine_row(const Args& a, int tok, int lane) {
    unsigned char* ws = a.ws;
    const int d1 = ((const int*)(ws + MS_DEST))[2 * tok], d2 = ((const int*)(ws + MS_DEST))[2 * tok + 1];
    const float w1 = ((const float*)(ws + MS_TOKW))[2 * tok], w2 = ((const float*)(ws + MS_TOKW))[2 * tok + 1];
    const bf16* y = (const bf16*)(ws + WS_XG);
    f32x4* o = (f32x4*)(a.out + (size_t)tok * D) + 4 * lane;
    const v4u* y1 = (const v4u*)(y + (size_t)d1 * D) + 2 * lane; const v4u* y2 = (const v4u*)(y + (size_t)d2 * D) + 2 * lane; const v4u* hh = (const v4u*)((const bf16*)(ws + WS_HB) + (size_t)tok * D) + 2 * lane;
#pragma unroll
    for (int q = 0; q < 2; ++q) { const v4u p1 = y1[q], p2 = y2[q], p0 = hh[q]; const unsigned a1[4] = {p1.x, p1.y, p1.z, p1.w}, a2[4] = {p2.x, p2.y, p2.z, p2.w}, a0[4] = {p0.x, p0.y, p0.z, p0.w};
#pragma unroll
        for (int e = 0; e < 2; ++e) { f32x4 v;
            v[0] = bflo(a0[2 * e]) + w1 * bflo(a1[2 * e]) + w2 * bflo(a2[2 * e]); v[1] = bfhi(a0[2 * e]) + w1 * bfhi(a1[2 * e]) + w2 * bfhi(a2[2 * e]);
            v[2] = bflo(a0[2 * e + 1]) + w1 * bflo(a1[2 * e + 1]) + w2 * bflo(a2[2 * e + 1]); v[3] = bfhi(a0[2 * e + 1]) + w1 * bfhi(a1[2 * e + 1]) + w2 * bfhi(a2[2 * e + 1]); o[2 * q + e] = v; } }
}

DI void combine_rows4(const Args& a, int tok0, int stride, int lane) {
    unsigned char* ws = a.ws; const bf16* y = (const bf16*)(ws + WS_XG);
    int d1[4], d2[4]; float w1[4], w2[4]; v4u p0[4][2], p1[4][2], p2[4][2];
#pragma unroll
    for (int r = 0; r < 4; ++r) { const int tok = tok0 + r * stride < T ? tok0 + r * stride : tok0;
        d1[r] = ((const int*)(ws + MS_DEST))[2 * tok]; d2[r] = ((const int*)(ws + MS_DEST))[2 * tok + 1]; w1[r] = ((const float*)(ws + MS_TOKW))[2 * tok]; w2[r] = ((const float*)(ws + MS_TOKW))[2 * tok + 1];
        const v4u* hh = (const v4u*)((const bf16*)(ws + WS_HB) + (size_t)tok * D) + 2 * lane; p0[r][0] = hh[0]; p0[r][1] = hh[1]; }
#pragma unroll
    for (int r = 0; r < 4; ++r) { const v4u* y1 = (const v4u*)(y + (size_t)d1[r] * D) + 2 * lane; const v4u* y2 = (const v4u*)(y + (size_t)d2[r] * D) + 2 * lane; p1[r][0] = y1[0]; p1[r][1] = y1[1]; p2[r][0] = y2[0]; p2[r][1] = y2[1]; }
#pragma unroll
    for (int r = 0; r < 4; ++r) { const int tok = tok0 + r * stride; if (tok >= T) break;
        f32x4* o = (f32x4*)(a.out + (size_t)tok * D) + 4 * lane;
#pragma unroll
        for (int q = 0; q < 2; ++q) { const unsigned a0[4] = {p0[r][q].x, p0[r][q].y, p0[r][q].z, p0[r][q].w}, a1[4] = {p1[r][q].x, p1[r][q].y, p1[r][q].z, p1[r][q].w}, a2[4] = {p2[r][q].x, p2[r][q].y, p2[r][q].z, p2[r][q].w};
#pragma unroll
            for (int e = 0; e < 2; ++e) { f32x4 v;
                v[0] = bflo(a0[2 * e]) + w1[r] * bflo(a1[2 * e]) + w2[r] * bflo(a2[2 * e]); v[1] = bfhi(a0[2 * e]) + w1[r] * bfhi(a1[2 * e]) + w2[r] * bfhi(a2[2 * e]);
                v[2] = bflo(a0[2 * e + 1]) + w1[r] * bflo(a1[2 * e + 1]) + w2[r] * bflo(a2[2 * e + 1]); v[3] = bfhi(a0[2 * e + 1]) + w1[r] * bfhi(a1[2 * e + 1]) + w2[r] * bfhi(a2[2 * e + 1]); o[2 * q + e] = v; } } }
}
constexpr int NPHASE = 23;
#ifndef MK_SUB
#define MK_SUB 3
#endif
#ifndef MK_ONE_LAUNCH
#define MK_ONE_LAUNCH 1
#endif
template <int P> DI void moe_pass(const Args& args, LAS unsigned char* lds, int G, int which  ) {
    unsigned char* ws = args.ws;
    const int* te = (const int*)(ws + MS_TILEE); const int ntiles = te[MAXTILES];
    const int lo = PASS_TILES * P, hi = (P == 3) ? ntiles : (ntiles < PASS_TILES * (P + 1) ? ntiles : PASS_TILES * (P + 1));
    if (lo >= hi) return;
    if (which == 0) {
        pg8::Gemm g{(const bf16*)(ws + WS_XG), (const bf16*)args.out, MAXTILES * 256, 2 * FFE, D};
        pg8::MoeOrder S{lo, hi, 2 * FFE / 256, G, (int)blockIdx.x, te};
        pg8::EpiSwiGLU<true> E{(bf16*)(ws + WS_ACT), FFE, nullptr, 2 * FFE / 256, lo};
        pg8::gemm_phase<pg8::EpiSwiGLU<true>, pg8::MoeOrder, true, true>(lds, g, S, E);
    } else {
        pg8::Gemm g{(const bf16*)(ws + WS_ACT) - (size_t)lo * 256 * FFE, (const bf16*)(ws + WS_WMD), MAXTILES * 256, D, FFE};
        pg8::MoeOrder S{lo, hi, D / 256, G, (int)blockIdx.x, te};
        pg8::EpiPlain E{(bf16*)(ws + WS_XG)};
        pg8::gemm_phase<pg8::EpiPlain, pg8::MoeOrder, true, true>(lds, g, S, E);
    }
}

__global__ void __launch_bounds__(NTHREADS, 2) fwd(Args args) {
    extern __shared__ __attribute__((aligned(16))) unsigned char lds_raw[];
    LAS unsigned char* lds = (LAS unsigned char*)lds_raw;
    volatile LAS unsigned* MISC = (volatile LAS unsigned*)(lds + MISC_OFF);
    const int tid = threadIdx.x, lane = tid & 63, wave = __builtin_amdgcn_readfirstlane(tid >> 6);
    const int G = gridDim.x, bx = blockIdx.x;
    const int vcu = (G % 8 == 0) ? (bx % 8) * (G / 8) + bx / 8 : bx;
    const int gw = vcu * NWAVES + wave, NGW = G * NWAVES;
    unsigned char* ws = args.ws;
    gu32* ctl = (gu32*)(ws + WS_CTL);
    for (int u = tid; u < (LDS_BYTES - LDSCTL_OFF) / 4; u += NTHREADS) ((LAS unsigned*)(lds + LDSCTL_OFF))[u] = 0u;
    __syncthreads();
    const int lo = args.ph_lo, hi = args.ph_hi;
    XcdBarrier bar; bar.bar = (unsigned*)(ctl + CW_BAR); bar.x = 0; bar.st = nullptr;
    if (hi - lo > 1) bar = xcd_barrier_post((unsigned*)(ctl + CW_BAR), MISC + 8);
#ifndef MK_PHMASK
#define MK_PHMASK 0x7fffffu
#endif
#define IN(k) ((((MK_PHMASK) >> (k)) & 1u) && lo <= (k) && (k) < hi)
#ifndef MK_STAMPMASK
#define MK_STAMPMASK 0u
#endif
    unsigned long long st_acc = 0ull, st_t0 = 0ull;
#ifndef MK_SUBSTAMP
#define MK_SUBSTAMP 0
#endif
#define SUBSTAMP_BEGIN(i) do { if (MK_SUBSTAMP == (i)) st_t0 = __builtin_amdgcn_s_memrealtime(); } while (0)
#define SUBSTAMP_END(i) do { if (MK_SUBSTAMP == (i)) st_acc += __builtin_amdgcn_s_memrealtime() - st_t0; } while (0)
#define STAMPED(k) ((((MK_STAMPMASK) >> (k)) & 1u) != 0u)
#define SEAM(k) do { if (IN(k) && IN((k) + 1)) xcd_barrier(bar); if (STAMPED(k)) st_acc += __builtin_amdgcn_s_memrealtime() - st_t0; } while (0)
#ifndef MK_DUP
#define MK_DUP -1
#endif
#define PH(k, ...) if (STAMPED(k)) st_t0 = __builtin_amdgcn_s_memrealtime(); if (IN(k)) { if (MK_DUP == (k)) { int o_tid = tid; asm volatile("" : "+v"(o_tid)); unsigned long long o_ws = (unsigned long long)ws; asm volatile("" : "+s"(o_ws)); \
        { const int tid = o_tid, lane = tid & 63, wave = __builtin_amdgcn_readfirstlane(tid >> 6); unsigned char* const ws = (unsigned char*)o_ws; const int gw = vcu * NWAVES + wave; (void)lane; (void)gw; (void)ws; \
          const bool dry = (args.ph_hi > 0); (void)dry; __VA_ARGS__ } xcd_barrier(bar); } \
        { int p_tid = threadIdx.x; asm volatile("" : "+v"(p_tid)); const int tid = p_tid, lane = tid & 63, wave = __builtin_amdgcn_readfirstlane(tid >> 6), gw = vcu * NWAVES + wave; (void)lane; (void)gw; \
          const bool dry = false; (void)dry; __VA_ARGS__ } } SEAM(k);

    PH(0,  phase_prologue(args, lds, gw, NGW, wave, lane); __syncthreads(); )

    PH(1,
        pg8::Gemm g{(const bf16*)(ws + WS_HB), (const bf16*)(ws + W0_IN), T, E_IN, D}; pg8::StaticOrder S; S.init(T, E_IN, G, bx);
        pg8::rstd_prepass(S, (const float*)(ws + WS_STA), (float*)(ws + MS_RC));
        pg8::EpiProj<0> E{(bf16*)(ws + WS_PROJ0), E_IN, (const float*)(ws + MS_RC), nullptr, nullptr};
        pg8::gemm_phase<pg8::EpiProj<0>, pg8::StaticOrder, true, true>(lds, g, S, E);
    )

    PH(2,
        if (MK_SUB & 1) { LruFrags LF; lru_frags(args, lds, LF, wave, lane); __syncthreads(); for (int u = vcu; u < NB * 128; u += G) lru_unit(args, lds, LF, u, wave, lane); }
        __syncthreads();
        if (MK_SUB & 2) for (int u = vcu; u < NB * 128 * 2; u += G) attn_unit(args, lds, u, tid, wave, lane);
    )

    PH(3,  for (int u = vcu; u < NB * 128; u += G) lrufix_unit(args, u, tid); )

    PH(4,
        pg8::Gemm g{(const bf16*)(ws + WS_YMIX), (const bf16*)(ws + W0_OUT), T, D, D}; pg8::StaticOrder S; S.init(T, D, G, bx);
        pg8::EpiResid E{(bf16*)(ws + WS_HB), (float*)(ws + WS_STB)};
        pg8::gemm_phase<pg8::EpiResid, pg8::StaticOrder, true, true>(lds, g, S, E);
    )

    PH(5,
        pg8::Gemm g{(const bf16*)(ws + WS_HB), (const bf16*)(ws + W0_GU), T, 2 * FF0, D}; pg8::StaticOrder S; S.init(T, 2 * FF0, G, bx);
        pg8::rstd_prepass(S, (const float*)(ws + WS_STB), (float*)(ws + MS_RC));
        pg8::EpiSwiGLU<false> E{(bf16*)(ws + WS_ACT0), FF0, (const float*)(ws + MS_RC), 0, 0};
        pg8::gemm_phase<pg8::EpiSwiGLU<false>, pg8::StaticOrder, true, true>(lds, g, S, E);
    )

    PH(6,
        pg8::Gemm g{(const bf16*)(ws + WS_ACT0), (const bf16*)(ws + W0_DN), T, D, FF0}; pg8::StaticOrder S; S.init(T, D, G, bx);
        pg8::EpiResid E{(bf16*)(ws + WS_HB), (float*)(ws + WS_STA)};
        pg8::gemm_phase<pg8::EpiResid, pg8::StaticOrder, true, true>(lds, g, S, E);
    )

    PH(7,
        pg8::Gemm g{(const bf16*)(ws + WS_HB), (const bf16*)(ws + W1_IN), T, 4096, D}; pg8::StaticOrder S; S.init(T, 4096, G, bx);
        pg8::rstd_prepass(S, (const float*)(ws + WS_STA), (float*)(ws + MS_RC));
        pg8::EpiProj<1> E{(bf16*)(ws + WS_QKV), 3072, (const float*)(ws + MS_RC), (bf16*)(ws + WS_GATE), (bf16*)(ws + WS_HALO)};
        pg8::gemm_phase<pg8::EpiProj<1>, pg8::StaticOrder, true, true>(lds, g, S, E);
        for (int t = gw; t < T / 16; t += NGW) skinny_tile(args, t, lane);
    )

    PH(8,  SUBSTAMP_BEGIN(1); for (int u = vcu; u < NB * NCH; u += G) conv_unit(args, u, tid);
        if (hi - lo > 1) xcd_barrier(bar); SUBSTAMP_END(1);
        SUBSTAMP_BEGIN(2); prep_phase(args, lds, vcu, G, (NUNIT - vcu + G - 1) / G, tid, wave, lane, dry, st_acc); SUBSTAMP_END(2); )

    PH(9,
        volatile LAS int* sq = (volatile LAS int*)(lds + LDSCTL_OFF + 64);
        if (tid == 0) { const unsigned x = xb_xcc_id() & 7u; const unsigned t = __hip_atomic_fetch_add((unsigned*)(ctl + CW_SCANQ + 64 * x), 1u, __ATOMIC_RELAXED, __HIP_MEMORY_SCOPE_AGENT);
            unsigned n[8]; unsigned tot = 0;
            for (int j = 0; j < 8; ++j) { n[j] = __hip_atomic_load((unsigned*)(ctl + CW_BAR) + XB_XCNT(j), __ATOMIC_RELAXED, __HIP_MEMORY_SCOPE_AGENT); tot += n[j]; }
            int chain = -1, wrank = 0, nwork = 0;
            if (tot != (unsigned)G || hi - lo <= 1) { chain = vcu < 128 ? vcu : -1; wrank = vcu - 128; nwork = G - 128; }
            else if (t < 16u) chain = (int)((2u * x + (t >> 3)) * 8u + (t & 7u));
            else { unsigned w = t - 16u, nl = 0, nw = 0;
                for (int j = 0; j < 8; ++j) { if ((unsigned)j < x && n[j] > 16u) w += n[j] - 16u; nl += n[j] < 16u ? 16u - n[j] : 0u; nw += n[j] > 16u ? n[j] - 16u : 0u; }
                if (w < nl) { unsigned r = w;
                    for (int j = 0; j < 8; ++j) { const unsigned lj = n[j] < 16u ? 16u - n[j] : 0u; if (chain < 0) { if (r < lj) { const unsigned tt = n[j] + r; chain = (int)((2u * j + (tt >> 3)) * 8u + (tt & 7u)); } else r -= lj; } } }
                else { wrank = (int)(w - nl); nwork = (int)(nw - nl); } }
            sq[0] = chain; sq[1] = wrank; sq[2] = nwork; }
        __syncthreads();
        const int chain = sq[0]; const int wrank = sq[1]; const int nwork = sq[2];
        __syncthreads();
        SUBSTAMP_BEGIN(6); if (chain >= 0) scan_chain(args, lds, chain, tid, wave, lane, dry, st_acc); SUBSTAMP_END(6);
        SUBSTAMP_BEGIN(7); if (chain < 0 && nwork > 0) { moe_convert(args, wrank * NWAVES + wave, nwork * NWAVES, lane); } SUBSTAMP_END(7);
        if (G < 128 + 1) { moe_convert(args, gw, NGW, lane); }
    )

    PH(10,
        LAS float* red = (LAS float*)lds; int it = 0;
        for (int u = vcu; u < NUNIT; u += G, ++it) onorm_unit(args, red, u, it, wave, lane);
        __syncthreads();
    )

    PH(11,
        pg8::Gemm g{(const bf16*)(ws + WS_ON), (const bf16*)(ws + W1_OUT), T, D, D}; pg8::StaticOrder S; S.init(T, D, G, bx);
        pg8::EpiResid E{(bf16*)(ws + WS_HB), (float*)(ws + WS_STB)};
        pg8::gemm_phase<pg8::EpiResid, pg8::StaticOrder, true, true>(lds, g, S, E);
    )

    PH(12,  for (int u = vcu; u < 256; u += G) route_unit(args, (LAS int*)lds, u, wave, lane); )
    PH(13,  for (int u = vcu; u < 256; u += G) gather_unit(args, (LAS int*)lds, u, tid, wave, lane); )

    PH(14, moe_pass<0>(args, lds, G, 0);)
    PH(15, moe_pass<0>(args, lds, G, 1);)
    PH(16, moe_pass<1>(args, lds, G, 0);)
    PH(17, moe_pass<1>(args, lds, G, 1);)
    PH(18, moe_pass<2>(args, lds, G, 0);)
    PH(19, moe_pass<2>(args, lds, G, 1);)
    PH(20, moe_pass<3>(args, lds, G, 0);)
    PH(21, moe_pass<3>(args, lds, G, 1);)

    PH(22, for (int t = gw; t < T; t += 4 * NGW) combine_rows4(args, t, NGW, lane); )
    if ((MK_STAMPMASK != 0u || MK_SUBSTAMP != 0) && blockIdx.x == 0 && tid == 0) { const unsigned long long t1 = __builtin_amdgcn_s_memrealtime(); while (__builtin_amdgcn_s_memrealtime() - t1 < st_acc) __builtin_amdgcn_s_sleep(8); }
#undef IN
#undef SEAM
#undef PH
}

extern "C" void kernel_launch(void* const* d_in, const int* in_sizes, int n_in, void* d_out, int out_size, void* d_ws, size_t ws_size, hipStream_t stream) {
    static int grid = 0;
    if (grid == 0) {
        if (n_in != 28 || out_size != T * D || ws_size < WS_END) { fprintf(stderr, "kernel_launch: unexpected problem (n_in %d, out %d, ws %zu)\n", n_in, out_size, ws_size); grid = -1; return; }
        int dev = 0, cus = 0, per_cu = 0;
        if (hipGetDevice(&dev) != hipSuccess || hipDeviceGetAttribute(&cus, hipDeviceAttributeMultiprocessorCount, dev) != hipSuccess) { grid = -1; return; }
        if (hipFuncSetAttribute((const void*)fwd, hipFuncAttributeMaxDynamicSharedMemorySize, LDS_BYTES) != hipSuccess) { fprintf(stderr, "kernel_launch: hipFuncSetAttribute failed\n"); grid = -1; return; }
        if (hipOccupancyMaxActiveBlocksPerMultiprocessor(&per_cu, (const void*)fwd, NTHREADS, LDS_BYTES) != hipSuccess || per_cu < 1) fprintf(stderr, "kernel_launch: occupancy query says %d\n", per_cu);
        (void)hipGetLastError();
        grid = cus;
    }
    if (grid < 0) return;
    if (hipMemsetAsync((char*)d_ws + WS_CTL, 0, CTL_ZERO_BYTES, stream) != hipSuccess) return;
    Args a{};
    for (int i = 0; i < 28; ++i) a.in[i] = (const float*)d_in[i];
    a.out = (float*)d_out; a.ws = (unsigned char*)d_ws;
#if MK_ONE_LAUNCH
    a.ph_lo = 0; a.ph_hi = NPHASE;
    hipLaunchKernelGGL(fwd, dim3(grid), dim3(NTHREADS), LDS_BYTES, stream, a);
#else
    for (int p = 0; p < NPHASE; ++p) { a.ph_lo = p; a.ph_hi = p + 1; hipLaunchKernelGGL(fwd, dim3(grid), dim3(NTHREADS), LDS_BYTES, stream, a); }
#endif
}
```

```cpp
#include <hip/hip_runtime.h>
#include <cstdio>
#include <cstdint>
#include <cmath>
namespace pg8 {
#define PG8_LAS __attribute__((address_space(3)))
typedef unsigned short bf16_t;
typedef short bf16x8 __attribute__((ext_vector_type(8)));
typedef float f32x4 __attribute__((ext_vector_type(4)));
typedef unsigned u32x4 __attribute__((ext_vector_type(4)));
constexpr int BM = 256, BK = 64, HALF = 128, HTB = HALF * BK * 2  , STAGE_BYTES = 8 * HTB, NXCD = 8, WGM = 8;

__host__ __device__ __forceinline__ int lds_byte(int r, int c) { const int st = (r >> 4) * 2 + (c >> 5), rr = r & 15, cc = c & 31, ob = rr * 64 + cc * 2; return st * 1024 + (ob ^ (((ob >> 9) & 1) << 5)); }
__host__ __device__ __forceinline__ void stage_rc(int b, int& R, int& C) { const int st = b / 1024, sb = b % 1024, swz = sb ^ (((sb >> 9) & 1) << 5); R = (st >> 1) * 16 + swz / 64; C = (st & 1) * 32 + (swz % 64) / 2; }
__host__ __device__ __forceinline__ int perm32(int rho) { const int n = rho >> 4, i = rho & 15; return 8 * (i >> 2) + 4 * n + (i & 3); }

struct Unit { int pm, pn, pk; };
struct Gemm { const bf16_t* A; const bf16_t* Bt; int M, N, K, Kt; };

struct StaticOrder {
    int nM, nN, nwg, G, c;
    __host__ __device__ void init(int M, int N, int G_, int c_) { nM = M / BM; nN = N / BM; nwg = nM * nN; G = G_; c = c_; }
    __host__ __device__ bool next(int i, Unit& u) const {
        const long L = (long)i * G + c; if (L >= nwg) return false;
        int wgid = (int)L; { const int q = nwg / NXCD, r = nwg % NXCD, xcd = wgid % NXCD, off = wgid / NXCD; wgid = (xcd < r ? xcd * (q + 1) : r * (q + 1) + (xcd - r) * q) + off; }
        const int nig = WGM * nN, gid = wgid / nig, fm = gid * WGM, gsz = (nM - fm) < WGM ? (nM - fm) : WGM;
        u.pm = fm + ((wgid % nig) % gsz); u.pn = (wgid % nig) / gsz; u.pk = 0; return true;
    }
    __device__ __forceinline__ void a_ready(const Unit&) const {}
    __device__ __forceinline__ void done(const Unit&) const {}
};

__device__ __forceinline__ unsigned cvt_pk_bf16(float lo, float hi) { unsigned r; asm volatile("v_cvt_pk_bf16_f32 %0, %1, %2" : "=v"(r) : "v"(lo), "v"(hi)); return r; }
typedef float f32x2 __attribute__((ext_vector_type(2)));
__device__ __forceinline__ float rstd16(const float* st, int row) {
    const f32x4* p = (const f32x4*)(st + (size_t)row * 16); const f32x4 a = p[0], b = p[1], c = p[2], d = p[3];
    const float s = ((a[0] + a[1]) + (a[2] + a[3])) + ((b[0] + b[1]) + (b[2] + b[3])) + ((c[0] + c[1]) + (c[2] + c[3])) + ((d[0] + d[1]) + (d[2] + d[3]));
    return __builtin_amdgcn_rsqf(s * (1.0f / 1024.0f) + 1e-6f);
}
__device__ __forceinline__ u32x4 pack8(const f32x4 v0, const f32x4 v1) { u32x4 w; w.x = cvt_pk_bf16(v0[0], v0[1]); w.y = cvt_pk_bf16(v0[2], v0[3]); w.z = cvt_pk_bf16(v1[0], v1[1]); w.w = cvt_pk_bf16(v1[2], v1[3]); return w; }
__device__ __forceinline__ float silu_f(float x) { return x * __builtin_amdgcn_rcpf(1.0f + __expf(-x)); }

template <int MODE> struct EpiProj {
    static constexpr bool PERM = true, AFTER_DRAIN = false;
    bf16_t* O; int ldo; const float* stats; bf16_t* gate; bf16_t* halo;
    __device__ __forceinline__ void operator()(const f32x4 (&acc)[2][2][4][2], const Unit& u, int wr, int wc, int fr, int fq) const {
        const int row0 = u.pm * BM + wr * 64 + fr, col0 = u.pn * BM + wc * 32 + 8 * fq;
#pragma unroll
        for (int ai = 0; ai < 2; ++ai)
#pragma unroll
            for (int m = 0; m < 4; ++m) { const int row = row0 + ai * HALF + m * 16; const float rs = stats[row];
#pragma unroll
                for (int bj = 0; bj < 2; ++bj) { const int col = col0 + bj * HALF; const u32x4 w = pack8(acc[ai][bj][m][0] * rs, acc[ai][bj][m][1] * rs);
                    if (MODE == 0) { *(u32x4*)(O + (size_t)row * ldo + col) = w; }
                    else { if (col < 3072) { *(u32x4*)(O + (size_t)row * 3072 + col) = w; if (m == 3 && fr >= 13) *(u32x4*)(halo + ((size_t)(row >> 6) * 3 + (fr - 13)) * 3072 + col) = w; }
                           else *(u32x4*)(gate + (size_t)row * 1024 + (col - 3072)) = w; } } }
    }
};
struct EpiResid {
    static constexpr bool PERM = true, AFTER_DRAIN = false;
    bf16_t* hb; float* stats;
    __device__ __forceinline__ void operator()(const f32x4 (&acc)[2][2][4][2], const Unit& u, int wr, int wc, int fr, int fq) const {
        const int row0 = u.pm * BM + wr * 64 + fr, col0 = u.pn * BM + wc * 32 + 8 * fq;
#pragma unroll
        for (int ai = 0; ai < 2; ++ai)
#pragma unroll
            for (int m = 0; m < 4; ++m) { const int row = row0 + ai * HALF + m * 16; float ss = 0.f;
#pragma unroll
                for (int bj = 0; bj < 2; ++bj) { const size_t off = (size_t)row * 1024 + col0 + bj * HALF;
                    const u32x4 r = *(const u32x4*)(hb + off);
                    const f32x4 r0 = {__builtin_bit_cast(float, r.x << 16), __builtin_bit_cast(float, r.x & 0xffff0000u), __builtin_bit_cast(float, r.y << 16), __builtin_bit_cast(float, r.y & 0xffff0000u)};
                    const f32x4 r1 = {__builtin_bit_cast(float, r.z << 16), __builtin_bit_cast(float, r.z & 0xffff0000u), __builtin_bit_cast(float, r.w << 16), __builtin_bit_cast(float, r.w & 0xffff0000u)};
                    const f32x4 v0 = acc[ai][bj][m][0] + r0, v1 = acc[ai][bj][m][1] + r1;
                    *(u32x4*)(hb + off) = pack8(v0, v1);
                    ss += ((v0[0] * v0[0] + v0[1] * v0[1]) + (v0[2] * v0[2] + v0[3] * v0[3])) + ((v1[0] * v1[0] + v1[1] * v1[1]) + (v1[2] * v1[2] + v1[3] * v1[3])); }
                ss += __shfl_xor(ss, 16); ss += __shfl_xor(ss, 32);
                if (fq == 0) stats[(size_t)row * 16 + (u.pn & 3) * 4 + wc] = ss; }
    }
};
template <bool MOE> struct EpiSwiGLU {
    static constexpr bool PERM = true, AFTER_DRAIN = false;
    bf16_t* O; int ldo; const float* stats; int ntn, pm_lo;
    __device__ __forceinline__ void operator()(const f32x4 (&acc)[2][2][4][2], const Unit& u, int wr, int wc, int fr, int fq) const {
        const int pnl = MOE ? (u.pn % ntn) : u.pn;
        const int row0 = u.pm * BM + wr * 64 + fr, col = pnl * HALF + wc * 32 + 8 * fq;
#pragma unroll
        for (int ai = 0; ai < 2; ++ai)
#pragma unroll
            for (int m = 0; m < 4; ++m) { const int row = row0 + ai * HALF + m * 16; const float rs = MOE ? 1.0f : stats[row];
                const f32x4 g0 = acc[ai][0][m][0] * rs, g1 = acc[ai][0][m][1] * rs, u0 = acc[ai][1][m][0] * rs, u1 = acc[ai][1][m][1] * rs; f32x4 a0, a1;
#pragma unroll
                for (int i = 0; i < 4; ++i) { a0[i] = silu_f(g0[i]) * u0[i]; a1[i] = silu_f(g1[i]) * u1[i]; }
                *(u32x4*)(O + (size_t)(row - pm_lo * BM) * ldo + col) = pack8(a0, a1); }
    }
};
struct EpiPlain {
    static constexpr bool PERM = true, AFTER_DRAIN = false;
    bf16_t* O;
    __device__ __forceinline__ void operator()(const f32x4 (&acc)[2][2][4][2], const Unit& u, int wr, int wc, int fr, int fq) const {
        const int row0 = u.pm * BM + wr * 64 + fr, col0 = (u.pn & 3) * BM + wc * 32 + 8 * fq;
#pragma unroll
        for (int ai = 0; ai < 2; ++ai)
#pragma unroll
            for (int m = 0; m < 4; ++m) { const int row = row0 + ai * HALF + m * 16;
#pragma unroll
                for (int bj = 0; bj < 2; ++bj) *(u32x4*)(O + (size_t)row * 1024 + col0 + bj * HALF) = pack8(acc[ai][bj][m][0], acc[ai][bj][m][1]); }
    }
};
template <class Sched> __device__ __forceinline__ void rstd_prepass(const Sched& S, const float* st, float* rc) {
    Unit u; const int tid = threadIdx.x;
    for (int i = 0; S.next(i, u); ++i) { const int row = u.pm * BM + (tid >> 1); const f32x4* p = (const f32x4*)(st + (size_t)row * 16) + 2 * (tid & 1); const f32x4 a = p[0], b = p[1];
        float s = ((a[0] + a[1]) + (a[2] + a[3])) + ((b[0] + b[1]) + (b[2] + b[3])); s += __shfl_xor(s, 1);
        if ((tid & 1) == 0) rc[row] = __builtin_amdgcn_rsqf(s * (1.0f / 1024.0f) + 1e-6f); }
    asm volatile("s_waitcnt vmcnt(0)" ::: "memory"); __syncthreads();
}
struct GroupOrder {
    int nM, nN, G, c;
    __device__ __forceinline__ void init(int M, int N, int G_, int c_) { nM = M / BM; nN = N / BM; G = G_; c = c_; }
    __device__ __forceinline__ bool next(int i, Unit& u) const {
        const long L = (long)i * G + c; if (L >= (long)nM * nN) return false;
        const int grp = (int)(L / (8 * nN)), fm = grp * 8, gsz = (nM - fm) < 8 ? (nM - fm) : 8, w = (int)(L - (long)grp * 8 * nN);
        u.pm = fm + (w % gsz); u.pn = w / gsz; u.pk = 0; return true;
    }
    __device__ __forceinline__ void a_ready(const Unit&) const {}
    __device__ __forceinline__ void done(const Unit&) const {}
};
struct MoeOrder {
    int lo, hi, NT, G, c; const int* tile_e;
    __device__ __forceinline__ bool next(int i, Unit& u) const {
        const long L = (long)i * G + c; const int nt = hi - lo; if (L >= (long)nt * NT) return false;
        const int grp = (int)(L / (8 * NT)), fm = grp * 8, gsz = (nt - fm) < 8 ? (nt - fm) : 8, w = (int)(L - (long)grp * 8 * NT), rt = lo + fm + (w % gsz);
        u.pm = rt; u.pn = tile_e[rt] * NT + (w / gsz); u.pk = 0; return true;
    }
    __device__ __forceinline__ void a_ready(const Unit&) const {}
    __device__ __forceinline__ void done(const Unit&) const {}
};

struct TailOrder {
    int lo, hi, G, c; const int* tile_e;
    __device__ __forceinline__ bool next(int i, Unit& u) const {
        const long L = (long)i * G + c; if (L >= (long)(hi - lo) * 28) return false;
        const int ks = (int)(L % 7), rest = (int)(L / 7), rt = lo + (rest >> 2);
        u.pm = rt; u.pn = tile_e[rt] * 4 + (rest & 3); u.pk = ks; return true;
    }
    __device__ __forceinline__ void a_ready(const Unit&) const {}
    __device__ __forceinline__ void done(const Unit&) const {}
};
struct EpiPart {
    static constexpr bool PERM = true, AFTER_DRAIN = false;
    bf16_t* P; int lo, rows;
    __device__ __forceinline__ void operator()(const f32x4 (&acc)[2][2][4][2], const Unit& u, int wr, int wc, int fr, int fq) const {
        const int row0 = (u.pm - lo) * BM + wr * 64 + fr, col0 = (u.pn & 3) * BM + wc * 32 + 8 * fq; bf16_t* base = P + (size_t)u.pk * rows * 1024;
#pragma unroll
        for (int ai = 0; ai < 2; ++ai)
#pragma unroll
            for (int m = 0; m < 4; ++m) { const int row = row0 + ai * HALF + m * 16;
#pragma unroll
                for (int bj = 0; bj < 2; ++bj) *(u32x4*)(base + (size_t)row * 1024 + col0 + bj * HALF) = pack8(acc[ai][bj][m][0], acc[ai][bj][m][1]); }
    }
};
template <class Epi, class Sched, bool ALIGN_EPI = false, bool SP2 = false>
__device__ __forceinline__ void gemm_phase(PG8_LAS unsigned char* lds, const Gemm g, const Sched& S, const Epi& E) {
    const int tid = threadIdx.x, wid = __builtin_amdgcn_readfirstlane(tid >> 6), lane = tid & 63, wr = wid >> 2, wc = wid & 3, fr = lane & 15, fq = lane >> 4;
    const int K = g.K, nt = g.Kt / BK; const size_t kslice = (size_t)g.Kt * 2;
    unsigned voffA[2], voffB[2];
#pragma unroll
    for (int i = 0; i < 2; ++i) { int R, C; stage_rc(tid * 16 + i * 8192, R, C); const int Rb = Epi::PERM ? ((R & ~31) + perm32(R & 31)) : R;
        voffA[i] = (unsigned)(R * K + C) * 2u; voffB[i] = (unsigned)(Rb * K + C) * 2u; }
    const size_t kstep = (size_t)(BK * 2);
    const size_t hstep = (size_t)HALF * K * 2;
    const size_t tstep = 2 * hstep;
    const unsigned ldsw = (unsigned)wid * 1024u;
    const int aoff = lds_byte(wr * 64 + fr, fq * 8), boff = lds_byte(wc * 32 + fr, fq * 8);
#define PG8_SA(b, h) (((b) * 2 + (h)) * HTB)
#define PG8_SB(b, h) ((4 + (b) * 2 + (h)) * HTB)
#define PG8_STAGE(bufoff, gbase, voff) do { _Pragma("unroll") for (int _i = 0; _i < 2; ++_i) \
        __builtin_amdgcn_global_load_lds((const unsigned*)((const char*)(gbase) + (voff)[_i]), (PG8_LAS unsigned*)(lds + (bufoff) + ldsw + _i * 8192), 16, 0, 0); } while (0)
#define PG8_LDA(dst, b, h) do { _Pragma("unroll") for (int m = 0; m < 4; ++m) _Pragma("unroll") for (int k = 0; k < 2; ++k) dst[m][k] = *(const PG8_LAS bf16x8*)(lds + PG8_SA(b, h) + aoff + m * 2048 + k * 1024); } while (0)
#define PG8_LDB(dst, b, h) do { _Pragma("unroll") for (int n = 0; n < 2; ++n) _Pragma("unroll") for (int k = 0; k < 2; ++k) dst[n][k] = *(const PG8_LAS bf16x8*)(lds + PG8_SB(b, h) + boff + n * 2048 + k * 1024); } while (0)
#define PG8_MMA(ai, bj, At, Bt) do { __builtin_amdgcn_s_setprio(1); _Pragma("unroll") for (int m = 0; m < 4; ++m) _Pragma("unroll") for (int n = 0; n < 2; ++n) _Pragma("unroll") for (int k = 0; k < 2; ++k) \
        acc[ai][bj][m][n] = __builtin_amdgcn_mfma_f32_16x16x32_bf16(Bt[n][k], At[m][k], acc[ai][bj][m][n], 0, 0, 0); __builtin_amdgcn_s_setprio(0); } while (0)
#define PG8_WAIT_V(n) asm volatile("s_waitcnt vmcnt(" #n ")" ::: "memory")
#define PG8_WAIT_L(n) asm volatile("s_waitcnt lgkmcnt(" #n ")" ::: "memory")
#define PG8_BAR __builtin_amdgcn_s_barrier()
#define PG8_SCHED __builtin_amdgcn_sched_barrier(0)
    Unit cur, nxt; int ui = 0;
    if (!S.next(0, cur)) return;
    f32x4 acc[2][2][4][2];
#pragma unroll
    for (int a = 0; a < 2; ++a)
#pragma unroll
        for (int b = 0; b < 2; ++b)
#pragma unroll
            for (int m = 0; m < 4; ++m)
#pragma unroll
                for (int n = 0; n < 2; ++n) acc[a][b][m][n] = (f32x4){0.f, 0.f, 0.f, 0.f};
    bf16x8 At[4][2], B0[2][2], B1[2][2];
    const char* cA = (const char*)g.A + (size_t)cur.pm * tstep + (size_t)cur.pk * kslice; const char* cB = (const char*)g.Bt + (size_t)cur.pn * tstep + (size_t)cur.pk * kslice;
    S.a_ready(cur);
    if constexpr (SP2) {
        PG8_STAGE(PG8_SB(0, 0), cB, voffB); PG8_STAGE(PG8_SB(0, 1), cB + hstep, voffB); PG8_STAGE(PG8_SA(0, 0), cA, voffA); PG8_STAGE(PG8_SA(0, 1), cA + hstep, voffA);
        if (wr == 1) PG8_BAR;
        PG8_WAIT_V(2); PG8_BAR;
        PG8_STAGE(PG8_SB(1, 0), cB + kstep, voffB); PG8_STAGE(PG8_SA(1, 0), cA + kstep, voffA); PG8_STAGE(PG8_SB(1, 1), cB + hstep + kstep, voffB);
        PG8_WAIT_V(6); PG8_BAR;
    } else {
        PG8_STAGE(PG8_SB(0, 0), cB, voffB); PG8_STAGE(PG8_SA(0, 0), cA, voffA); PG8_STAGE(PG8_SB(0, 1), cB + hstep, voffB); PG8_STAGE(PG8_SA(0, 1), cA + hstep, voffA);
        if (wr == 1) PG8_BAR;
        PG8_WAIT_V(4); PG8_BAR;
        PG8_STAGE(PG8_SB(1, 0), cB + kstep, voffB); PG8_STAGE(PG8_SA(1, 0), cA + kstep, voffA); PG8_STAGE(PG8_SB(1, 1), cB + hstep + kstep, voffB);
        PG8_WAIT_V(6); PG8_BAR;
    }
    for (;;) {
        const bool has_next = S.next(ui + 1, nxt);
        const char* nA = has_next ? (const char*)g.A + (size_t)nxt.pm * tstep + (size_t)nxt.pk * kslice : cA; const char* nB = has_next ? (const char*)g.Bt + (size_t)nxt.pn * tstep + (size_t)nxt.pk * kslice : cB;
        for (int t = 0; t < nt; t += 2) {
            const bool last = (t == nt - 2);
            const char* a1 = cA + (size_t)(t + 1) * kstep;
            const char* a2 = last ? nA : cA + (size_t)(t + 2) * kstep; const char* b2 = last ? nB : cB + (size_t)(t + 2) * kstep;
            const char* a3 = a2 + kstep; const char* b3 = b2 + kstep;
            if (last && has_next) S.a_ready(nxt);
            if constexpr (SP2) {
            PG8_LDB(B0, 0, 0); PG8_LDB(B1, 0, 1); PG8_SCHED; PG8_LDA(At, 0, 0); PG8_STAGE(PG8_SA(1, 1), a1 + hstep, voffA);
            PG8_WAIT_V(8); PG8_WAIT_L(0); PG8_BAR; PG8_MMA(0, 0, At, B0); PG8_MMA(0, 1, At, B1); PG8_BAR; PG8_SCHED;
            PG8_LDA(At, 0, 1); PG8_STAGE(PG8_SB(0, 0), b2, voffB); PG8_STAGE(PG8_SB(0, 1), b2 + hstep, voffB); PG8_STAGE(PG8_SA(0, 0), a2, voffA);
            PG8_WAIT_V(8); PG8_WAIT_L(0); PG8_BAR; PG8_MMA(1, 0, At, B0); PG8_MMA(1, 1, At, B1); PG8_BAR; PG8_SCHED;
            PG8_LDB(B0, 1, 0); PG8_LDB(B1, 1, 1); PG8_SCHED; PG8_LDA(At, 1, 0); PG8_STAGE(PG8_SA(0, 1), a2 + hstep, voffA);
            PG8_WAIT_V(8); PG8_WAIT_L(0); PG8_BAR; PG8_MMA(0, 0, At, B0); PG8_MMA(0, 1, At, B1); PG8_BAR; PG8_SCHED;
            PG8_LDA(At, 1, 1); PG8_STAGE(PG8_SB(1, 0), b3, voffB); PG8_STAGE(PG8_SB(1, 1), b3 + hstep, voffB); PG8_STAGE(PG8_SA(1, 0), a3, voffA);
            PG8_WAIT_V(8); PG8_WAIT_L(0); PG8_BAR; PG8_MMA(1, 0, At, B0); PG8_MMA(1, 1, At, B1); PG8_BAR; PG8_SCHED;
            } else {
            PG8_LDB(B0, 0, 0); PG8_SCHED; PG8_LDA(At, 0, 0); PG8_STAGE(PG8_SA(1, 1), a1 + hstep, voffA);
            PG8_WAIT_L(8); PG8_BAR; PG8_WAIT_L(0); PG8_MMA(0, 0, At, B0); PG8_BAR; PG8_SCHED;
            PG8_LDB(B1, 0, 1); PG8_STAGE(PG8_SB(0, 0), b2, voffB);
            PG8_BAR; PG8_WAIT_L(0); PG8_MMA(0, 1, At, B1); PG8_BAR;
            PG8_LDA(At, 0, 1); PG8_STAGE(PG8_SA(0, 0), a2, voffA);
            PG8_BAR; PG8_WAIT_L(0); PG8_MMA(1, 0, At, B0); PG8_BAR; PG8_SCHED;
            PG8_STAGE(PG8_SB(0, 1), b2 + hstep, voffB);
            PG8_WAIT_V(6); PG8_BAR; PG8_MMA(1, 1, At, B1); PG8_BAR;
            PG8_LDB(B0, 1, 0); PG8_SCHED; PG8_LDA(At, 1, 0); PG8_STAGE(PG8_SA(0, 1), a2 + hstep, voffA);
            PG8_WAIT_L(8); PG8_BAR; PG8_WAIT_L(0); PG8_MMA(0, 0, At, B0); PG8_BAR; PG8_SCHED;
            PG8_LDB(B1, 1, 1); PG8_STAGE(PG8_SB(1, 0), b3, voffB);
            PG8_BAR; PG8_WAIT_L(0); PG8_MMA(0, 1, At, B1); PG8_BAR;
            PG8_LDA(At, 1, 1); PG8_STAGE(PG8_SA(1, 0), a3, voffA);
            PG8_BAR; PG8_WAIT_L(0); PG8_MMA(1, 0, At, B0); PG8_BAR; PG8_SCHED;
            PG8_STAGE(PG8_SB(1, 1), b3 + hstep, voffB);
            PG8_WAIT_V(6); PG8_BAR; PG8_MMA(1, 1, At, B1); PG8_BAR;
            }
        }
        if constexpr (ALIGN_EPI) { if (wr == 0) PG8_BAR; }
        if constexpr (!Epi::AFTER_DRAIN) { E(acc, cur, wr, wc, fr, fq); S.done(cur); }
        if (!has_next) break;
#pragma unroll
        for (int a = 0; a < 2; ++a)
#pragma unroll
            for (int b = 0; b < 2; ++b)
#pragma unroll
                for (int m = 0; m < 4; ++m)
#pragma unroll
                    for (int n = 0; n < 2; ++n) acc[a][b][m][n] = (f32x4){0.f, 0.f, 0.f, 0.f};
        cur = nxt; cA = nA; cB = nB; ++ui;
        if constexpr (ALIGN_EPI) { if (wr == 1) PG8_BAR; }
    }
    PG8_WAIT_V(0);
    if constexpr (!ALIGN_EPI) { if (wr == 0) PG8_BAR; }
    PG8_BAR;
    if constexpr (Epi::AFTER_DRAIN) { E.fused(acc, cur, wr, wc, fr, fq, lds, wid, lane); S.done(cur); }
#undef PG8_SA
#undef PG8_SB
#undef PG8_STAGE
#undef PG8_LDA
#undef PG8_LDB
#undef PG8_MMA
#undef PG8_WAIT_V
#undef PG8_WAIT_L
#undef PG8_BAR
#undef PG8_SCHED
}
}
constexpr int NWAVES = 8, NTHREADS = 512;
constexpr int SEQ = 16384, NB = 2, T = NB * SEQ, D = 1024;
constexpr int E_IN = 1792, LRU_W = 512, FF0 = 2816;
constexpr int O_IN = 4112, GH = 8, GD = 128, GC = 64, NCH = SEQ / GC  , NUNIT = NB * GH * NCH  ;
constexpr int NE = 8, FFE = 3584;
constexpr int MAXTILES = 264, PASS_TILES = 64;
constexpr float EPS = 1e-6f;

constexpr size_t MiB = 1u << 20;
constexpr size_t WS_CTL = 0, CTL_ZERO_BYTES = 1 * MiB;
constexpr size_t WS_ROPE = 1 * MiB;
constexpr size_t WS_STA = 5 * MiB, WS_STB = 7 * MiB;
constexpr size_t WS_MISC = 9 * MiB;
constexpr size_t MS_LRU_A = WS_MISC, MS_LRU_H = WS_MISC + 512 * 1024;
constexpr size_t MS_TOKE = WS_MISC + 1 * MiB;
constexpr size_t MS_TOKW = MS_TOKE + 128 * 1024;
constexpr size_t MS_RANK = MS_TOKW + 256 * 1024;
constexpr size_t MS_DEST = MS_RANK + 256 * 1024;
constexpr size_t MS_CNT = MS_DEST + 256 * 1024;
constexpr size_t MS_TILEE = MS_CNT + 8 * 1024;
constexpr size_t MS_RG = MS_TILEE + 2 * 1024;
constexpr size_t MS_GLAST = WS_MISC + 3 * MiB;
constexpr size_t MS_WSK = MS_GLAST + 16 * 1024;
constexpr size_t MS_ROUT = MS_WSK + 32 * 1024;
constexpr size_t MS_RC = MS_ROUT + 32 * 1024;
constexpr size_t MS_AB = MS_RC + 128 * 1024;
constexpr size_t WS_W0 = 13 * MiB;
constexpr size_t W0_IN = WS_W0, W0_OUT = W0_IN + (size_t)E_IN * D * 2, W0_GU = W0_OUT + (size_t)D * D * 2, W0_DN = W0_GU + (size_t)2 * FF0 * D * 2;
constexpr size_t WS_HALO = 13 * MiB;
constexpr size_t W1_OUT = 35 * MiB;
constexpr size_t WS_AB = 37 * MiB;
constexpr size_t WS_HB = 40 * MiB;
constexpr size_t WS_PROJ0 = 104 * MiB;
constexpr size_t WS_LRUH = 216 * MiB, WS_LRUP = 280 * MiB;
constexpr size_t WS_YMIX = 344 * MiB;
constexpr size_t W1_IN = 408 * MiB;
constexpr size_t WS_ACT0 = 104 * MiB;
constexpr size_t WS_QKV = 104 * MiB;
constexpr size_t WS_GATE = 296 * MiB;
constexpr size_t WS_UT = 360 * MiB;
constexpr size_t WS_AQK = 424 * MiB;
constexpr size_t WS_WMD = 456 * MiB;
constexpr size_t WS_ON = 104 * MiB;
constexpr size_t WS_XG = 168 * MiB;
constexpr size_t WS_ACT = 300 * MiB;
constexpr size_t WS_PART = 426 * MiB;
constexpr size_t WS_END = 512 * MiB;
static_assert(W0_DN + (size_t)D * FF0 * 2 <= W1_OUT && MS_AB <= WS_W0 && WS_HALO + (size_t)NB * NCH * 3 * 3072 * 2 <= W1_OUT, "ws map");
static_assert(WS_XG + (size_t)MAXTILES * 256 * 1024 * 2 <= WS_ACT && WS_ACT + (size_t)(PASS_TILES + 8) * 256 * FFE * 2 <= WS_PART && WS_PART + (size_t)7 * 2048 * 1024 * 2 <= WS_WMD && WS_WMD + (size_t)NE * D * FFE * 2 <= WS_END, "ws map (MoE)");
constexpr int CW_TMO = 0, CW_BAR = 4096, CW_SCANQ = 8192, CW_SCANP = 12288;

constexpr int RING_BYTES = 131072;
constexpr int LDSCTL_OFF = 161024, MISC_OFF = LDSCTL_OFF + 320;
constexpr int LDS_BYTES = 162048;

#define GAS __attribute__((address_space(1)))
#define LAS __attribute__((address_space(3)))
#define DI __device__ __forceinline__
typedef unsigned short bf16;
typedef unsigned v4u __attribute__((ext_vector_type(4)));
typedef unsigned v2u __attribute__((ext_vector_type(2)));
typedef float f32x4 __attribute__((ext_vector_type(4)));
typedef float f32x2 __attribute__((ext_vector_type(2)));
typedef short bf16x8 __attribute__((ext_vector_type(8)));
typedef short bf16x4 __attribute__((ext_vector_type(4)));
typedef GAS unsigned gu32;
#define LDS_WAIT() asm volatile("s_waitcnt lgkmcnt(0)" ::: "memory")
#define VM_WAIT() asm volatile("s_waitcnt vmcnt(0)" ::: "memory")
#define MFMA16(a, b, c) __builtin_amdgcn_mfma_f32_16x16x32_bf16((a), (b), (c), 0, 0, 0)
typedef __bf16 bf16v2_t __attribute__((ext_vector_type(2)));
DI unsigned pk2(float lo, float hi) { const f32x2 v = {lo, hi}; return __builtin_bit_cast(unsigned, __builtin_convertvector(v, bf16v2_t)); }
DI unsigned f2bf(float f) { return pk2(f, 0.f) & 0xffffu; }
DI float bflo(unsigned w) { return __builtin_bit_cast(float, w << 16); }
DI float bfhi(unsigned w) { return __builtin_bit_cast(float, w & 0xffff0000u); }
DI float bf2f(bf16 v) { return __builtin_bit_cast(float, (unsigned)v << 16); }
DI float sigmoid_f(float x) { return __builtin_amdgcn_rcpf(1.0f + __expf(-x)); }
DI float silu_f(float x) { return x * sigmoid_f(x); }
DI float wave_sum(float v) {
#pragma unroll
    for (int o = 1; o < 64; o <<= 1) v += __shfl_xor(v, o);
    return v;
}
DI bf16x8 mk8(v2u lo, v2u hi) { v4u w; w.x = lo.x; w.y = lo.y; w.z = hi.x; w.w = hi.y; return __builtin_bit_cast(bf16x8, w); }
DI bf16x8 pack_acc2(const f32x4 a, const f32x4 b) { v4u w; w.x = pk2(a[0], a[1]); w.y = pk2(a[2], a[3]); w.z = pk2(b[0], b[1]); w.w = pk2(b[2], b[3]); return __builtin_bit_cast(bf16x8, w); }
#define XB_TMO      128
#define XB_XCNT(j)  (256  + 64 * (j))
#define XB_XSUB(j)  (1280 + 64 * (j))
#define XB_XGEN(j)  (2304 + 64 * (j))
#define XB_TOP      3328
#define XB_TOPGEN   3392
#define XCD_BAR_WORDS 3456
#define XB_SPIN_CAP (1u << 18)

__device__ __forceinline__ unsigned xb_ld(unsigned* p)              { return __hip_atomic_load(p, __ATOMIC_RELAXED, __HIP_MEMORY_SCOPE_AGENT); }
__device__ __forceinline__ unsigned xb_add(unsigned* p, unsigned v) { return __hip_atomic_fetch_add(p, v, __ATOMIC_RELAXED, __HIP_MEMORY_SCOPE_AGENT); }
__device__ __forceinline__ unsigned xb_xcc_id() { return (unsigned)__builtin_amdgcn_s_getreg((3 << 11) | 20) & 0xFu; }
#define XB_SPIN(cond, bar) do { unsigned _sp = 0; while (cond) { __builtin_amdgcn_s_sleep(1); \
    if ((++_sp & 255u) == 0u) { if (xb_ld(&(bar)[XB_TMO])) break; if (_sp > XB_SPIN_CAP) { atomicAdd(&(bar)[XB_TMO], 1u); break; } } } } while (0)

struct XcdBarrier {
    unsigned* bar; unsigned x;
    volatile LAS unsigned* st;
};

__device__ __forceinline__ XcdBarrier xcd_barrier_post(unsigned* bar, volatile LAS unsigned* st) {
    XcdBarrier b; b.bar = bar; b.x = xb_xcc_id(); b.st = st;
    if (threadIdx.x == 0) (void)xb_add(&bar[XB_XCNT(b.x)], 1u);
    return b;
}
__device__ __forceinline__ void xcd_barrier_complete(unsigned* bar, unsigned x, unsigned& nloc, unsigned& nx) {
    const unsigned G = gridDim.x * gridDim.y * gridDim.z;
    unsigned sum, cnt, mine, sp = 0u;
    for (;;) {
        sum = 0u; cnt = 0u; mine = 0u;
#pragma unroll
        for (unsigned j = 0; j < 16; ++j) { const unsigned c = xb_ld(&bar[XB_XCNT(j)]); sum += c; cnt += (c > 0u) ? 1u : 0u; mine = (j == x) ? c : mine; }
        if (sum == G) break;
        __builtin_amdgcn_s_sleep(1);
        if ((++sp & 255u) == 0u) { if (xb_ld(&bar[XB_TMO])) break; if (sp > XB_SPIN_CAP) { atomicAdd(&bar[XB_TMO], 1u); break; } }
    }
    nloc = mine > 0u ? mine : 1u; nx = cnt > 0u ? cnt : 1u;
}

__device__ __forceinline__ void xcd_barrier(const XcdBarrier& b) {
    asm volatile("s_waitcnt vmcnt(0)" ::: "memory");
    __syncthreads();
    if (threadIdx.x == 0) {
        unsigned* bar = b.bar;
        __builtin_amdgcn_s_waitcnt(0);
        unsigned nloc = b.st[0], nx = b.st[1];
        if (nloc == 0u) { xcd_barrier_complete(bar, b.x, nloc, nx); b.st[0] = nloc; b.st[1] = nx; }
        const unsigned old = xb_add(&bar[XB_XSUB(b.x)], 1u);
        const unsigned gen = old / nloc;
        if (old + 1u == (gen + 1u) * nloc) {
            __builtin_amdgcn_fence(__ATOMIC_RELEASE, "agent");
            asm volatile("s_waitcnt vmcnt(0)" ::: "memory");
            const unsigned og = xb_add(&bar[XB_TOP], 1u);
            const unsigned tg = og / nx;
            if (og + 1u == (tg + 1u) * nx) xb_add(&bar[XB_TOPGEN], 1u);
            else XB_SPIN(xb_ld(&bar[XB_TOPGEN]) == tg, bar);
            __builtin_amdgcn_fence(__ATOMIC_ACQUIRE, "agent");
            xb_add(&bar[XB_XGEN(b.x)], 1u);
            asm volatile("s_waitcnt vmcnt(0)" ::: "memory");
        } else {
            XB_SPIN(xb_ld(&bar[XB_XGEN(b.x)]) == gen, bar);
            __builtin_amdgcn_fence(__ATOMIC_ACQUIRE, "agent");
            asm volatile("s_waitcnt vmcnt(0)" ::: "memory");
        }
    }
    __syncthreads();
}
struct CvtJob { const float* src; const float* gain; bf16* dst; int ldw, K; };
DI CvtJob cvt_job(const float* W, int ldw, int K, const float* gain, bf16* WT, int drow0, int k0, int n0, int lane) {
    const int kg = lane >> 3, c = lane & 7; CvtJob j; j.src = W + (size_t)(k0 + 8 * kg) * ldw + n0 + 4 * c; j.gain = gain ? gain + k0 + 8 * kg : nullptr; j.dst = WT + (size_t)(drow0 + 4 * c) * K + k0 + 8 * kg; j.ldw = ldw; j.K = K; return j;
}
struct CvtRegs { f32x4 v[8]; };
DI void cvt_ld(const CvtJob& j, CvtRegs& r) {
#pragma unroll
    for (int i = 0; i < 8; ++i) r.v[i] = *(const f32x4*)(j.src + (size_t)i * j.ldw);
}
DI void cvt_st(const CvtJob& j, CvtRegs& r) {
    if (j.gain) { const f32x4 g0 = *(const f32x4*)j.gain, g1 = *(const f32x4*)(j.gain + 4);
#pragma unroll
        for (int i = 0; i < 4; ++i) { r.v[i] = r.v[i] * g0[i]; r.v[4 + i] = r.v[4 + i] * g1[i]; } }
#pragma unroll
    for (int q = 0; q < 4; ++q) { v4u o; o.x = pk2(r.v[0][q], r.v[1][q]); o.y = pk2(r.v[2][q], r.v[3][q]); o.z = pk2(r.v[4][q], r.v[5][q]); o.w = pk2(r.v[6][q], r.v[7][q]); *(v4u*)(j.dst + (size_t)q * j.K) = o; }
}
DI void cvt_item(const float* W, int ldw, int K, const float* gain, bf16* WT, int drow0, int k0, int n0, LAS float* scr, int lane) {
    (void)scr; const CvtJob j = cvt_job(W, ldw, K, gain, WT, drow0, k0, n0, lane); CvtRegs r; cvt_ld(j, r); cvt_st(j, r);
}
DI void cvt_plain(const float* W, int ldw, int K, int N, const float* gain, bf16* WT, int it, LAS float* scr, int lane) {
    const int nblk = N / 32, kb = it / nblk, nb = it % nblk; cvt_item(W, ldw, K, gain, WT, 32 * nb, 64 * kb, 32 * nb, scr, lane);
}
DI void cvt_gu(const float* W, int K, int N, const float* gain, bf16* WT, int up, int it, LAS float* scr, int lane) {
    const int nblk = N / 32, kb = it / nblk, nb = it % nblk, n0 = 32 * nb; cvt_item(W, N, K, gain, WT, (n0 >> 7) * 256 + up * 128 + (n0 & 127), 64 * kb, n0, scr, lane);
}
struct Args { const float* in[28]; float* out; unsigned char* ws; int ph_lo, ph_hi; };
enum { I_X = 0, I_LNMIX, I_LNFFN, I_EWIN, I_CONVW, I_CONVB, I_WA, I_BA, I_WI, I_BI, I_LAM, I_QN, I_KN, I_SINK, I_EWOUT, I_FG, I_FU, I_FD,
       I_OWIN, I_OCONV, I_ALOG, I_DTB, I_ONORM, I_OWOUT, I_ROUT, I_MG, I_MU, I_MD };

DI void phase_prologue(const Args& a, LAS unsigned char* lds, int gw, int NGW, int wave, int lane) {
    unsigned char* ws = a.ws;
    LAS float* scr = (LAS float*)(lds + wave * 16384);
    constexpr int I1 = 16 * 56;
    for (int it = gw; it < I1; it += NGW) cvt_plain(a.in[I_EWIN], E_IN, D, E_IN, a.in[I_LNMIX], (bf16*)(ws + W0_IN), it, scr, lane);
    const int gt = gw * 64 + lane, NGT = NGW * 64;
    for (int i = gt; i < 16 * D; i += NGT) { const int c = i >> 10, k = i & 1023; ((bf16*)(ws + MS_WSK))[i] = (bf16)f2bf(a.in[I_OWIN][(size_t)k * O_IN + 4096 + c] * a.in[I_LNMIX][D + k]); }
    for (int i = gt; i < 8 * D; i += NGT) { const int k = i >> 3; ((float*)(ws + MS_ROUT))[i] = a.in[I_ROUT][i] * a.in[I_LNFFN][D + k]; }
    for (int i = gt; i < SEQ * 32; i += NGT) { const int pos = i >> 5, f = i & 31;
        const float inv = powf(10000.0f, -(float)f * (1.0f / 32.0f)); const float ang = (float)pos * inv;
        const double tt = (double)ang * 0.15915494309189535; const float fr = (float)(tt - rint(tt));
        f32x2 cs; cs.x = __builtin_amdgcn_cosf(fr); cs.y = __builtin_amdgcn_sinf(fr); ((f32x2*)(ws + WS_ROPE))[i] = cs; }
    for (int m0 = gw; m0 < T; m0 += 4 * NGW) { f32x4 v[4][4];
#pragma unroll
        for (int r = 0; r < 4; ++r) { const int m = m0 + r * NGW < T ? m0 + r * NGW : m0; const f32x4* xr = (const f32x4*)(a.in[I_X] + (size_t)m * D) + lane;
#pragma unroll
            for (int j = 0; j < 4; ++j) v[r][j] = xr[64 * j]; }
#pragma unroll
        for (int r = 0; r < 4; ++r) { const int m = m0 + r * NGW; if (m >= T) break; float s = 0.f;
#pragma unroll
            for (int j = 0; j < 4; ++j) s += (v[r][j].x * v[r][j].x + v[r][j].y * v[r][j].y) + (v[r][j].z * v[r][j].z + v[r][j].w * v[r][j].w);
            s = wave_sum(s);
            v2u* o8 = (v2u*)((bf16*)(ws + WS_HB) + (size_t)m * D) + lane;
#pragma unroll
            for (int j = 0; j < 4; ++j) { v2u w; w.x = pk2(v[r][j].x, v[r][j].y); w.y = pk2(v[r][j].z, v[r][j].w); o8[64 * j] = w; }
            if (lane < 16) ((float*)(ws + WS_STA))[(size_t)m * 16 + lane] = lane == 0 ? s : 0.f; }
    }
}
DI void weights_late(const Args& a, int first, int stride, int lane) {
    unsigned char* ws = a.ws; LAS float* scr = nullptr;
    constexpr int I2 = 16 * 32, I3 = 16 * 88, I5 = 44 * 32, I6 = 16 * 128, I7 = 16 * 32, NIT = I2 + 2 * I3 + I5 + I6 + I7;
    for (int it = first; it < NIT; it += stride) {
        int r = it;
        if (r < I2) { cvt_plain(a.in[I_EWOUT], D, D, D, nullptr, (bf16*)(ws + W0_OUT), r, scr, lane); continue; } r -= I2;
        if (r < I3) { cvt_gu(a.in[I_FG], D, FF0, a.in[I_LNFFN], (bf16*)(ws + W0_GU), 0, r, scr, lane); continue; } r -= I3;
        if (r < I3) { cvt_gu(a.in[I_FU], D, FF0, a.in[I_LNFFN], (bf16*)(ws + W0_GU), 1, r, scr, lane); continue; } r -= I3;
        if (r < I5) { cvt_plain(a.in[I_FD], D, FF0, D, nullptr, (bf16*)(ws + W0_DN), r, scr, lane); continue; } r -= I5;
        if (r < I6) { cvt_plain(a.in[I_OWIN], O_IN, D, 4096, a.in[I_LNMIX] + D, (bf16*)(ws + W1_IN), r, scr, lane); continue; } r -= I6;
        cvt_plain(a.in[I_OWOUT], D, D, D, nullptr, (bf16*)(ws + W1_OUT), r, scr, lane);
    }
}
constexpr int MOE_D_ITEMS = NE * 56 * 32, MOE_GU_ITEMS = NE * 2 * 16 * 112;
DI CvtJob moe_job(const Args& a, int it, int lane) {
    if (it < MOE_D_ITEMS) { const int e = it / (56 * 32), r = it % (56 * 32), kb = r / 32, nb = r % 32;
        return cvt_job(a.in[I_MD] + (size_t)e * FFE * D, D, FFE, nullptr, (bf16*)(a.ws + WS_WMD) + (size_t)e * D * FFE, 32 * nb, 64 * kb, 32 * nb, lane); }
    const int i2 = it - MOE_D_ITEMS, e = i2 / (2 * 16 * 112), r0 = i2 % (2 * 16 * 112), up = r0 / (16 * 112), r = r0 % (16 * 112), kb = r / 112, nb = r % 112, n0 = 32 * nb;
    return cvt_job((up ? a.in[I_MU] : a.in[I_MG]) + (size_t)e * D * FFE, FFE, D, a.in[I_LNFFN] + D, (bf16*)a.out + (size_t)e * 2 * FFE * D, (n0 >> 7) * 256 + up * 128 + (n0 & 127), 64 * kb, n0, lane);
}
DI void moe_convert(const Args& a, int first, int stride, int lane) {
    constexpr int N = MOE_D_ITEMS + MOE_GU_ITEMS;
    for (int it = first; it < N; it += 4 * stride) {
        CvtJob j0 = moe_job(a, it, lane); CvtRegs r0, r1, r2, r3; cvt_ld(j0, r0);
        const bool h1 = it + stride < N, h2 = it + 2 * stride < N, h3 = it + 3 * stride < N;
        CvtJob j1 = moe_job(a, h1 ? it + stride : it, lane), j2 = moe_job(a, h2 ? it + 2 * stride : it, lane), j3 = moe_job(a, h3 ? it + 3 * stride : it, lane);
        cvt_ld(j1, r1); cvt_ld(j2, r2); cvt_ld(j3, r3);
        cvt_st(j0, r0); if (h1) cvt_st(j1, r1); if (h2) cvt_st(j2, r2); if (h3) cvt_st(j3, r3);
    }
}

struct LruFrags { bf16x8 wa[4][2], wi[4][2]; };
DI void lru_frags(const Args& a, LAS unsigned char* lds, LruFrags& F, int wave, int lane) {
    const int g = lane >> 4, c16 = lane & 15;
    LAS float* scr = (LAS float*)(lds + wave * 16384);
#pragma unroll
    for (int gate = 0; gate < 2; ++gate) {
        const f32x4* W = (const f32x4*)((gate ? a.in[I_WI] : a.in[I_WA]) + wave * 4096);
#pragma unroll
        for (int q = 0; q < 16; ++q) ((LAS f32x4*)scr)[q * 64 + lane] = W[q * 64 + lane];
        LDS_WAIT();
        const LAS float* sp = scr + (8 * g) * 64 + c16;
#pragma unroll
        for (int jt = 0; jt < 4; ++jt)
#pragma unroll
            for (int ks = 0; ks < 2; ++ks) { float t[8];
#pragma unroll
                for (int e = 0; e < 8; ++e) t[e] = sp[(32 * ks + e) * 64 + 16 * jt];
                v4u p; p.x = pk2(t[0], t[1]); p.y = pk2(t[2], t[3]); p.z = pk2(t[4], t[5]); p.w = pk2(t[6], t[7]);
                if (gate) F.wi[jt][ks] = __builtin_bit_cast(bf16x8, p); else F.wa[jt][ks] = __builtin_bit_cast(bf16x8, p); }
        LDS_WAIT();
    }
}
DI void lru_unit(const Args& a, LAS unsigned char* lds, const LruFrags& F, int unit, int wave, int lane) {
    unsigned char* ws = a.ws;
    const int b = unit >> 7, chk = unit & 127, t0 = chk * 128, g = lane >> 4, c16 = lane & 15;
    const size_t rowb = (size_t)b * SEQ;
    const bf16* proj0 = (const bf16*)(ws + WS_PROJ0);
    unsigned* hp = (unsigned*)(ws + WS_LRUH);
    const int c = wave * 64 + lane;
    const float w0 = a.in[I_CONVW][c], w1 = a.in[I_CONVW][512 + c], w2 = a.in[I_CONVW][1024 + c], w3 = a.in[I_CONVW][1536 + c], cb = a.in[I_CONVB][c];
    const float ba = a.in[I_BA][c], bi = a.in[I_BI][c], lam = a.in[I_LAM][c];
    const float sp8 = 8.0f * (lam < -20.f ? -lam : log1pf(expf(-lam)));
    LAS bf16* XC = (LAS bf16*)(lds + wave * 11264);
    LAS float* GA = (LAS float*)(lds + wave * 11264 + 2304);
    LAS float* GI = GA + 16 * 68;
    float x1 = 0.f, x2 = 0.f, x3 = 0.f;
    if (t0 > 0) { x1 = bf2f(proj0[(rowb + t0 - 1) * E_IN + c]); x2 = bf2f(proj0[(rowb + t0 - 2) * E_IN + c]); x3 = bf2f(proj0[(rowb + t0 - 3) * E_IN + c]); }
    float h = 0.f, P = 1.f;
    bf16 xr[16];
#pragma unroll
    for (int tt = 0; tt < 16; ++tt) xr[tt] = proj0[(rowb + t0 + tt) * E_IN + c];
#pragma unroll 1
    for (int st = 0; st < 8; ++st) {
        float xc[16]; bf16 xcur[16];
#pragma unroll
        for (int tt = 0; tt < 16; ++tt) xcur[tt] = xr[tt];
        if (st < 7) {
#pragma unroll
            for (int tt = 0; tt < 16; ++tt) xr[tt] = proj0[(rowb + t0 + 16 * (st + 1) + tt) * E_IN + c]; }
#pragma unroll
        for (int tt = 0; tt < 16; ++tt) { const float xn = bf2f(xcur[tt]);
            xc[tt] = w0 * x3 + w1 * x2 + w2 * x1 + w3 * xn + cb; x3 = x2; x2 = x1; x1 = xn; XC[tt * 72 + lane] = (bf16)f2bf(xc[tt]); }
        LDS_WAIT();
        bf16x8 bx[2];
#pragma unroll
        for (int ks = 0; ks < 2; ++ks) bx[ks] = *(const LAS bf16x8*)(XC + c16 * 72 + 32 * ks + 8 * g);
#pragma unroll
        for (int jt = 0; jt < 4; ++jt) { f32x4 ca = {0.f, 0.f, 0.f, 0.f}, ci = {0.f, 0.f, 0.f, 0.f};
#pragma unroll
            for (int ks = 0; ks < 2; ++ks) { ca = MFMA16(F.wa[jt][ks], bx[ks], ca); ci = MFMA16(F.wi[jt][ks], bx[ks], ci); }
            *(LAS f32x4*)(GA + c16 * 68 + 16 * jt + 4 * g) = ca; *(LAS f32x4*)(GI + c16 * 68 + 16 * jt + 4 * g) = ci; }
        LDS_WAIT();
#pragma unroll
        for (int tt = 0; tt < 16; ++tt) {
            const float r = sigmoid_f(GA[tt * 68 + lane] + ba), gi = sigmoid_f(GI[tt * 68 + lane] + bi);
            const float la = -sp8 * r, av = __expf(la), mult = sqrtf(fmaxf(1.0f - av * av, 0.f));
            h = av * h + mult * gi * xc[tt]; P *= av;
            const size_t o = (rowb + t0 + 16 * st + tt) * LRU_W + c; hp[o] = pk2(h, P); }
        LDS_WAIT();
    }
    ((float*)(ws + MS_LRU_A))[(size_t)unit * 512 + c] = P; ((float*)(ws + MS_LRU_H))[(size_t)unit * 512 + c] = h;
}

DI void attn_unit(const Args& a, LAS unsigned char* lds, int unit, int tid, int wave, int lane) {
    unsigned char* ws = a.ws;
    const int kvh = unit & 1, blk = (unit >> 1) & 127, b = unit >> 8, t0 = blk * 128, g = lane >> 4, c = lane & 15;
    const size_t rowb = (size_t)b * SEQ;
    const bf16* proj0 = (const bf16*)(ws + WS_PROJ0); const f32x2* rope = (const f32x2*)(ws + WS_ROPE);
    LAS bf16* Ks = (LAS bf16*)lds;
    LAS bf16* Vt = (LAS bf16*)(lds + 36864);
    {
        const int key = tid >> 1, p = tid & 1, pos = t0 - 128 + key;
        if (pos >= 0) {
            const bf16* src = proj0 + (rowb + pos) * E_IN + 1536 + kvh * 64;
            const v4u q0 = *(const v4u*)(src + 16 * p), q1 = *(const v4u*)(src + 16 * p + 8), q2 = *(const v4u*)(src + 32 + 16 * p), q3 = *(const v4u*)(src + 32 + 16 * p + 8);
            float xa[16], xb[16];
            xa[0] = bflo(q0.x); xa[1] = bfhi(q0.x); xa[2] = bflo(q0.y); xa[3] = bfhi(q0.y); xa[4] = bflo(q0.z); xa[5] = bfhi(q0.z); xa[6] = bflo(q0.w); xa[7] = bfhi(q0.w);
            xa[8] = bflo(q1.x); xa[9] = bfhi(q1.x); xa[10] = bflo(q1.y); xa[11] = bfhi(q1.y); xa[12] = bflo(q1.z); xa[13] = bfhi(q1.z); xa[14] = bflo(q1.w); xa[15] = bfhi(q1.w);
            xb[0] = bflo(q2.x); xb[1] = bfhi(q2.x); xb[2] = bflo(q2.y); xb[3] = bfhi(q2.y); xb[4] = bflo(q2.z); xb[5] = bfhi(q2.z); xb[6] = bflo(q2.w); xb[7] = bfhi(q2.w);
            xb[8] = bflo(q3.x); xb[9] = bfhi(q3.x); xb[10] = bflo(q3.y); xb[11] = bfhi(q3.y); xb[12] = bflo(q3.z); xb[13] = bfhi(q3.z); xb[14] = bflo(q3.w); xb[15] = bfhi(q3.w);
            float ss = 0.f;
#pragma unroll
            for (int e = 0; e < 16; ++e) ss += xa[e] * xa[e] + xb[e] * xb[e];
            ss += __shfl_xor(ss, 1);
            const float rn = __builtin_amdgcn_rsqf(ss * (1.0f / 64.0f) + EPS);
            unsigned oa[8], ob[8];
#pragma unroll
            for (int e = 0; e < 16; e += 2) { float r1[2], r2[2];
#pragma unroll
                for (int k = 0; k < 2; ++k) { const int d = 16 * p + e + k; const f32x2 cs = rope[(size_t)pos * 32 + d];
                    const float y1 = xa[e + k] * rn * a.in[I_KN][d], y2 = xb[e + k] * rn * a.in[I_KN][32 + d]; r1[k] = y1 * cs.x - y2 * cs.y; r2[k] = y2 * cs.x + y1 * cs.y; }
                oa[e >> 1] = pk2(r1[0], r1[1]); ob[e >> 1] = pk2(r2[0], r2[1]); }
            v4u w; w.x = oa[0]; w.y = oa[1]; w.z = oa[2]; w.w = oa[3]; *(LAS v4u*)(Ks + key * 72 + 16 * p) = w;
            w.x = oa[4]; w.y = oa[5]; w.z = oa[6]; w.w = oa[7]; *(LAS v4u*)(Ks + key * 72 + 16 * p + 8) = w;
            w.x = ob[0]; w.y = ob[1]; w.z = ob[2]; w.w = ob[3]; *(LAS v4u*)(Ks + key * 72 + 32 + 16 * p) = w;
            w.x = ob[4]; w.y = ob[5]; w.z = ob[6]; w.w = ob[7]; *(LAS v4u*)(Ks + key * 72 + 32 + 16 * p + 8) = w;
            const bf16* vs = proj0 + (rowb + pos) * E_IN + 1664 + kvh * 64 + 32 * p;
#pragma unroll
            for (int q = 0; q < 4; ++q) { const v4u vv = *(const v4u*)(vs + 8 * q); const unsigned vw[4] = {vv.x, vv.y, vv.z, vv.w};
#pragma unroll
                for (int e = 0; e < 4; ++e) { Vt[(32 * p + 8 * q + 2 * e) * 264 + key] = (bf16)(vw[e] & 0xffffu); Vt[(32 * p + 8 * q + 2 * e + 1) * 264 + key] = (bf16)(vw[e] >> 16); } }
        } else {
            const v4u z = {0u, 0u, 0u, 0u};
            *(LAS v4u*)(Ks + key * 72 + 16 * p) = z; *(LAS v4u*)(Ks + key * 72 + 16 * p + 8) = z; *(LAS v4u*)(Ks + key * 72 + 32 + 16 * p) = z; *(LAS v4u*)(Ks + key * 72 + 32 + 16 * p + 8) = z;
#pragma unroll
            for (int e = 0; e < 32; ++e) Vt[(32 * p + e) * 264 + key] = (bf16)0;
        }
    }
    __syncthreads();
    const int hq = kvh * 4 + (wave >> 1), qh = wave & 1; const float sink = a.in[I_SINK][hq];
    bf16* ymix = (bf16*)(ws + WS_YMIX);
    v4u qr0[4], qr1[4];
#pragma unroll
    for (int qt = 0; qt < 4; ++qt) { const bf16* src = proj0 + (rowb + t0 + 64 * qh + 16 * qt + c) * E_IN + 1024 + hq * 64; qr0[qt] = *(const v4u*)(src + 8 * g); qr1[qt] = *(const v4u*)(src + 32 + 8 * g); }
#pragma unroll
    for (int qt = 0; qt < 4; ++qt) {
        const int q0 = 64 * qh + 16 * qt, kt0 = 4 * qh + qt; const int tok = t0 + q0 + c;
        bf16x8 bq[2];
        {   const v4u r0 = qr0[qt], r1 = qr1[qt];
            const unsigned u0[4] = {r0.x, r0.y, r0.z, r0.w}, u1[4] = {r1.x, r1.y, r1.z, r1.w}; float xa[8], xb[8]; float ss = 0.f;
#pragma unroll
            for (int e = 0; e < 4; ++e) { xa[2 * e] = bflo(u0[e]); xa[2 * e + 1] = bfhi(u0[e]); xb[2 * e] = bflo(u1[e]); xb[2 * e + 1] = bfhi(u1[e]); }
#pragma unroll
            for (int e = 0; e < 8; ++e) ss += xa[e] * xa[e] + xb[e] * xb[e];
            ss += __shfl_xor(ss, 16); ss += __shfl_xor(ss, 32);
            const float rn = __builtin_amdgcn_rsqf(ss * (1.0f / 64.0f) + EPS) * 0.125f;
            float o1[8], o2[8];
#pragma unroll
            for (int e = 0; e < 8; ++e) { const int d = 8 * g + e; const f32x2 cs = rope[(size_t)tok * 32 + d];
                const float y1 = xa[e] * rn * a.in[I_QN][d], y2 = xb[e] * rn * a.in[I_QN][32 + d]; o1[e] = y1 * cs.x - y2 * cs.y; o2[e] = y2 * cs.x + y1 * cs.y; }
            v4u w; w.x = pk2(o1[0], o1[1]); w.y = pk2(o1[2], o1[3]); w.z = pk2(o1[4], o1[5]); w.w = pk2(o1[6], o1[7]); bq[0] = __builtin_bit_cast(bf16x8, w);
            w.x = pk2(o2[0], o2[1]); w.y = pk2(o2[2], o2[3]); w.z = pk2(o2[4], o2[5]); w.w = pk2(o2[6], o2[7]); bq[1] = __builtin_bit_cast(bf16x8, w);
        }
        f32x4 s[9]; float mx = -1e30f;
        const int qi = 128 + q0 + c;
#pragma unroll
        for (int kt = 0; kt < 9; ++kt) {
            const LAS bf16* kp = Ks + (16 * (kt0 + kt) + c) * 72 + 8 * g;
            f32x4 acc = {0.f, 0.f, 0.f, 0.f};
            acc = MFMA16(*(const LAS bf16x8*)kp, bq[0], acc); acc = MFMA16(*(const LAS bf16x8*)(kp + 32), bq[1], acc);
#pragma unroll
            for (int r = 0; r < 4; ++r) { const int kj = 16 * (kt0 + kt) + 4 * g + r; const bool ok = (kj <= qi) && (qi - kj < 128) && (blk > 0 || kj >= 128);
                acc[r] = ok ? acc[r] : -1e30f; mx = fmaxf(mx, acc[r]); }
            s[kt] = acc;
        }
        mx = fmaxf(mx, __shfl_xor(mx, 16)); mx = fmaxf(mx, __shfl_xor(mx, 32)); mx = fmaxf(mx, sink);
        float sum = 0.f;
#pragma unroll
        for (int kt = 0; kt < 9; ++kt)
#pragma unroll
            for (int r = 0; r < 4; ++r) { const float p = (s[kt][r] > -1e29f) ? __expf(s[kt][r] - mx) : 0.f; s[kt][r] = p; sum += p; }
        sum += __shfl_xor(sum, 16); sum += __shfl_xor(sum, 32); sum += __expf(sink - mx);
        const float inv = __builtin_amdgcn_rcpf(sum);
        bf16x8 bp[5];
#pragma unroll
        for (int pp = 0; pp < 4; ++pp) bp[pp] = pack_acc2(s[2 * pp] * inv, s[2 * pp + 1] * inv);
        { const f32x4 z = {0.f, 0.f, 0.f, 0.f}; bp[4] = pack_acc2(s[8] * inv, z); }
#pragma unroll
        for (int dt = 0; dt < 4; ++dt) { f32x4 o = {0.f, 0.f, 0.f, 0.f};
#pragma unroll
            for (int pp = 0; pp < 5; ++pp) { const LAS bf16* vp = Vt + (16 * dt + c) * 264 + 16 * (kt0 + 2 * pp) + 4 * g;
                const v2u lo = *(const LAS v2u*)vp, hi = *(const LAS v2u*)(vp + (pp < 4 ? 16 : 0)); o = MFMA16(mk8(lo, hi), bp[pp], o); }
            v2u w; w.x = pk2(o[0], o[1]); w.y = pk2(o[2], o[3]); *(v2u*)(ymix + (rowb + tok) * D + 512 + hq * 64 + 16 * dt + 4 * g) = w; }
    }
    __syncthreads();
}

DI void lrufix_unit(const Args& a, int unit, int tid) {
    unsigned char* ws = a.ws;
    const int b = unit >> 7, chk = unit & 127, c = tid;
    const float* At = (const float*)(ws + MS_LRU_A); const float* Ht = (const float*)(ws + MS_LRU_H);
    float hin = 0.f;
    for (int c0 = 0; c0 < chk; c0 += 8) { float av[8], hv[8];
#pragma unroll
        for (int e = 0; e < 8; ++e) { const int cc = c0 + e < chk ? c0 + e : chk - 1; const size_t o = (size_t)(b * 128 + cc) * 512 + c; av[e] = At[o]; hv[e] = Ht[o]; }
#pragma unroll
        for (int e = 0; e < 8; ++e) if (c0 + e < chk) hin = av[e] * hin + hv[e]; }
    const unsigned* hp = (const unsigned*)(ws + WS_LRUH);
    const bf16* proj0 = (const bf16*)(ws + WS_PROJ0); bf16* ymix = (bf16*)(ws + WS_YMIX);
    for (int t0 = 0; t0 < 128; t0 += 8) { float hl[8], pc[8], xg[8];
#pragma unroll
        for (int e = 0; e < 8; ++e) { const size_t row = (size_t)b * SEQ + chk * 128 + t0 + e; const unsigned w = hp[row * LRU_W + c]; hl[e] = bflo(w); pc[e] = bfhi(w); xg[e] = bf2f(proj0[row * E_IN + 512 + c]); }
#pragma unroll
        for (int e = 0; e < 8; ++e) { const size_t row = (size_t)b * SEQ + chk * 128 + t0 + e; const float h = hl[e] + pc[e] * hin, x = xg[e];
            const float z = 0.7978845608028654f * (x + 0.044715f * x * x * x); const float th = 1.0f - 2.0f * __builtin_amdgcn_rcpf(1.0f + __expf(2.0f * z));
            ymix[row * D + c] = (bf16)f2bf(h * 0.5f * x * (1.0f + th)); } }
}
DI void skinny_tile(const Args& a, int tile, int lane) {
    unsigned char* ws = a.ws; const int g = lane >> 4, c = lane & 15;
    const bf16* wsk = (const bf16*)(ws + MS_WSK) + c * D + 8 * g; const bf16* hb = (const bf16*)(ws + WS_HB) + (size_t)(tile * 16 + c) * D + 8 * g;
    f32x4 acc = {0.f, 0.f, 0.f, 0.f};
#pragma unroll 8
    for (int ks = 0; ks < 32; ++ks) acc = MFMA16(*(const bf16x8*)(wsk + 32 * ks), *(const bf16x8*)(hb + 32 * ks), acc);
    const int row = tile * 16 + c; const float rs = pg8::rstd16((const float*)(ws + WS_STA), row);
    *(f32x4*)((float*)(ws + WS_AB) + (size_t)row * 16 + 4 * g) = acc * rs;
}

DI void conv_unit(const Args& a, int unit, int tid) {
    if (tid >= 384) return;
    unsigned char* ws = a.ws; const int b = unit >> 8, ck = unit & 255, col = 8 * tid;
    bf16* p = (bf16*)(ws + WS_QKV) + ((size_t)b * SEQ + (size_t)ck * 64) * 3072 + col;
    float w[4][8];
#pragma unroll
    for (int j = 0; j < 4; ++j) { const f32x4 w0 = *(const f32x4*)(a.in[I_OCONV] + j * 3072 + col), w1 = *(const f32x4*)(a.in[I_OCONV] + j * 3072 + col + 4);
#pragma unroll
        for (int e = 0; e < 4; ++e) { w[j][e] = w0[e]; w[j][4 + e] = w1[e]; } }
    float x1[8], x2[8], x3[8];
    if (ck > 0) { const bf16* hp = (const bf16*)(ws + WS_HALO) + (size_t)(b * NCH + ck - 1) * 3 * 3072 + col; const v4u h3 = *(const v4u*)hp, h2 = *(const v4u*)(hp + 3072), h1 = *(const v4u*)(hp + 6144);
        const unsigned u3[4] = {h3.x, h3.y, h3.z, h3.w}, u2[4] = {h2.x, h2.y, h2.z, h2.w}, u1[4] = {h1.x, h1.y, h1.z, h1.w};
#pragma unroll
        for (int e = 0; e < 4; ++e) { x3[2 * e] = bflo(u3[e]); x3[2 * e + 1] = bfhi(u3[e]); x2[2 * e] = bflo(u2[e]); x2[2 * e + 1] = bfhi(u2[e]); x1[2 * e] = bflo(u1[e]); x1[2 * e + 1] = bfhi(u1[e]); } }
    else {
#pragma unroll
        for (int e = 0; e < 8; ++e) { x1[e] = 0.f; x2[e] = 0.f; x3[e] = 0.f; } }
    for (int j0 = 0; j0 < 64; j0 += 8) { v4u raw[8];
#pragma unroll
        for (int t = 0; t < 8; ++t) raw[t] = *(const v4u*)(p + (size_t)(j0 + t) * 3072);
#pragma unroll
        for (int t = 0; t < 8; ++t) { const unsigned uw[4] = {raw[t].x, raw[t].y, raw[t].z, raw[t].w}; float y[8];
#pragma unroll
            for (int e = 0; e < 8; ++e) { const float xn = (e & 1) ? bfhi(uw[e >> 1]) : bflo(uw[e >> 1]); const float v = w[0][e] * x3[e] + w[1][e] * x2[e] + w[2][e] * x1[e] + w[3][e] * xn; x3[e] = x2[e]; x2[e] = x1[e]; x1[e] = xn; y[e] = silu_f(v); }
            v4u o; o.x = pk2(y[0], y[1]); o.y = pk2(y[2], y[3]); o.z = pk2(y[4], y[5]); o.w = pk2(y[6], y[7]); *(v4u*)(p + (size_t)(j0 + t) * 3072) = o; }
    }
}

constexpr int PR_XQ = 0, PR_XK = 17408;
constexpr int PR_KT = 36448, PR_VT = 54880;
constexpr int PR_SLOT = 73728, PR_SLOTB = 9216, PR_VEC = 147456, PR_VECB = 1536;
DI int lrow_off(int i) { const int m = (i - 1) >> 2; return i <= 0 ? 0 : 8 * m * (m + 1) + (i - 1 - 4 * m) * 4 * (m + 1); }
struct PrepRegs { v4u a[2], b[2]; float ab0, ab1; };
DI void prep_load(const unsigned char* ws, PrepRegs& r, int unit, int colA, int colB, int tid_, bool want_ab) {
    int tid = tid_; asm volatile("" : "+v"(tid));
    const int ck = unit & 255, h = (unit >> 8) & 7, b = unit >> 11; const size_t R0 = (size_t)b * SEQ + (size_t)ck * 64;
    const bf16* qkv = (const bf16*)(ws + WS_QKV);
#pragma unroll
    for (int k = 0; k < 2; ++k) { const int idx = tid + 512 * k, row = idx >> 4, c16 = idx & 15; const bf16* p = qkv + (R0 + row) * 3072 + h * 128 + 8 * c16; r.a[k] = *(const v4u*)(p + colA); r.b[k] = *(const v4u*)(p + colB); }
    if (want_ab && tid >= 448) { const float* ab = (const float*)(ws + WS_AB) + (R0 + (tid - 448)) * 16; r.ab0 = ab[h]; r.ab1 = ab[8 + h]; }
}
DI void prep_stage(LAS unsigned char* lds, const PrepRegs& r, int tid_) {
    int tid = tid_; asm volatile("" : "+v"(tid));
#pragma unroll
    for (int k = 0; k < 2; ++k) { const int idx = tid + 512 * k, row = idx >> 4, c16 = idx & 15;
        *(LAS v4u*)((LAS bf16*)(lds + PR_XQ) + row * 136 + 8 * c16) = r.a[k]; *(LAS v4u*)((LAS bf16*)(lds + PR_XK) + row * 136 + 8 * c16) = r.b[k]; }
}
DI void prep_front_a(const Args& a, LAS unsigned char* lds, int unit, int slot, const PrepRegs& R, int tid, int wave, int lane, const bool dry) {
    unsigned char* ws = a.ws;
    const int ck = unit & 255, h = (unit >> 8) & 7, b = unit >> 11, g = lane >> 4, c = lane & 15;
    const size_t R0 = (size_t)b * SEQ + (size_t)ck * 64;
    bf16* qkv = (bf16*)(ws + WS_QKV);
    LAS bf16* XQ = (LAS bf16*)(lds + PR_XQ); LAS bf16* XK = (LAS bf16*)(lds + PR_XK);
    LAS float* Ls = (LAS float*)(lds + PR_SLOT + slot * PR_SLOTB);
    LAS float* Gs = (LAS float*)(lds + PR_VEC + slot * PR_VECB); LAS float* Bs = Gs + 64; LAS float* Rq = Gs + 128; LAS float* Rk = Gs + 192; LAS float* SK = Gs + 256; LAS float* SD = Gs + 320;
    prep_stage(lds, R, tid);
    if (wave == 7) {
        const float xin = R.ab0 + a.in[I_DTB][h]; const float sp = xin > 20.f ? xin : log1pf(expf(xin));
        float G = -expf(a.in[I_ALOG][h]) * sp;
#pragma unroll
        for (int o = 1; o < 64; o <<= 1) { const float v = __shfl_up(G, o); if (lane >= o) G += v; }
        Gs[lane] = G; Bs[lane] = sigmoid_f(R.ab1);
        if (lane == 63 && !dry) ((float*)(ws + MS_GLAST))[unit] = expf(G);
    }
}
DI void prep_front_b(const Args& a, LAS unsigned char* lds, int unit, int slot, int tid_, int wave, int lane_, const bool dry) {
    unsigned char* ws = a.ws; int tid = tid_; asm volatile("" : "+v"(tid)); const int lane = tid & 63; (void)lane_;
    const int ck = unit & 255, h = (unit >> 8) & 7, b = unit >> 11, g = lane >> 4, c = lane & 15;
    const size_t R0 = (size_t)b * SEQ + (size_t)ck * 64;
    bf16* qkv = (bf16*)(ws + WS_QKV);
    LAS bf16* XQ = (LAS bf16*)(lds + PR_XQ); LAS bf16* XK = (LAS bf16*)(lds + PR_XK);
    LAS float* Ls = (LAS float*)(lds + PR_SLOT + slot * PR_SLOTB);
    LAS float* Gs = (LAS float*)(lds + PR_VEC + slot * PR_VECB); LAS float* Bs = Gs + 64; LAS float* Rq = Gs + 128; LAS float* Rk = Gs + 192; LAS float* SK = Gs + 256; LAS float* SD = Gs + 320;
    __syncthreads();
    { const int row = tid >> 2, qtr = tid & 3; const LAS bf16* s = (row < 64 ? XQ + row * 136 : XK + (row - 64) * 136) + 32 * qtr; float ss = 0.f;
#pragma unroll
      for (int q = 0; q < 4; ++q) { const v4u v = *(const LAS v4u*)(s + 8 * q); const unsigned vw[4] = {v.x, v.y, v.z, v.w};
#pragma unroll
          for (int e = 0; e < 4; ++e) { const float l = bflo(vw[e]), hh = bfhi(vw[e]); ss += l * l + hh * hh; } }
      ss += __shfl_xor(ss, 1); ss += __shfl_xor(ss, 2);
      const float rn = __builtin_amdgcn_rsqf(ss + EPS);
      if (qtr == 0) { if (row < 64) Rq[row] = rn * 0.08838834764831845f; else { const int j = row - 64; Rk[j] = rn; const float Gj = Gs[j]; SK[j] = -Bs[j] * rn * __expf(Gj); SD[j] = rn * __expf(Gs[63] - Gj); } } }
    __syncthreads();
    bf16* aq = (bf16*)(ws + WS_AQK) + (size_t)unit * 4096;
    for (int job = wave; job < 26; job += 8) {
        int it, jt; const bool isk = job < 10;
        if (isk) { it = job >= 6 ? 3 : (job >= 3 ? 2 : (job >= 1 ? 1 : 0)); jt = job - it * (it + 1) / 2; } else { it = (job - 10) >> 2; jt = (job - 10) & 3; }
        const int i = 16 * it + c, j0 = 16 * jt + 4 * g;
        bf16* aqf = aq + ((it * 2 + (jt >> 1)) * 64 + lane) * 8 + (jt & 1) * 4;
        if (it < jt) { const v2u z = {0u, 0u}; if (!dry && !isk) *(v2u*)aqf = z; continue; }
        const LAS bf16* ap = XK + (16 * jt + c) * 136 + 8 * g; const LAS bf16* bp = (isk ? XK : XQ) + (16 * it + c) * 136 + 8 * g;
        f32x4 acc = {0.f, 0.f, 0.f, 0.f};
#pragma unroll
        for (int ks = 0; ks < 4; ++ks) acc = MFMA16(*(const LAS bf16x8*)(ap + 32 * ks), *(const LAS bf16x8*)(bp + 32 * ks), acc);
        const float Gi = Gs[i], ri = isk ? Bs[i] * Rk[i] : Rq[i]; f32x4 o;
#pragma unroll
        for (int r = 0; r < 4; ++r) { const int j = j0 + r; const bool ok = isk ? (i > j) : (i >= j); const float dcy = __expf(fminf(Gi - Gs[j], 0.f)); o[r] = ok ? acc[r] * ri * Rk[j] * dcy : 0.f; }
        if (isk) { LAS float* lp = Ls + lrow_off(i) + j0;
#pragma unroll
            for (int r = 0; r < 4; ++r) if (j0 + r < i) lp[r] = o[r]; }
        else { v2u w; w.x = pk2(o[0], o[1]); w.y = pk2(o[2], o[3]); if (!dry) *(v2u*)aqf = w; }
    }
#pragma unroll
    for (int k = 0; k < 2; ++k) { const int task = tid + 512 * k, i = task >> 4, dc = task & 15; const float sc = Rq[i] * __expf(Gs[i]);
        const v4u v = *(const LAS v4u*)(XQ + i * 136 + 8 * dc); v4u o;
        o.x = pk2(bflo(v.x) * sc, bfhi(v.x) * sc); o.y = pk2(bflo(v.y) * sc, bfhi(v.y) * sc); o.z = pk2(bflo(v.z) * sc, bfhi(v.z) * sc); o.w = pk2(bflo(v.w) * sc, bfhi(v.w) * sc);
        if (!dry) *(v4u*)(qkv + (R0 + i) * 3072 + h * 128 + 8 * dc) = o; }
    __syncthreads();
}
DI void prep_invert(LAS unsigned char* lds, int slot, int lane) {
    LAS float* Ls = (LAS float*)(lds + PR_SLOT + slot * PR_SLOTB);
    float t[64]; int ln = lane; asm volatile("" : "+v"(ln));
#pragma unroll
    for (int i = 0; i < 64; ++i) { float a0 = (i == ln) ? 1.f : 0.f, a1 = 0.f, a2 = 0.f, a3 = 0.f;
#pragma unroll
        for (int k4 = 0; k4 < (i + 3) / 4; ++k4) { const f32x4 l = *(const LAS f32x4*)(Ls + lrow_off(i) + 4 * k4);
            if (4 * k4 + 0 < i) a0 -= l[0] * t[4 * k4 + 0]; if (4 * k4 + 1 < i) a1 -= l[1] * t[4 * k4 + 1]; if (4 * k4 + 2 < i) a2 -= l[2] * t[4 * k4 + 2]; if (4 * k4 + 3 < i) a3 -= l[3] * t[4 * k4 + 3];
            if ((k4 & 3) == 3) asm volatile("" ::: "memory"); }
        t[i] = (a0 + a1) + (a2 + a3); asm volatile("" ::: "memory"); }
    LDS_WAIT();
    LAS bf16* Tb = (LAS bf16*)Ls;
#pragma unroll
    for (int i = 0; i < 64; ++i) Tb[i * 72 + lane] = (bf16)f2bf(t[i]);
}
DI void prep_back(const Args& a, LAS unsigned char* lds, int unit, int slot, int tid_, int wave, int lane_, const bool dry) {
    unsigned char* ws = a.ws; int tid = tid_; asm volatile("" : "+v"(tid)); const int lane = tid & 63; (void)lane_;
    const int ck = unit & 255, h = (unit >> 8) & 7, b = unit >> 11, g = lane >> 4, c = lane & 15;
    const size_t R0 = (size_t)b * SEQ + (size_t)ck * 64;
    bf16* qkv = (bf16*)(ws + WS_QKV);
    LAS bf16* KT = (LAS bf16*)(lds + PR_KT); LAS bf16* VT = (LAS bf16*)(lds + PR_VT); const LAS bf16* Tb = (const LAS bf16*)(lds + PR_SLOT + slot * PR_SLOTB);
    const LAS float* Gs = (const LAS float*)(lds + PR_VEC + slot * PR_VECB); const LAS float* Bs = Gs + 64; const LAS float* SK = Gs + 256; const LAS float* SD = Gs + 320;
    __syncthreads();
    {   const int part = tid >> 8, half = (tid >> 7) & 1, ch = tid & 127;
        const LAS bf16* rw = (const LAS bf16*)(lds + (part ? PR_XK : PR_XQ)) + (32 * half) * 136 + ch; LAS bf16* to = (part ? VT : KT) + ch * 72 + 32 * half;
        const LAS float* s0 = (part ? Bs : SK) + 32 * half; const LAS float* s1 = SD + 32 * half;
        bf16* kd = qkv + (R0 + (ch >> 1)) * 3072 + 2048 + h * 128 + (ch & 1) * 64 + 32 * half;
#pragma unroll
        for (int j8 = 0; j8 < 4; ++j8) { float x[8];
#pragma unroll
            for (int e = 0; e < 8; ++e) x[e] = bf2f(rw[(8 * j8 + e) * 136]);
            const f32x4 sa = *(const LAS f32x4*)(s0 + 8 * j8), sb = *(const LAS f32x4*)(s0 + 8 * j8 + 4);
            v4u w; w.x = pk2(x[0] * sa[0], x[1] * sa[1]); w.y = pk2(x[2] * sa[2], x[3] * sa[3]); w.z = pk2(x[4] * sb[0], x[5] * sb[1]); w.w = pk2(x[6] * sb[2], x[7] * sb[3]); *(LAS v4u*)(to + 8 * j8) = w;
            if (part == 0) { const f32x4 da = *(const LAS f32x4*)(s1 + 8 * j8), db = *(const LAS f32x4*)(s1 + 8 * j8 + 4);
                v4u o; o.x = pk2(x[0] * da[0], x[1] * da[1]); o.y = pk2(x[2] * da[2], x[3] * da[3]); o.z = pk2(x[4] * db[0], x[5] * db[1]); o.w = pk2(x[6] * db[2], x[7] * db[3]); if (!dry) *(v4u*)(kd + 8 * j8) = o; } }
    }
    __syncthreads();
    bf16* uT = (bf16*)(ws + WS_UT) + (size_t)unit * 8192;
    for (int job = wave; job < 64; job += 8) {
        f32x4 acc = {0.f, 0.f, 0.f, 0.f};
        if (job < 32) { const int it = job >> 3, et = job & 7; const LAS bf16* ap = Tb + (16 * it + c) * 72 + 8 * g; const LAS bf16* bp = VT + (16 * et + c) * 72 + 8 * g;
#pragma unroll
            for (int ks = 0; ks < 2; ++ks) acc = MFMA16(*(const LAS bf16x8*)(ap + 32 * ks), *(const LAS bf16x8*)(bp + 32 * ks), acc);
            v2u w; w.x = pk2(acc[0], acc[1]); w.y = pk2(acc[2], acc[3]); if (!dry) *(v2u*)(uT + (16 * et + c) * 64 + 16 * it + 4 * g) = w;
        } else { const int dt = (job - 32) >> 2, it = (job - 32) & 3; const LAS bf16* ap = KT + (16 * dt + c) * 72 + 8 * g; const LAS bf16* bp = Tb + (16 * it + c) * 72 + 8 * g;
#pragma unroll
            for (int ks = 0; ks < 2; ++ks) acc = MFMA16(*(const LAS bf16x8*)(ap + 32 * ks), *(const LAS bf16x8*)(bp + 32 * ks), acc);
            v2u w; w.x = pk2(acc[0], acc[1]); w.y = pk2(acc[2], acc[3]); if (!dry) *(v2u*)(qkv + (R0 + 16 * it + c) * 3072 + 1024 + h * 128 + 16 * dt + 4 * g) = w; }
    }
}
#ifndef MK_SUBSTAMP
#define MK_SUBSTAMP 0
#endif
DI void prep_phase(const Args& a, LAS unsigned char* lds, int first, int stride, int n, int tid, int wave, int lane, const bool dry, unsigned long long& st_acc) {
    const unsigned char* ws = a.ws; unsigned long long t0 = 0ull; (void)t0;
#define PSB(i) do { if (MK_SUBSTAMP == (i)) t0 = __builtin_amdgcn_s_memrealtime(); } while (0)
#define PSE(i) do { if (MK_SUBSTAMP == (i)) st_acc += __builtin_amdgcn_s_memrealtime() - t0; } while (0)
    for (int b0 = 0; b0 < n; b0 += 8) {
        const int nb = (n - b0) < 8 ? (n - b0) : 8;
        PrepRegs R;
        PSB(3);
        prep_load(ws, R, first + b0 * stride, 0, 1024, tid, true);
        for (int s = 0; s < nb; ++s) {
            const int unit = first + (b0 + s) * stride;
            prep_front_a(a, lds, unit, s, R, tid, wave, lane, dry);
            if (s + 1 < nb) prep_load(ws, R, unit + stride, 0, 1024, tid, true);
            prep_front_b(a, lds, unit, s, tid, wave, lane, dry);
        }
        PSE(3); PSB(4);
#ifndef NO_INV
        if (wave < nb) prep_invert(lds, wave, lane);
#endif
        prep_load(ws, R, first + b0 * stride, 1024, 2048, tid, false);
        __syncthreads();
        PSE(4); PSB(5);
        for (int s = 0; s < nb; ++s) {
            const int unit = first + (b0 + s) * stride;
            prep_stage(lds, R, tid);
            if (s + 1 < nb) prep_load(ws, R, unit + stride, 1024, 2048, tid, false);
            prep_back(a, lds, unit, s, tid, wave, lane, dry);
        }
        __syncthreads();
        PSE(5);
    }
#undef PSB
#undef PSE
}

#ifndef MK_SUBSTAMP
#define MK_SUBSTAMP 0
#endif
constexpr int SC_SLOT = 51200, SC_W = 0, SC_K = 16384, SC_U = 32768, SC_Q = 34816;
constexpr int SC_DUMP = 3 * SC_SLOT, SC_XS = SC_DUMP + 1024, SC_XV = SC_XS + 4096, SC_FLAG = SC_XV + 2048;
static_assert(SC_FLAG + 128 <= LDSCTL_OFF, "scan LDS map");
DI const LAS v2u* sw256(const LAS unsigned char* base, int row, int j, int half) { return (const LAS v2u*)(base + row * 256 + ((j ^ (row & 15)) << 4) + half * 8); }
DI const LAS v2u* sw128(const LAS unsigned char* base, int row, int j, int half) { return (const LAS v2u*)(base + row * 128 + ((j ^ ((row >> 1) & 7)) << 4) + half * 8); }
#define SCAN_BAR() do { asm volatile("s_waitcnt lgkmcnt(0)" ::: "memory"); __builtin_amdgcn_s_barrier(); asm volatile("" ::: "memory"); } while (0)
struct AFrag { v4u v[8]; };
DI void af_load(AFrag& f, const unsigned char* ws, unsigned off) {
#pragma unroll
    for (int k = 0; k < 8; ++k) asm volatile("global_load_dwordx4 %0, %1, %2" : "=v"(f.v[k]) : "v"(off + (unsigned)k * 1024u), "s"(ws) : "memory");
}
#define AF_WAIT(N, f) asm volatile("s_waitcnt vmcnt(" #N ")" : "+v"(f.v[0]), "+v"(f.v[1]), "+v"(f.v[2]), "+v"(f.v[3]), "+v"(f.v[4]), "+v"(f.v[5]), "+v"(f.v[6]), "+v"(f.v[7]) :: "memory")
template <int w> DI void scan_crit(const unsigned char* ws, LAS unsigned char* lds, int b, int h, int lane) {
    const int g = lane >> 4, c = lane & 15, gh = g >> 1, gl1 = g & 1;
    LAS v4u* XS = (LAS v4u*)(lds + SC_XS); LAS v4u* XV = (LAS v4u*)(lds + SC_XV);
        const float* glast = (const float*)(ws + MS_GLAST) + (b * GH + h) * NCH;
        { const v4u z = {0u, 0u, 0u, 0u}; XS[(2 * w) * 64 + lane] = z; XS[(2 * w + 1) * 64 + lane] = z; }
        SCAN_BAR();
        f32x4 S[4]; bf16x8 Sb[4];
#pragma unroll
        for (int i = 0; i < 4; ++i) { S[i] = (f32x4){0.f, 0.f, 0.f, 0.f}; Sb[i] = (bf16x8){0, 0, 0, 0, 0, 0, 0, 0}; }
        int slot = 0;
        const unsigned lw = (unsigned)((32 * w + c) * 256 + gl1 * 8), lk = (unsigned)((64 * w + c) * 128 + gl1 * 8), lu = (unsigned)(c * 128 + gl1 * 8), kx = (unsigned)((c >> 1) & 7);
        unsigned xw[4][2], xk[2][2], xu[2];
#pragma unroll
        for (int s = 0; s < 4; ++s)
#pragma unroll
            for (int t = 0; t < 2; ++t) xw[s][t] = (unsigned)(((4 * s + 2 * t + gh) ^ c) << 4);
#pragma unroll
        for (int s = 0; s < 2; ++s)
#pragma unroll
            for (int t = 0; t < 2; ++t) xk[s][t] = (((unsigned)(4 * s + 2 * t + gh)) ^ kx) << 4;
#pragma unroll
        for (int j = 0; j < 2; ++j) xu[j] = (((unsigned)(2 * (2 * w + j) + gh)) ^ kx) << 4;
        for (int ck = 0; ck < NCH; ++ck) {
            const LAS unsigned char* cur = lds + slot * SC_SLOT; slot = slot == 2 ? 0 : slot + 1;
            const float gl = glast[ck]; f32x4 vn[2]; bf16x8 wf[2][4], kf[4][2]; v2u uf[2];
#pragma unroll
            for (int s = 0; s < 4; ++s) { const LAS unsigned char* p0 = cur + SC_W + lw + xw[s][0]; const LAS unsigned char* p1 = cur + SC_W + lw + xw[s][1];
#pragma unroll
                for (int j = 0; j < 2; ++j) wf[j][s] = mk8(*(const LAS v2u*)(p0 + j * 4096), *(const LAS v2u*)(p1 + j * 4096)); }
#pragma unroll
            for (int j = 0; j < 2; ++j) uf[j] = *(const LAS v2u*)(cur + SC_U + lu + xu[j]);
#pragma unroll
            for (int s = 0; s < 2; ++s) { const LAS unsigned char* p0 = cur + SC_K + lk + xk[s][0]; const LAS unsigned char* p1 = cur + SC_K + lk + xk[s][1];
#pragma unroll
                for (int d = 0; d < 4; ++d) kf[d][s] = mk8(*(const LAS v2u*)(p0 + d * 2048), *(const LAS v2u*)(p1 + d * 2048)); }
            if (ck > 0) { Sb[2 - 2 * w] = __builtin_bit_cast(bf16x8, XS[(2 - 2 * w) * 64 + lane]); Sb[3 - 2 * w] = __builtin_bit_cast(bf16x8, XS[(3 - 2 * w) * 64 + lane]); }
#pragma unroll
            for (int j = 0; j < 2; ++j) { f32x4 acc = {bflo(uf[j].x), bfhi(uf[j].x), bflo(uf[j].y), bfhi(uf[j].y)};
#pragma unroll
                for (int s = 0; s < 4; ++s) acc = MFMA16(wf[j][s], Sb[s], acc);
                vn[j] = acc; }
            bf16x8 vb[2]; vb[w] = pack_acc2(vn[0], vn[1]);
            XV[w * 64 + lane] = __builtin_bit_cast(v4u, vb[w]);
            SCAN_BAR();
            vb[1 - w] = __builtin_bit_cast(bf16x8, XV[(1 - w) * 64 + lane]);
#pragma unroll
            for (int d = 0; d < 4; ++d) { f32x4 acc = S[d] * gl;
#pragma unroll
                for (int s = 0; s < 2; ++s) acc = MFMA16(kf[d][s], vb[s], acc);
                S[d] = acc; }
            Sb[2 * w] = pack_acc2(S[0], S[1]); Sb[2 * w + 1] = pack_acc2(S[2], S[3]);
            XS[(2 * w) * 64 + lane] = __builtin_bit_cast(v4u, Sb[2 * w]); XS[(2 * w + 1) * 64 + lane] = __builtin_bit_cast(v4u, Sb[2 * w + 1]);
            SCAN_BAR();
        }
}
DI void scan_chain(const Args& a, LAS unsigned char* lds, int chain, int tid, int wave, int lane, const bool dry, unsigned long long& st_acc) {
    unsigned char* ws = a.ws; (void)st_acc;
    const int es = chain & 7, h = (chain >> 3) & 7, b = chain >> 6, g = lane >> 4, c = lane & 15, gh = g >> 1, gl1 = g & 1;
    LAS v4u* XS = (LAS v4u*)(lds + SC_XS); LAS v4u* XV = (LAS v4u*)(lds + SC_XV);
    __syncthreads();
    if (wave == 0) scan_crit<0>(ws, lds, b, h, lane); else if (wave == 1) scan_crit<1>(ws, lds, b, h, lane);
    else if (wave == 2) {
        const int unit0 = (b * GH + h) * NCH;
        bf16* oT = (bf16*)(ws + WS_UT) + (size_t)unit0 * 8192 + (16 * es + c) * 64 + 4 * g;
        const unsigned aoff = (unsigned)(WS_AQK + ((size_t)unit0 * 4096 + lane * 8) * 2);
        AFrag F0, F1, F2;
        const unsigned lw = (unsigned)(c * 256 + gl1 * 8); unsigned xw[4][2];
#pragma unroll
        for (int s = 0; s < 4; ++s)
#pragma unroll
            for (int t = 0; t < 2; ++t) xw[s][t] = (unsigned)(((4 * s + 2 * t + gh) ^ c) << 4);
        af_load(F0, ws, aoff); af_load(F1, ws, aoff + 8192u);
        unsigned anext = aoff + 2u * 8192u; bf16* onext = oT;
        SCAN_BAR();
#define OUT_STEP(ck, FX, FZ) do { \
            const LAS unsigned char* cur = lds + ((ck) % 3) * SC_SLOT; \
            if ((ck) + 2 < NCH) { af_load(FZ, ws, anext); anext += 8192u; } \
            bf16x8 So[4], qf[4][4]; f32x4 acc[4]; \
            _Pragma("unroll") for (int s = 0; s < 4; ++s) So[s] = __builtin_bit_cast(bf16x8, XS[s * 64 + lane]); \
            _Pragma("unroll") for (int s = 0; s < 4; ++s) { const LAS unsigned char* p0 = cur + SC_Q + lw + xw[s][0]; const LAS unsigned char* p1 = cur + SC_Q + lw + xw[s][1]; \
                _Pragma("unroll") for (int jt = 0; jt < 4; ++jt) qf[jt][s] = mk8(*(const LAS v2u*)(p0 + jt * 4096), *(const LAS v2u*)(p1 + jt * 4096)); } \
            _Pragma("unroll") for (int jt = 0; jt < 4; ++jt) { acc[jt] = (f32x4){0.f, 0.f, 0.f, 0.f}; \
                _Pragma("unroll") for (int s = 0; s < 4; ++s) acc[jt] = MFMA16(qf[jt][s], So[s], acc[jt]); } \
            SCAN_BAR(); \
            bf16x8 vb[2]; vb[0] = __builtin_bit_cast(bf16x8, XV[lane]); vb[1] = __builtin_bit_cast(bf16x8, XV[64 + lane]); \
            if ((ck) + 2 >= NCH) AF_WAIT(0, FX); else if ((ck) == 0) AF_WAIT(16, FX); else if ((ck) == 1) AF_WAIT(20, FX); else AF_WAIT(24, FX); \
            _Pragma("unroll") for (int jt = 0; jt < 4; ++jt) { \
                _Pragma("unroll") for (int s = 0; s < 2; ++s) acc[jt] = MFMA16(__builtin_bit_cast(bf16x8, FX.v[jt * 2 + s]), vb[s], acc[jt]); \
                v2u w; w.x = pk2(acc[jt][0], acc[jt][1]); w.y = pk2(acc[jt][2], acc[jt][3]); \
                if (!dry) asm volatile("global_store_dwordx2 %0, %1, off" :: "v"(onext + 16 * jt), "v"(w) : "memory"); } \
            onext += 8192; \
            SCAN_BAR(); } while (0)
        for (int c0 = 0; c0 < NCH; c0 += 3) {
            OUT_STEP(c0, F0, F2);
            if (c0 + 1 < NCH) OUT_STEP(c0 + 1, F1, F0);
            if (c0 + 2 < NCH) OUT_STEP(c0 + 2, F2, F1);
        }
#undef OUT_STEP
        asm volatile("s_waitcnt vmcnt(0)" ::: "memory");
    } else if (wave == 6) {
        SCAN_BAR();
        for (int ck = 0; ck < NCH; ++ck) { SCAN_BAR(); SCAN_BAR(); }
    } else {
        const size_t R0 = (size_t)b * SEQ; const int unit0 = (b * GH + h) * NCH, lw = wave == 7 ? 3 : wave - 3;
        unsigned gc[13], ic[13], lc[13];
#pragma unroll
        for (int k = 0; k < 13; ++k) { int r = lw + 4 * k; const bool pad = r >= 50; if (pad) r = lw; size_t gg; unsigned gi, ll;
            if (r < 16) { const int row = 4 * r + (lane >> 4), j = (lane & 15) ^ (row & 15); gg = WS_QKV + ((R0 + row) * 3072 + 1024 + h * 128 + 8 * j) * 2; gi = 64u * 3072u * 2u; ll = SC_W + r * 1024; }
            else if (r < 32) { const int d = 8 * (r - 16) + (lane >> 3), j = (lane & 7) ^ ((d >> 1) & 7); gg = WS_QKV + ((R0 + (d >> 1)) * 3072 + 2048 + h * 128 + (d & 1) * 64 + 8 * j) * 2; gi = 64u * 3072u * 2u; ll = SC_K + (r - 16) * 1024; }
            else if (r < 34) { const int e = 8 * (r - 32) + (lane >> 3), j = (lane & 7) ^ ((e >> 1) & 7); gg = WS_UT + ((size_t)unit0 * 8192 + (16 * es + e) * 64 + 8 * j) * 2; gi = 16384u; ll = SC_U + (r - 32) * 1024; }
            else { const int row = 4 * (r - 34) + (lane >> 4), j = (lane & 15) ^ (row & 15); gg = WS_QKV + ((R0 + row) * 3072 + h * 128 + 8 * j) * 2; gi = 64u * 3072u * 2u; ll = SC_Q + (r - 34) * 1024; }
            gc[k] = (unsigned)gg; ic[k] = gi; lc[k] = pad ? 0xffffffffu : ll; }
#define DMA_C(slot) do { _Pragma("unroll") for (int k = 0; k < 13; ++k) { \
            __builtin_amdgcn_global_load_lds((const unsigned*)(ws + gc[k]), (LAS unsigned*)(lds + (lc[k] == 0xffffffffu ? (unsigned)SC_DUMP : (unsigned)(slot) * SC_SLOT + lc[k])), 16, 0, 0); gc[k] += ic[k]; } } while (0)
        DMA_C(0); DMA_C(1);
        asm volatile("s_waitcnt vmcnt(0)" ::: "memory");
        SCAN_BAR();
        int s2 = 2;
        for (int ck = 0; ck < NCH; ++ck) {
            if (ck + 2 < NCH) DMA_C(s2);
            s2 = s2 == 2 ? 0 : s2 + 1;
            SCAN_BAR();
            if (ck + 2 < NCH) asm volatile("s_waitcnt vmcnt(13)" ::: "memory"); else asm volatile("s_waitcnt vmcnt(0)" ::: "memory");
            SCAN_BAR();
        }
#undef DMA_C
    }
    __syncthreads();
}

DI void onorm_unit(const Args& a, LAS float* red  , int unit, int it, int wave, int lane) {
    unsigned char* ws = a.ws;
    const int ck = unit & 255, h = (unit >> 8) & 7, b = unit >> 11; const size_t row = (size_t)b * SEQ + (size_t)ck * 64 + lane;
    const bf16* oT = (const bf16*)(ws + WS_UT) + (size_t)unit * 8192 + (16 * wave) * 64 + lane;
    float v[16]; float ss = 0.f;
#pragma unroll
    for (int k = 0; k < 16; ++k) { v[k] = bf2f(oT[k * 64]); ss += v[k] * v[k]; }
    LAS float* rb = red + (it & 1) * 512; rb[wave * 64 + lane] = ss;
    const bf16* gp = (const bf16*)(ws + WS_GATE) + row * D + h * 128 + 16 * wave; const v4u g0 = *(const v4u*)gp, g1 = *(const v4u*)(gp + 8);
    __syncthreads();
    float tot = 0.f;
#pragma unroll
    for (int w = 0; w < 8; ++w) tot += rb[w * 64 + lane];
    const float rs = __builtin_amdgcn_rsqf(tot * (1.0f / 128.0f) + EPS);
    const unsigned gw[8] = {g0.x, g0.y, g0.z, g0.w, g1.x, g1.y, g1.z, g1.w}; unsigned o[8];
    const float* on = a.in[I_ONORM] + 16 * wave;
#pragma unroll
    for (int k = 0; k < 8; ++k) { const float ga = bflo(gw[k]), gb = bfhi(gw[k]); o[k] = pk2(v[2 * k] * rs * on[2 * k] * silu_f(ga), v[2 * k + 1] * rs * on[2 * k + 1] * silu_f(gb)); }
    bf16* op = (bf16*)(ws + WS_ON) + row * D + h * 128 + 16 * wave;
    v4u w0, w1; w0.x = o[0]; w0.y = o[1]; w0.z = o[2]; w0.w = o[3]; w1.x = o[4]; w1.y = o[5]; w1.z = o[6]; w1.w = o[7]; *(v4u*)op = w0; *(v4u*)(op + 8) = w1;
}

DI void route_unit(const Args& a, LAS int* esel, int unit, int wave, int lane) {
    unsigned char* ws = a.ws;
    const float* rt = (const float*)(ws + MS_ROUT);
    f32x4 rr[4][4][2];
#pragma unroll
    for (int j = 0; j < 4; ++j)
#pragma unroll
        for (int i = 0; i < 4; ++i) { const f32x4* p = (const f32x4*)(rt + (size_t)(4 * (64 * j + lane) + i) * 8); rr[j][i][0] = p[0]; rr[j][i][1] = p[1]; }
    for (int tl = 16 * wave; tl < 16 * wave + 16; ++tl) {
        const int tok = unit * 128 + tl;
        const v2u* xr = (const v2u*)((const bf16*)(ws + WS_HB) + (size_t)tok * D) + lane;
        float acc[8] = {0.f, 0.f, 0.f, 0.f, 0.f, 0.f, 0.f, 0.f};
#pragma unroll
        for (int j = 0; j < 4; ++j) { const v2u xw = xr[64 * j]; const f32x4 x = {bflo(xw.x), bfhi(xw.x), bflo(xw.y), bfhi(xw.y)};
#pragma unroll
            for (int i = 0; i < 4; ++i)
#pragma unroll
                for (int e = 0; e < 8; ++e) acc[e] += x[i] * rr[j][i][e >> 2][e & 3]; }
#pragma unroll
        for (int e = 0; e < 8; ++e) acc[e] = wave_sum(acc[e]);
        const float rs = pg8::rstd16((const float*)(ws + WS_STB), tok);
        int e1 = 0; float l1 = acc[0];
#pragma unroll
        for (int e = 1; e < 8; ++e) if (acc[e] > l1) { l1 = acc[e]; e1 = e; }
        int e2 = -1; float l2 = -3.0e38f;
#pragma unroll
        for (int e = 0; e < 8; ++e) if (e != e1 && acc[e] > l2) { l2 = acc[e]; e2 = e; }
        const float w1 = __builtin_amdgcn_rcpf(1.0f + __expf((l2 - l1) * rs));
        if (lane == 0) { ((int*)(ws + MS_TOKE))[tok] = e1 | (e2 << 8); ((float*)(ws + MS_TOKW))[2 * tok] = w1; ((float*)(ws + MS_TOKW))[2 * tok + 1] = 1.0f - w1; esel[2 * tl] = e1; esel[2 * tl + 1] = e2; }
    }
    __syncthreads();
    { int base = 0;
      for (int i = 0; i < 4; ++i) { const bool m = esel[64 * i + lane] == wave; const unsigned long long mask = __ballot(m);
          if (m) ((int*)(ws + MS_RANK))[unit * 256 + 64 * i + lane] = base + __popcll(mask & ((1ull << lane) - 1ull)); base += __popcll(mask); }
      if (lane == 0) ((int*)(ws + MS_CNT))[unit * 8 + wave] = base; }
    __syncthreads();
}

DI void gather_unit(const Args& a, LAS int* sm  , int unit, int tid, int wave, int lane) {
    unsigned char* ws = a.ws;
    const int* cnt = (const int*)(ws + MS_CNT);
    if (tid < 8) { int tot = 0, off = 0; for (int u = 0; u < 256; ++u) { const int v = cnt[u * 8 + tid]; tot += v; if (u < unit) off += v; } sm[tid] = tot; sm[8 + tid] = off; }
    __syncthreads();
    if (tid == 0) { int s = 0; for (int e = 0; e < 8; ++e) { sm[16 + e] = s; s += ((sm[e] + 255) >> 8) << 8; } sm[24] = s;
        if (unit == 0) { int* te = (int*)(ws + MS_TILEE); for (int e = 0; e < 8; ++e) for (int t = sm[16 + e] >> 8; t < (sm[16 + e + 1] >> 8); ++t) te[t] = e; te[MAXTILES] = s >> 8; } }
    __syncthreads();
    const bf16* hb3 = (const bf16*)(ws + WS_HB); bf16* xg = (bf16*)(ws + WS_XG); float* rg = (float*)(ws + MS_RG);
    for (int s0 = 32 * wave; s0 < 32 * wave + 32; s0 += 4) { int dest[4]; v4u r0[4], r1[4];
#pragma unroll
        for (int q = 0; q < 4; ++q) { const int s = s0 + q, tok = unit * 128 + (s >> 1), k = s & 1; const int e = (((const int*)(ws + MS_TOKE))[tok] >> (8 * k)) & 0xff;
            dest[q] = sm[16 + e] + sm[8 + e] + ((const int*)(ws + MS_RANK))[unit * 256 + s];
            const v4u* src = (const v4u*)(hb3 + (size_t)tok * D) + lane; r0[q] = src[0]; r1[q] = src[64]; }
#pragma unroll
        for (int q = 0; q < 4; ++q) { const int s = s0 + q, tok = unit * 128 + (s >> 1), k = s & 1; const float rs = pg8::rstd16((const float*)(ws + WS_STB), tok);
            if (lane == 0) ((int*)(ws + MS_DEST))[2 * tok + k] = dest[q];
            v4u a0 = r0[q], a1 = r1[q];
            a0.x = pk2(bflo(a0.x) * rs, bfhi(a0.x) * rs); a0.y = pk2(bflo(a0.y) * rs, bfhi(a0.y) * rs); a0.z = pk2(bflo(a0.z) * rs, bfhi(a0.z) * rs); a0.w = pk2(bflo(a0.w) * rs, bfhi(a0.w) * rs);
            a1.x = pk2(bflo(a1.x) * rs, bfhi(a1.x) * rs); a1.y = pk2(bflo(a1.y) * rs, bfhi(a1.y) * rs); a1.z = pk2(bflo(a1.z) * rs, bfhi(a1.z) * rs); a1.w = pk2(bflo(a1.w) * rs, bfhi(a1.w) * rs);
            v4u* dst = (v4u*)(xg + (size_t)dest[q] * D) + lane; dst[0] = a0; dst[64] = a1; }
    }
    if (unit < 8) {
        const int e = unit, r0 = sm[16 + e] + sm[e], r1 = sm[16 + e + 1]; const v4u z = {0u, 0u, 0u, 0u};
        for (int r = r0 + wave; r < r1; r += 8) { v4u* dst = (v4u*)(xg + (size_t)r * D) + lane; dst[0] = z; dst[64] = z; }
    }
    __syncthreads();
}

DI void combine_row(const Args& a, int tok, int lane) {
    unsigned char* ws = a.ws;
    const int d1 = ((const int*)(ws + MS_DEST))[2 * tok], d2 = ((const int*)(ws + MS_DEST))[2 * tok + 1];
    const float w1 = ((const float*)(ws + MS_TOKW))[2 * tok], w2 = ((const float*)(ws + MS_TOKW))[2 * tok + 1];
    const bf16* y = (const bf16*)(ws + WS_XG);
    f32x4* o = (f32x4*)(a.out + (size_t)tok * D) + 4 * lane;
    const v4u* y1 = (const v4u*)(y + (size_t)d1 * D) + 2 * lane; const v4u* y2 = (const v4u*)(y + (size_t)d2 * D) + 2 * lane; const v4u* hh = (const v4u*)((const bf16*)(ws + WS_HB) + (size_t)tok * D) + 2 * lane;
#pragma unroll
    for (int q = 0; q < 2; ++q) { const v4u p1 = y1[q], p2 = y2[q], p0 = hh[q]; const unsigned a1[4] = {p1.x, p1.y, p1.z, p1.w}, a2[4] = {p2.x, p2.y, p2.z, p2.w}, a0[4] = {p0.x, p0.y, p0.z, p0.w};
#pragma unroll
        for (int e = 0; e < 2; ++e) { f32x4 v;
            v[0] = bflo(a0[2 * e]) + w1 * bflo(a1[2 * e]) + w2 * bflo(a2[2 * e]); v[1] = bfhi(a0[2 * e]) + w1 * bfhi(a1[2 * e]) + w2 * bfhi(a2[2 * e]);
            v[2] = bflo(a0[2 * e + 1]) + w1 * bflo(a1[2 * e + 1]) + w2 * bflo(a2[2 * e + 1]); v[3] = bfhi(a0[2 * e + 1]) + w1 * bfhi(a1[2 * e + 1]) + w2 * bfhi(a2[2 * e + 1]); o[2 * q + e] = v; } }
}

DI void combine_rows4(const Args& a, int tok0, int stride, int lane) {
    unsigned char* ws = a.ws; const bf16* y = (const bf16*)(ws + WS_XG);
    int d1[4], d2[4]; float w1[4], w2[4]; v4u p0[4][2], p1[4][2], p2[4][2];
#pragma unroll
    for (int r = 0; r < 4; ++r) { const int tok = tok0 + r * stride < T ? tok0 + r * stride : tok0;
        d1[r] = ((const int*)(ws + MS_DEST))[2 * tok]; d2[r] = ((const int*)(ws + MS_DEST))[2 * tok + 1]; w1[r] = ((const float*)(ws + MS_TOKW))[2 * tok]; w2[r] = ((const float*)(ws + MS_TOKW))[2 * tok + 1];
        const v4u* hh = (const v4u*)((const bf16*)(ws + WS_HB) + (size_t)tok * D) + 2 * lane; p0[r][0] = hh[0]; p0[r][1] = hh[1]; }
    const int ntl = ((const int*)(ws + MS_TILEE))[MAXTILES], trows = (ntl - 4 * PASS_TILES) * 256; const bf16* part = (const bf16*)(ws + WS_PART);
#pragma unroll
    for (int r = 0; r < 4; ++r) {
#pragma unroll
        for (int k = 0; k < 2; ++k) { const int d = k ? d2[r] : d1[r]; v4u q0, q1;
            if (d < 4 * PASS_TILES * 256) { const v4u* yy = (const v4u*)(y + (size_t)d * D) + 2 * lane; q0 = yy[0]; q1 = yy[1]; }
            else { float s[16];
#pragma unroll
                for (int e = 0; e < 16; ++e) s[e] = 0.f;
                for (int ks = 0; ks < 7; ++ks) { const v4u* pp = (const v4u*)(part + ((size_t)ks * trows + (d - 4 * PASS_TILES * 256)) * D) + 2 * lane; const v4u a0 = pp[0], a1 = pp[1]; const unsigned w[8] = {a0.x, a0.y, a0.z, a0.w, a1.x, a1.y, a1.z, a1.w};
#pragma unroll
                    for (int e = 0; e < 8; ++e) { s[2 * e] += bflo(w[e]); s[2 * e + 1] += bfhi(w[e]); } }
                q0.x = pk2(s[0], s[1]); q0.y = pk2(s[2], s[3]); q0.z = pk2(s[4], s[5]); q0.w = pk2(s[6], s[7]); q1.x = pk2(s[8], s[9]); q1.y = pk2(s[10], s[11]); q1.z = pk2(s[12], s[13]); q1.w = pk2(s[14], s[15]); }
            if (k) { p2[r][0] = q0; p2[r][1] = q1; } else { p1[r][0] = q0; p1[r][1] = q1; } } }
#pragma unroll
    for (int r = 0; r < 4; ++r) { const int tok = tok0 + r * stride; if (tok >= T) break;
        f32x4* o = (f32x4*)(a.out + (size_t)tok * D) + 4 * lane;
#pragma unroll
        for (int q = 0; q < 2; ++q) { const unsigned a0[4] = {p0[r][q].x, p0[r][q].y, p0[r][q].z, p0[r][q].w}, a1[4] = {p1[r][q].x, p1[r][q].y, p1[r][q].z, p1[r][q].w}, a2[4] = {p2[r][q].x, p2[r][q].y, p2[r][q].z, p2[r][q].w};
#pragma unroll
            for (int e = 0; e < 2; ++e) { f32x4 v;
                v[0] = bflo(a0[2 * e]) + w1[r] * bflo(a1[2 * e]) + w2[r] * bflo(a2[2 * e]); v[1] = bfhi(a0[2 * e]) + w1[r] * bfhi(a1[2 * e]) + w2[r] * bfhi(a2[2 * e]);
                v[2] = bflo(a0[2 * e + 1]) + w1[r] * bflo(a1[2 * e + 1]) + w2[r] * bflo(a2[2 * e + 1]); v[3] = bfhi(a0[2 * e + 1]) + w1[r] * bfhi(a1[2 * e + 1]) + w2[r] * bfhi(a2[2 * e + 1]); o[2 * q + e] = v; } } }
}
constexpr int NPHASE = 23;
#ifndef MK_SUB
#define MK_SUB 3
#endif
#ifndef MK_ONE_LAUNCH
#define MK_ONE_LAUNCH 1
#endif
template <int P> DI void moe_pass(const Args& args, LAS unsigned char* lds, int G, int which  ) {
    unsigned char* ws = args.ws;
    const int* te = (const int*)(ws + MS_TILEE); const int ntiles = te[MAXTILES];
    const int lo = PASS_TILES * P, hi = (P == 3) ? ntiles : (ntiles < PASS_TILES * (P + 1) ? ntiles : PASS_TILES * (P + 1));
    if (lo >= hi) return;
    if (which == 0) {
        pg8::Gemm g{(const bf16*)(ws + WS_XG), (const bf16*)args.out, MAXTILES * 256, 2 * FFE, D, D};
        pg8::MoeOrder S{lo, hi, 2 * FFE / 256, G, (int)blockIdx.x, te};
        pg8::EpiSwiGLU<true> E{(bf16*)(ws + WS_ACT), FFE, nullptr, 2 * FFE / 256, lo};
        pg8::gemm_phase<pg8::EpiSwiGLU<true>, pg8::MoeOrder, true, true>(lds, g, S, E);
    } else {
        const int hr = (P == 3 && hi > 4 * PASS_TILES) ? 4 * PASS_TILES : hi;
        pg8::Gemm g{(const bf16*)(ws + WS_ACT) - (size_t)lo * 256 * FFE, (const bf16*)(ws + WS_WMD), MAXTILES * 256, D, FFE, FFE};
        pg8::MoeOrder S{lo, hr, D / 256, G, (int)blockIdx.x, te};
        pg8::EpiPlain E{(bf16*)(ws + WS_XG)};
        pg8::gemm_phase<pg8::EpiPlain, pg8::MoeOrder, true, true>(lds, g, S, E);
        if (P == 3 && hi > hr) {
            pg8::Gemm g2{(const bf16*)(ws + WS_ACT) - (size_t)lo * 256 * FFE, (const bf16*)(ws + WS_WMD), MAXTILES * 256, D, FFE, 512};
            pg8::TailOrder S2{hr, hi, G, (int)blockIdx.x, te};
            pg8::EpiPart E2{(bf16*)(ws + WS_PART), hr, (hi - hr) * 256};
            pg8::gemm_phase<pg8::EpiPart, pg8::TailOrder, true, true>(lds, g2, S2, E2);
        }
    }
}

__global__ void __launch_bounds__(NTHREADS, 2) fwd(Args args) {
    extern __shared__ __attribute__((aligned(16))) unsigned char lds_raw[];
    LAS unsigned char* lds = (LAS unsigned char*)lds_raw;
    volatile LAS unsigned* MISC = (volatile LAS unsigned*)(lds + MISC_OFF);
    const int tid = threadIdx.x, lane = tid & 63, wave = __builtin_amdgcn_readfirstlane(tid >> 6);
    const int G = gridDim.x, bx = blockIdx.x;
    const int vcu = (G % 8 == 0) ? (bx % 8) * (G / 8) + bx / 8 : bx;
    const int gw = vcu * NWAVES + wave, NGW = G * NWAVES;
    unsigned char* ws = args.ws;
    gu32* ctl = (gu32*)(ws + WS_CTL);
    for (int u = tid; u < (LDS_BYTES - LDSCTL_OFF) / 4; u += NTHREADS) ((LAS unsigned*)(lds + LDSCTL_OFF))[u] = 0u;
    __syncthreads();
    const int lo = args.ph_lo, hi = args.ph_hi;
    XcdBarrier bar; bar.bar = (unsigned*)(ctl + CW_BAR); bar.x = 0; bar.st = nullptr;
    if (hi - lo > 1) bar = xcd_barrier_post((unsigned*)(ctl + CW_BAR), MISC + 8);
#ifndef MK_PHMASK
#define MK_PHMASK 0x7fffffu
#endif
#define IN(k) ((((MK_PHMASK) >> (k)) & 1u) && lo <= (k) && (k) < hi)
#ifndef MK_STAMPMASK
#define MK_STAMPMASK 0u
#endif
    unsigned long long st_acc = 0ull, st_t0 = 0ull;
#ifndef MK_SUBSTAMP
#define MK_SUBSTAMP 0
#endif
#define SUBSTAMP_BEGIN(i) do { if (MK_SUBSTAMP == (i)) st_t0 = __builtin_amdgcn_s_memrealtime(); } while (0)
#define SUBSTAMP_END(i) do { if (MK_SUBSTAMP == (i)) st_acc += __builtin_amdgcn_s_memrealtime() - st_t0; } while (0)
#define STAMPED(k) ((((MK_STAMPMASK) >> (k)) & 1u) != 0u)
#define SEAM(k) do { if (IN(k) && IN((k) + 1)) xcd_barrier(bar); if (STAMPED(k)) st_acc += __builtin_amdgcn_s_memrealtime() - st_t0; } while (0)
#ifndef MK_DUP
#define MK_DUP -1
#endif
#define PH(k, ...) if (STAMPED(k)) st_t0 = __builtin_amdgcn_s_memrealtime(); if (IN(k)) { if (MK_DUP == (k)) { int o_tid = tid; asm volatile("" : "+v"(o_tid)); unsigned long long o_ws = (unsigned long long)ws; asm volatile("" : "+s"(o_ws)); \
        { const int tid = o_tid, lane = tid & 63, wave = __builtin_amdgcn_readfirstlane(tid >> 6); unsigned char* const ws = (unsigned char*)o_ws; const int gw = vcu * NWAVES + wave; (void)lane; (void)gw; (void)ws; \
          const bool dry = (args.ph_hi > 0); (void)dry; __VA_ARGS__ } xcd_barrier(bar); } \
        { int p_tid = threadIdx.x; asm volatile("" : "+v"(p_tid)); const int tid = p_tid, lane = tid & 63, wave = __builtin_amdgcn_readfirstlane(tid >> 6), gw = vcu * NWAVES + wave; (void)lane; (void)gw; \
          const bool dry = false; (void)dry; __VA_ARGS__ } } SEAM(k);

    PH(0,  phase_prologue(args, lds, gw, NGW, wave, lane); __syncthreads(); )

    PH(1,
        pg8::Gemm g{(const bf16*)(ws + WS_HB), (const bf16*)(ws + W0_IN), T, E_IN, D, D}; pg8::StaticOrder S; S.init(T, E_IN, G, bx);
        pg8::rstd_prepass(S, (const float*)(ws + WS_STA), (float*)(ws + MS_RC));
        pg8::EpiProj<0> E{(bf16*)(ws + WS_PROJ0), E_IN, (const float*)(ws + MS_RC), nullptr, nullptr};
        pg8::gemm_phase<pg8::EpiProj<0>, pg8::StaticOrder, true, true>(lds, g, S, E);
        if (G == 256) { if (bx >= 128) weights_late(args, (bx - 128) * NWAVES + wave, 128 * NWAVES, lane); } else weights_late(args, gw, NGW, lane);
    )

    PH(2,
        if (MK_SUB & 1) { LruFrags LF; lru_frags(args, lds, LF, wave, lane); __syncthreads(); for (int u = vcu; u < NB * 128; u += G) lru_unit(args, lds, LF, u, wave, lane); }
        __syncthreads();
        if (MK_SUB & 2) for (int u = vcu; u < NB * 128 * 2; u += G) attn_unit(args, lds, u, tid, wave, lane);
    )

    PH(3,  for (int u = vcu; u < NB * 128; u += G) lrufix_unit(args, u, tid); )

    PH(4,
        pg8::Gemm g{(const bf16*)(ws + WS_YMIX), (const bf16*)(ws + W0_OUT), T, D, D, D}; pg8::StaticOrder S; S.init(T, D, G, bx);
        pg8::EpiResid E{(bf16*)(ws + WS_HB), (float*)(ws + WS_STB)};
        pg8::gemm_phase<pg8::EpiResid, pg8::StaticOrder, true, true>(lds, g, S, E);
    )

    PH(5,
        pg8::Gemm g{(const bf16*)(ws + WS_HB), (const bf16*)(ws + W0_GU), T, 2 * FF0, D, D}; pg8::StaticOrder S; S.init(T, 2 * FF0, G, bx);
        pg8::rstd_prepass(S, (const float*)(ws + WS_STB), (float*)(ws + MS_RC));
        pg8::EpiSwiGLU<false> E{(bf16*)(ws + WS_ACT0), FF0, (const float*)(ws + MS_RC), 0, 0};
        pg8::gemm_phase<pg8::EpiSwiGLU<false>, pg8::StaticOrder, true, true>(lds, g, S, E);
    )

    PH(6,
        pg8::Gemm g{(const bf16*)(ws + WS_ACT0), (const bf16*)(ws + W0_DN), T, D, FF0, FF0}; pg8::StaticOrder S; S.init(T, D, G, bx);
        pg8::EpiResid E{(bf16*)(ws + WS_HB), (float*)(ws + WS_STA)};
        pg8::gemm_phase<pg8::EpiResid, pg8::StaticOrder, true, true>(lds, g, S, E);
    )

    PH(7,
        pg8::Gemm g{(const bf16*)(ws + WS_HB), (const bf16*)(ws + W1_IN), T, 4096, D, D}; pg8::StaticOrder S; S.init(T, 4096, G, bx);
        pg8::rstd_prepass(S, (const float*)(ws + WS_STA), (float*)(ws + MS_RC));
        pg8::EpiProj<1> E{(bf16*)(ws + WS_QKV), 3072, (const float*)(ws + MS_RC), (bf16*)(ws + WS_GATE), (bf16*)(ws + WS_HALO)};
        pg8::gemm_phase<pg8::EpiProj<1>, pg8::StaticOrder, true, true>(lds, g, S, E);
        for (int t = gw; t < T / 16; t += NGW) skinny_tile(args, t, lane);
    )

    PH(8,  SUBSTAMP_BEGIN(1); for (int u = vcu; u < NB * NCH; u += G) conv_unit(args, u, tid);
        if (hi - lo > 1) xcd_barrier(bar); SUBSTAMP_END(1);
        SUBSTAMP_BEGIN(2); prep_phase(args, lds, vcu, G, (NUNIT - vcu + G - 1) / G, tid, wave, lane, dry, st_acc); SUBSTAMP_END(2); )

    PH(9,
        volatile LAS int* sq = (volatile LAS int*)(lds + LDSCTL_OFF + 64);
        if (tid == 0) { const unsigned x = xb_xcc_id() & 7u; const unsigned t = __hip_atomic_fetch_add((unsigned*)(ctl + CW_SCANQ + 64 * x), 1u, __ATOMIC_RELAXED, __HIP_MEMORY_SCOPE_AGENT);
            unsigned n[8]; unsigned tot = 0;
            for (int j = 0; j < 8; ++j) { n[j] = __hip_atomic_load((unsigned*)(ctl + CW_BAR) + XB_XCNT(j), __ATOMIC_RELAXED, __HIP_MEMORY_SCOPE_AGENT); tot += n[j]; }
            int chain = -1, wrank = 0, nwork = 0;
            if (tot != (unsigned)G || hi - lo <= 1) { chain = vcu < 128 ? vcu : -1; wrank = vcu - 128; nwork = G - 128; }
            else if (t < 16u) chain = (int)((2u * x + (t >> 3)) * 8u + (t & 7u));
            else { unsigned w = t - 16u, nl = 0, nw = 0;
                for (int j = 0; j < 8; ++j) { if ((unsigned)j < x && n[j] > 16u) w += n[j] - 16u; nl += n[j] < 16u ? 16u - n[j] : 0u; nw += n[j] > 16u ? n[j] - 16u : 0u; }
                if (w < nl) { unsigned r = w;
                    for (int j = 0; j < 8; ++j) { const unsigned lj = n[j] < 16u ? 16u - n[j] : 0u; if (chain < 0) { if (r < lj) { const unsigned tt = n[j] + r; chain = (int)((2u * j + (tt >> 3)) * 8u + (tt & 7u)); } else r -= lj; } } }
                else { wrank = (int)(w - nl); nwork = (int)(nw - nl); } }
            sq[0] = chain; sq[1] = wrank; sq[2] = nwork; }
        __syncthreads();
        const int chain = sq[0]; const int wrank = sq[1]; const int nwork = sq[2];
        __syncthreads();
        SUBSTAMP_BEGIN(6); if (chain >= 0) scan_chain(args, lds, chain, tid, wave, lane, dry, st_acc); SUBSTAMP_END(6);
        SUBSTAMP_BEGIN(7); if (chain < 0 && nwork > 0) { moe_convert(args, wrank * NWAVES + wave, nwork * NWAVES, lane); } SUBSTAMP_END(7);
        if (G < 128 + 1) { moe_convert(args, gw, NGW, lane); }
    )

    PH(10,
        LAS float* red = (LAS float*)lds; int it = 0;
        for (int u = vcu; u < NUNIT; u += G, ++it) onorm_unit(args, red, u, it, wave, lane);
        __syncthreads();
    )

    PH(11,
        pg8::Gemm g{(const bf16*)(ws + WS_ON), (const bf16*)(ws + W1_OUT), T, D, D, D}; pg8::StaticOrder S; S.init(T, D, G, bx);
        pg8::EpiResid E{(bf16*)(ws + WS_HB), (float*)(ws + WS_STB)};
        pg8::gemm_phase<pg8::EpiResid, pg8::StaticOrder, true, true>(lds, g, S, E);
    )

    PH(12,  for (int u = vcu; u < 256; u += G) route_unit(args, (LAS int*)lds, u, wave, lane); )
    PH(13,  for (int u = vcu; u < 256; u += G) gather_unit(args, (LAS int*)lds, u, tid, wave, lane); )

    PH(14, moe_pass<0>(args, lds, G, 0);)
    PH(15, moe_pass<0>(args, lds, G, 1);)
    PH(16, moe_pass<1>(args, lds, G, 0);)
    PH(17, moe_pass<1>(args, lds, G, 1);)
    PH(18, moe_pass<2>(args, lds, G, 0);)
    PH(19, moe_pass<2>(args, lds, G, 1);)
    PH(20, moe_pass<3>(args, lds, G, 0);)
    PH(21, moe_pass<3>(args, lds, G, 1);)

    PH(22, for (int t = gw; t < T; t += 4 * NGW) combine_rows4(args, t, NGW, lane); )
    if ((MK_STAMPMASK != 0u || MK_SUBSTAMP != 0) && blockIdx.x == 0 && tid == 0) { const unsigned long long t1 = __builtin_amdgcn_s_memrealtime(); while (__builtin_amdgcn_s_memrealtime() - t1 < st_acc) __builtin_amdgcn_s_sleep(8); }
#undef IN
#undef SEAM
#undef PH
}

extern "C" void kernel_launch(void* const* d_in, const int* in_sizes, int n_in, void* d_out, int out_size, void* d_ws, size_t ws_size, hipStream_t stream) {
    static int grid = 0;
    if (grid == 0) {
        if (n_in != 28 || out_size != T * D || ws_size < WS_END) { fprintf(stderr, "kernel_launch: unexpected problem (n_in %d, out %d, ws %zu)\n", n_in, out_size, ws_size); grid = -1; return; }
        int dev = 0, cus = 0, per_cu = 0;
        if (hipGetDevice(&dev) != hipSuccess || hipDeviceGetAttribute(&cus, hipDeviceAttributeMultiprocessorCount, dev) != hipSuccess) { grid = -1; return; }
        if (hipFuncSetAttribute((const void*)fwd, hipFuncAttributeMaxDynamicSharedMemorySize, LDS_BYTES) != hipSuccess) { fprintf(stderr, "kernel_launch: hipFuncSetAttribute failed\n"); grid = -1; return; }
        if (hipOccupancyMaxActiveBlocksPerMultiprocessor(&per_cu, (const void*)fwd, NTHREADS, LDS_BYTES) != hipSuccess || per_cu < 1) fprintf(stderr, "kernel_launch: occupancy query says %d\n", per_cu);
        (void)hipGetLastError();
        grid = cus;
    }
    if (grid < 0) return;
    if (hipMemsetAsync((char*)d_ws + WS_CTL, 0, CTL_ZERO_BYTES, stream) != hipSuccess) return;
    Args a{};
    for (int i = 0; i < 28; ++i) a.in[i] = (const float*)d_in[i];
    a.out = (float*)d_out; a.ws = (unsigned char*)d_ws;
#if MK_ONE_LAUNCH
    a.ph_lo = 0; a.ph_hi = NPHASE;
    hipLaunchKernelGGL(fwd, dim3(grid), dim3(NTHREADS), LDS_BYTES, stream, a);
#else
    for (int p = 0; p < NPHASE; ++p) { a.ph_lo = p; a.ph_hi = p + 1; hipLaunchKernelGGL(fwd, dim3(grid), dim3(NTHREADS), LDS_BYTES, stream, a); }
#endif
}
```

```cpp
#include <hip/hip_runtime.h>
#include <cstdio>
#include <cstdint>
#include <cmath>
namespace pg8 {
#define PG8_LAS __attribute__((address_space(3)))
typedef unsigned short bf16_t;
typedef short bf16x8 __attribute__((ext_vector_type(8)));
typedef float f32x4 __attribute__((ext_vector_type(4)));
typedef unsigned u32x4 __attribute__((ext_vector_type(4)));
constexpr int BM = 256, BK = 64, HALF = 128, HTB = HALF * BK * 2  , STAGE_BYTES = 8 * HTB, NXCD = 8, WGM = 8;

__host__ __device__ __forceinline__ int lds_byte(int r, int c) { const int st = (r >> 4) * 2 + (c >> 5), rr = r & 15, cc = c & 31, ob = rr * 64 + cc * 2; return st * 1024 + (ob ^ (((ob >> 9) & 1) << 5)); }
__host__ __device__ __forceinline__ void stage_rc(int b, int& R, int& C) { const int st = b / 1024, sb = b % 1024, swz = sb ^ (((sb >> 9) & 1) << 5); R = (st >> 1) * 16 + swz / 64; C = (st & 1) * 32 + (swz % 64) / 2; }
__host__ __device__ __forceinline__ int perm32(int rho) { const int n = rho >> 4, i = rho & 15; return 8 * (i >> 2) + 4 * n + (i & 3); }

struct Unit { int pm, pn, pk; };
struct Gemm { const bf16_t* A; const bf16_t* Bt; int M, N, K, Kt; };

struct StaticOrder {
    int nM, nN, nwg, G, c;
    __host__ __device__ void init(int M, int N, int G_, int c_) { nM = M / BM; nN = N / BM; nwg = nM * nN; G = G_; c = c_; }
    __host__ __device__ bool next(int i, Unit& u) const {
        const long L = (long)i * G + c; if (L >= nwg) return false;
        int wgid = (int)L; { const int q = nwg / NXCD, r = nwg % NXCD, xcd = wgid % NXCD, off = wgid / NXCD; wgid = (xcd < r ? xcd * (q + 1) : r * (q + 1) + (xcd - r) * q) + off; }
        const int nig = WGM * nN, gid = wgid / nig, fm = gid * WGM, gsz = (nM - fm) < WGM ? (nM - fm) : WGM;
        u.pm = fm + ((wgid % nig) % gsz); u.pn = (wgid % nig) / gsz; u.pk = 0; return true;
    }
    __device__ __forceinline__ void a_ready(const Unit&) const {}
    __device__ __forceinline__ void done(const Unit&) const {}
};

__device__ __forceinline__ unsigned cvt_pk_bf16(float lo, float hi) { unsigned r; asm volatile("v_cvt_pk_bf16_f32 %0, %1, %2" : "=v"(r) : "v"(lo), "v"(hi)); return r; }
typedef float f32x2 __attribute__((ext_vector_type(2)));
__device__ __forceinline__ float rstd16(const float* st, int row) {
    const f32x4* p = (const f32x4*)(st + (size_t)row * 16); const f32x4 a = p[0], b = p[1], c = p[2], d = p[3];
    const float s = ((a[0] + a[1]) + (a[2] + a[3])) + ((b[0] + b[1]) + (b[2] + b[3])) + ((c[0] + c[1]) + (c[2] + c[3])) + ((d[0] + d[1]) + (d[2] + d[3]));
    return __builtin_amdgcn_rsqf(s * (1.0f / 1024.0f) + 1e-6f);
}
__device__ __forceinline__ u32x4 pack8(const f32x4 v0, const f32x4 v1) { u32x4 w; w.x = cvt_pk_bf16(v0[0], v0[1]); w.y = cvt_pk_bf16(v0[2], v0[3]); w.z = cvt_pk_bf16(v1[0], v1[1]); w.w = cvt_pk_bf16(v1[2], v1[3]); return w; }
__device__ __forceinline__ float silu_f(float x) { return x * __builtin_amdgcn_rcpf(1.0f + __expf(-x)); }

template <int MODE> struct EpiProj {
    static constexpr bool PERM = true, AFTER_DRAIN = false;
    bf16_t* O; int ldo; const float* stats; bf16_t* gate; bf16_t* halo;
    __device__ __forceinline__ void operator()(const f32x4 (&acc)[2][2][4][2], const Unit& u, int wr, int wc, int fr, int fq) const {
        const int row0 = u.pm * BM + wr * 64 + fr, col0 = u.pn * BM + wc * 32 + 8 * fq;
#pragma unroll
        for (int ai = 0; ai < 2; ++ai)
#pragma unroll
            for (int m = 0; m < 4; ++m) { const int row = row0 + ai * HALF + m * 16; const float rs = stats[row];
#pragma unroll
                for (int bj = 0; bj < 2; ++bj) { const int col = col0 + bj * HALF; const u32x4 w = pack8(acc[ai][bj][m][0] * rs, acc[ai][bj][m][1] * rs);
                    if (MODE == 0) { *(u32x4*)(O + (size_t)row * ldo + col) = w; }
                    else { if (col < 3072) { const int prt = col >> 10, hh = (col >> 7) & 7, un = ((row >> 14) * 8 + hh) * 256 + ((row >> 6) & 255); *(u32x4*)(O + ((size_t)(un * 3 + prt) * 64 + (row & 63)) * 128 + (col & 127)) = w; if (m == 3 && fr >= 13) *(u32x4*)(halo + ((size_t)(row >> 6) * 3 + (fr - 13)) * 3072 + col) = w; }
                           else *(u32x4*)(gate + (size_t)row * 1024 + (col - 3072)) = w; } } }
    }
};
struct EpiResid {
    static constexpr bool PERM = true, AFTER_DRAIN = false;
    bf16_t* hb; float* stats;
    __device__ __forceinline__ void operator()(const f32x4 (&acc)[2][2][4][2], const Unit& u, int wr, int wc, int fr, int fq) const {
        const int row0 = u.pm * BM + wr * 64 + fr, col0 = u.pn * BM + wc * 32 + 8 * fq;
#pragma unroll
        for (int ai = 0; ai < 2; ++ai)
#pragma unroll
            for (int m = 0; m < 4; ++m) { const int row = row0 + ai * HALF + m * 16; float ss = 0.f;
#pragma unroll
                for (int bj = 0; bj < 2; ++bj) { const size_t off = (size_t)row * 1024 + col0 + bj * HALF;
                    const u32x4 r = *(const u32x4*)(hb + off);
                    const f32x4 r0 = {__builtin_bit_cast(float, r.x << 16), __builtin_bit_cast(float, r.x & 0xffff0000u), __builtin_bit_cast(float, r.y << 16), __builtin_bit_cast(float, r.y & 0xffff0000u)};
                    const f32x4 r1 = {__builtin_bit_cast(float, r.z << 16), __builtin_bit_cast(float, r.z & 0xffff0000u), __builtin_bit_cast(float, r.w << 16), __builtin_bit_cast(float, r.w & 0xffff0000u)};
                    const f32x4 v0 = acc[ai][bj][m][0] + r0, v1 = acc[ai][bj][m][1] + r1;
                    *(u32x4*)(hb + off) = pack8(v0, v1);
                    ss += ((v0[0] * v0[0] + v0[1] * v0[1]) + (v0[2] * v0[2] + v0[3] * v0[3])) + ((v1[0] * v1[0] + v1[1] * v1[1]) + (v1[2] * v1[2] + v1[3] * v1[3])); }
                ss += __shfl_xor(ss, 16); ss += __shfl_xor(ss, 32);
                if (fq == 0) stats[(size_t)row * 16 + (u.pn & 3) * 4 + wc] = ss; }
    }
};
template <bool MOE> struct EpiSwiGLU {
    static constexpr bool PERM = true, AFTER_DRAIN = false;
    bf16_t* O; int ldo; const float* stats; int ntn, pm_lo;
    __device__ __forceinline__ void operator()(const f32x4 (&acc)[2][2][4][2], const Unit& u, int wr, int wc, int fr, int fq) const {
        const int pnl = MOE ? (u.pn % ntn) : u.pn;
        const int row0 = u.pm * BM + wr * 64 + fr, col = pnl * HALF + wc * 32 + 8 * fq;
#pragma unroll
        for (int ai = 0; ai < 2; ++ai)
#pragma unroll
            for (int m = 0; m < 4; ++m) { const int row = row0 + ai * HALF + m * 16; const float rs = MOE ? 1.0f : stats[row];
                const f32x4 g0 = acc[ai][0][m][0] * rs, g1 = acc[ai][0][m][1] * rs, u0 = acc[ai][1][m][0] * rs, u1 = acc[ai][1][m][1] * rs; f32x4 a0, a1;
#pragma unroll
                for (int i = 0; i < 4; ++i) { a0[i] = silu_f(g0[i]) * u0[i]; a1[i] = silu_f(g1[i]) * u1[i]; }
                *(u32x4*)(O + (size_t)(row - pm_lo * BM) * ldo + col) = pack8(a0, a1); }
    }
};
struct EpiPlain {
    static constexpr bool PERM = true, AFTER_DRAIN = false;
    bf16_t* O;
    __device__ __forceinline__ void operator()(const f32x4 (&acc)[2][2][4][2], const Unit& u, int wr, int wc, int fr, int fq) const {
        const int row0 = u.pm * BM + wr * 64 + fr, col0 = (u.pn & 3) * BM + wc * 32 + 8 * fq;
#pragma unroll
        for (int ai = 0; ai < 2; ++ai)
#pragma unroll
            for (int m = 0; m < 4; ++m) { const int row = row0 + ai * HALF + m * 16;
#pragma unroll
                for (int bj = 0; bj < 2; ++bj) *(u32x4*)(O + (size_t)row * 1024 + col0 + bj * HALF) = pack8(acc[ai][bj][m][0], acc[ai][bj][m][1]); }
    }
};
template <class Sched> __device__ __forceinline__ void rstd_prepass(const Sched& S, const float* st, float* rc) {
    Unit u; const int tid = threadIdx.x;
    for (int i = 0; S.next(i, u); ++i) { const int row = u.pm * BM + (tid >> 1); const f32x4* p = (const f32x4*)(st + (size_t)row * 16) + 2 * (tid & 1); const f32x4 a = p[0], b = p[1];
        float s = ((a[0] + a[1]) + (a[2] + a[3])) + ((b[0] + b[1]) + (b[2] + b[3])); s += __shfl_xor(s, 1);
        if ((tid & 1) == 0) rc[row] = __builtin_amdgcn_rsqf(s * (1.0f / 1024.0f) + 1e-6f); }
    asm volatile("s_waitcnt vmcnt(0)" ::: "memory"); __syncthreads();
}
struct GroupOrder {
    int nM, nN, G, c;
    __device__ __forceinline__ void init(int M, int N, int G_, int c_) { nM = M / BM; nN = N / BM; G = G_; c = c_; }
    __device__ __forceinline__ bool next(int i, Unit& u) const {
        const long L = (long)i * G + c; if (L >= (long)nM * nN) return false;
        const int grp = (int)(L / (8 * nN)), fm = grp * 8, gsz = (nM - fm) < 8 ? (nM - fm) : 8, w = (int)(L - (long)grp * 8 * nN);
        u.pm = fm + (w % gsz); u.pn = w / gsz; u.pk = 0; return true;
    }
    __device__ __forceinline__ void a_ready(const Unit&) const {}
    __device__ __forceinline__ void done(const Unit&) const {}
};
struct MoeOrder {
    int lo, hi, NT, G, c; const int* tile_e;
    __device__ __forceinline__ bool next(int i, Unit& u) const {
        const long L = (long)i * G + c; const int nt = hi - lo; if (L >= (long)nt * NT) return false;
        const int grp = (int)(L / (8 * NT)), fm = grp * 8, gsz = (nt - fm) < 8 ? (nt - fm) : 8, w = (int)(L - (long)grp * 8 * NT), rt = lo + fm + (w % gsz);
        u.pm = rt; u.pn = tile_e[rt] * NT + (w / gsz); u.pk = 0; return true;
    }
    __device__ __forceinline__ void a_ready(const Unit&) const {}
    __device__ __forceinline__ void done(const Unit&) const {}
};

struct TailOrder {
    int lo, hi, G, c; const int* tile_e;
    __device__ __forceinline__ bool next(int i, Unit& u) const {
        const long L = (long)i * G + c; if (L >= (long)(hi - lo) * 28) return false;
        const int ks = (int)(L % 7), rest = (int)(L / 7), rt = lo + (rest >> 2);
        u.pm = rt; u.pn = tile_e[rt] * 4 + (rest & 3); u.pk = ks; return true;
    }
    __device__ __forceinline__ void a_ready(const Unit&) const {}
    __device__ __forceinline__ void done(const Unit&) const {}
};
struct EpiPart {
    static constexpr bool PERM = true, AFTER_DRAIN = false;
    bf16_t* P; int lo, rows;
    __device__ __forceinline__ void operator()(const f32x4 (&acc)[2][2][4][2], const Unit& u, int wr, int wc, int fr, int fq) const {
        const int row0 = (u.pm - lo) * BM + wr * 64 + fr, col0 = (u.pn & 3) * BM + wc * 32 + 8 * fq; bf16_t* base = P + (size_t)u.pk * rows * 1024;
#pragma unroll
        for (int ai = 0; ai < 2; ++ai)
#pragma unroll
            for (int m = 0; m < 4; ++m) { const int row = row0 + ai * HALF + m * 16;
#pragma unroll
                for (int bj = 0; bj < 2; ++bj) *(u32x4*)(base + (size_t)row * 1024 + col0 + bj * HALF) = pack8(acc[ai][bj][m][0], acc[ai][bj][m][1]); }
    }
};
template <class Epi, class Sched, bool ALIGN_EPI = false, bool SP2 = false>
__device__ __forceinline__ void gemm_phase(PG8_LAS unsigned char* lds, const Gemm g, const Sched& S, const Epi& E) {
    const int tid = threadIdx.x, wid = __builtin_amdgcn_readfirstlane(tid >> 6), lane = tid & 63, wr = wid >> 2, wc = wid & 3, fr = lane & 15, fq = lane >> 4;
    const int K = g.K, nt = g.Kt / BK; const size_t kslice = (size_t)g.Kt * 2;
    unsigned voffA[2], voffB[2];
#pragma unroll
    for (int i = 0; i < 2; ++i) { int R, C; stage_rc(tid * 16 + i * 8192, R, C); const int Rb = Epi::PERM ? ((R & ~31) + perm32(R & 31)) : R;
        voffA[i] = (unsigned)(R * K + C) * 2u; voffB[i] = (unsigned)(Rb * K + C) * 2u; }
    const size_t kstep = (size_t)(BK * 2);
    const size_t hstep = (size_t)HALF * K * 2;
    const size_t tstep = 2 * hstep;
    const unsigned ldsw = (unsigned)wid * 1024u;
    const int aoff = lds_byte(wr * 64 + fr, fq * 8), boff = lds_byte(wc * 32 + fr, fq * 8);
#define PG8_SA(b, h) (((b) * 2 + (h)) * HTB)
#define PG8_SB(b, h) ((4 + (b) * 2 + (h)) * HTB)
#define PG8_STAGE(bufoff, gbase, voff) do { _Pragma("unroll") for (int _i = 0; _i < 2; ++_i) \
        __builtin_amdgcn_global_load_lds((const unsigned*)((const char*)(gbase) + (voff)[_i]), (PG8_LAS unsigned*)(lds + (bufoff) + ldsw + _i * 8192), 16, 0, 0); } while (0)
#define PG8_LDA(dst, b, h) do { _Pragma("unroll") for (int m = 0; m < 4; ++m) _Pragma("unroll") for (int k = 0; k < 2; ++k) dst[m][k] = *(const PG8_LAS bf16x8*)(lds + PG8_SA(b, h) + aoff + m * 2048 + k * 1024); } while (0)
#define PG8_LDB(dst, b, h) do { _Pragma("unroll") for (int n = 0; n < 2; ++n) _Pragma("unroll") for (int k = 0; k < 2; ++k) dst[n][k] = *(const PG8_LAS bf16x8*)(lds + PG8_SB(b, h) + boff + n * 2048 + k * 1024); } while (0)
#define PG8_MMA(ai, bj, At, Bt) do { __builtin_amdgcn_s_setprio(1); _Pragma("unroll") for (int m = 0; m < 4; ++m) _Pragma("unroll") for (int n = 0; n < 2; ++n) _Pragma("unroll") for (int k = 0; k < 2; ++k) \
        acc[ai][bj][m][n] = __builtin_amdgcn_mfma_f32_16x16x32_bf16(Bt[n][k], At[m][k], acc[ai][bj][m][n], 0, 0, 0); __builtin_amdgcn_s_setprio(0); } while (0)
#define PG8_WAIT_V(n) asm volatile("s_waitcnt vmcnt(" #n ")" ::: "memory")
#define PG8_WAIT_L(n) asm volatile("s_waitcnt lgkmcnt(" #n ")" ::: "memory")
#define PG8_BAR __builtin_amdgcn_s_barrier()
#define PG8_SCHED __builtin_amdgcn_sched_barrier(0)
    Unit cur, nxt; int ui = 0;
    if (!S.next(0, cur)) return;
    f32x4 acc[2][2][4][2];
#pragma unroll
    for (int a = 0; a < 2; ++a)
#pragma unroll
        for (int b = 0; b < 2; ++b)
#pragma unroll
            for (int m = 0; m < 4; ++m)
#pragma unroll
                for (int n = 0; n < 2; ++n) acc[a][b][m][n] = (f32x4){0.f, 0.f, 0.f, 0.f};
    bf16x8 At[4][2], B0[2][2], B1[2][2];
    const char* cA = (const char*)g.A + (size_t)cur.pm * tstep + (size_t)cur.pk * kslice; const char* cB = (const char*)g.Bt + (size_t)cur.pn * tstep + (size_t)cur.pk * kslice;
    S.a_ready(cur);
    if constexpr (SP2) {
        PG8_STAGE(PG8_SB(0, 0), cB, voffB); PG8_STAGE(PG8_SB(0, 1), cB + hstep, voffB); PG8_STAGE(PG8_SA(0, 0), cA, voffA); PG8_STAGE(PG8_SA(0, 1), cA + hstep, voffA);
        if (wr == 1) PG8_BAR;
        PG8_WAIT_V(2); PG8_BAR;
        PG8_STAGE(PG8_SB(1, 0), cB + kstep, voffB); PG8_STAGE(PG8_SA(1, 0), cA + kstep, voffA); PG8_STAGE(PG8_SB(1, 1), cB + hstep + kstep, voffB);
        PG8_WAIT_V(6); PG8_BAR;
    } else {
        PG8_STAGE(PG8_SB(0, 0), cB, voffB); PG8_STAGE(PG8_SA(0, 0), cA, voffA); PG8_STAGE(PG8_SB(0, 1), cB + hstep, voffB); PG8_STAGE(PG8_SA(0, 1), cA + hstep, voffA);
        if (wr == 1) PG8_BAR;
        PG8_WAIT_V(4); PG8_BAR;
        PG8_STAGE(PG8_SB(1, 0), cB + kstep, voffB); PG8_STAGE(PG8_SA(1, 0), cA + kstep, voffA); PG8_STAGE(PG8_SB(1, 1), cB + hstep + kstep, voffB);
        PG8_WAIT_V(6); PG8_BAR;
    }
    for (;;) {
        const bool has_next = S.next(ui + 1, nxt);
        const char* nA = has_next ? (const char*)g.A + (size_t)nxt.pm * tstep + (size_t)nxt.pk * kslice : cA; const char* nB = has_next ? (const char*)g.Bt + (size_t)nxt.pn * tstep + (size_t)nxt.pk * kslice : cB;
        for (int t = 0; t < nt; t += 2) {
            const bool last = (t == nt - 2);
            const char* a1 = cA + (size_t)(t + 1) * kstep;
            const char* a2 = last ? nA : cA + (size_t)(t + 2) * kstep; const char* b2 = last ? nB : cB + (size_t)(t + 2) * kstep;
            const char* a3 = a2 + kstep; const char* b3 = b2 + kstep;
            if (last && has_next) S.a_ready(nxt);
            if constexpr (SP2) {
            PG8_LDB(B0, 0, 0); PG8_LDB(B1, 0, 1); PG8_SCHED; PG8_LDA(At, 0, 0); PG8_STAGE(PG8_SA(1, 1), a1 + hstep, voffA);
            PG8_WAIT_V(8); PG8_WAIT_L(0); PG8_BAR; PG8_MMA(0, 0, At, B0); PG8_MMA(0, 1, At, B1); PG8_BAR; PG8_SCHED;
            PG8_LDA(At, 0, 1); PG8_STAGE(PG8_SB(0, 0), b2, voffB); PG8_STAGE(PG8_SB(0, 1), b2 + hstep, voffB); PG8_STAGE(PG8_SA(0, 0), a2, voffA);
            PG8_WAIT_V(8); PG8_WAIT_L(0); PG8_BAR; PG8_MMA(1, 0, At, B0); PG8_MMA(1, 1, At, B1); PG8_BAR; PG8_SCHED;
            PG8_LDB(B0, 1, 0); PG8_LDB(B1, 1, 1); PG8_SCHED; PG8_LDA(At, 1, 0); PG8_STAGE(PG8_SA(0, 1), a2 + hstep, voffA);
            PG8_WAIT_V(8); PG8_WAIT_L(0); PG8_BAR; PG8_MMA(0, 0, At, B0); PG8_MMA(0, 1, At, B1); PG8_BAR; PG8_SCHED;
            PG8_LDA(At, 1, 1); PG8_STAGE(PG8_SB(1, 0), b3, voffB); PG8_STAGE(PG8_SB(1, 1), b3 + hstep, voffB); PG8_STAGE(PG8_SA(1, 0), a3, voffA);
            PG8_WAIT_V(8); PG8_WAIT_L(0); PG8_BAR; PG8_MMA(1, 0, At, B0); PG8_MMA(1, 1, At, B1); PG8_BAR; PG8_SCHED;
            } else {
            PG8_LDB(B0, 0, 0); PG8_SCHED; PG8_LDA(At, 0, 0); PG8_STAGE(PG8_SA(1, 1), a1 + hstep, voffA);
            PG8_WAIT_L(8); PG8_BAR; PG8_WAIT_L(0); PG8_MMA(0, 0, At, B0); PG8_BAR; PG8_SCHED;
            PG8_LDB(B1, 0, 1); PG8_STAGE(PG8_SB(0, 0), b2, voffB);
            PG8_BAR; PG8_WAIT_L(0); PG8_MMA(0, 1, At, B1); PG8_BAR;
            PG8_LDA(At, 0, 1); PG8_STAGE(PG8_SA(0, 0), a2, voffA);
            PG8_BAR; PG8_WAIT_L(0); PG8_MMA(1, 0, At, B0); PG8_BAR; PG8_SCHED;
            PG8_STAGE(PG8_SB(0, 1), b2 + hstep, voffB);
            PG8_WAIT_V(6); PG8_BAR; PG8_MMA(1, 1, At, B1); PG8_BAR;
            PG8_LDB(B0, 1, 0); PG8_SCHED; PG8_LDA(At, 1, 0); PG8_STAGE(PG8_SA(0, 1), a2 + hstep, voffA);
            PG8_WAIT_L(8); PG8_BAR; PG8_WAIT_L(0); PG8_MMA(0, 0, At, B0); PG8_BAR; PG8_SCHED;
            PG8_LDB(B1, 1, 1); PG8_STAGE(PG8_SB(1, 0), b3, voffB);
            PG8_BAR; PG8_WAIT_L(0); PG8_MMA(0, 1, At, B1); PG8_BAR;
            PG8_LDA(At, 1, 1); PG8_STAGE(PG8_SA(1, 0), a3, voffA);
            PG8_BAR; PG8_WAIT_L(0); PG8_MMA(1, 0, At, B0); PG8_BAR; PG8_SCHED;
            PG8_STAGE(PG8_SB(1, 1), b3 + hstep, voffB);
            PG8_WAIT_V(6); PG8_BAR; PG8_MMA(1, 1, At, B1); PG8_BAR;
            }
        }
        if constexpr (ALIGN_EPI) { if (wr == 0) PG8_BAR; }
        if constexpr (!Epi::AFTER_DRAIN) { E(acc, cur, wr, wc, fr, fq); S.done(cur); }
        if (!has_next) break;
#pragma unroll
        for (int a = 0; a < 2; ++a)
#pragma unroll
            for (int b = 0; b < 2; ++b)
#pragma unroll
                for (int m = 0; m < 4; ++m)
#pragma unroll
                    for (int n = 0; n < 2; ++n) acc[a][b][m][n] = (f32x4){0.f, 0.f, 0.f, 0.f};
        cur = nxt; cA = nA; cB = nB; ++ui;
        if constexpr (ALIGN_EPI) { if (wr == 1) PG8_BAR; }
    }
    PG8_WAIT_V(0);
    if constexpr (!ALIGN_EPI) { if (wr == 0) PG8_BAR; }
    PG8_BAR;
    if constexpr (Epi::AFTER_DRAIN) { E.fused(acc, cur, wr, wc, fr, fq, lds, wid, lane); S.done(cur); }
#undef PG8_SA
#undef PG8_SB
#undef PG8_STAGE
#undef PG8_LDA
#undef PG8_LDB
#undef PG8_MMA
#undef PG8_WAIT_V
#undef PG8_WAIT_L
#undef PG8_BAR
#undef PG8_SCHED
}
}
constexpr int NWAVES = 8, NTHREADS = 512;
constexpr int SEQ = 16384, NB = 2, T = NB * SEQ, D = 1024;
constexpr int E_IN = 1792, LRU_W = 512, FF0 = 2816;
constexpr int O_IN = 4112, GH = 8, GD = 128, GC = 64, NCH = SEQ / GC  , NUNIT = NB * GH * NCH  ;
constexpr int NE = 8, FFE = 3584;
constexpr int MAXTILES = 264, PASS_TILES = 64;
constexpr float EPS = 1e-6f;

constexpr size_t MiB = 1u << 20;
constexpr size_t WS_CTL = 0, CTL_ZERO_BYTES = 1 * MiB;
constexpr size_t WS_ROPE = 1 * MiB;
constexpr size_t WS_STA = 5 * MiB, WS_STB = 7 * MiB;
constexpr size_t WS_MISC = 9 * MiB;
constexpr size_t MS_LRU_A = WS_MISC, MS_LRU_H = WS_MISC + 512 * 1024;
constexpr size_t MS_TOKE = WS_MISC + 1 * MiB;
constexpr size_t MS_TOKW = MS_TOKE + 128 * 1024;
constexpr size_t MS_RANK = MS_TOKW + 256 * 1024;
constexpr size_t MS_DEST = MS_RANK + 256 * 1024;
constexpr size_t MS_CNT = MS_DEST + 256 * 1024;
constexpr size_t MS_TILEE = MS_CNT + 8 * 1024;
constexpr size_t MS_RG = MS_TILEE + 2 * 1024;
constexpr size_t MS_GLAST = WS_MISC + 3 * MiB;
constexpr size_t MS_WSK = MS_GLAST + 16 * 1024;
constexpr size_t MS_ROUT = MS_WSK + 32 * 1024;
constexpr size_t MS_RC = MS_ROUT + 32 * 1024;
constexpr size_t MS_AB = MS_RC + 128 * 1024;
constexpr size_t WS_W0 = 13 * MiB;
constexpr size_t W0_IN = WS_W0, W0_OUT = W0_IN + (size_t)E_IN * D * 2, W0_GU = W0_OUT + (size_t)D * D * 2, W0_DN = W0_GU + (size_t)2 * FF0 * D * 2;
constexpr size_t WS_HALO = 13 * MiB;
constexpr size_t W1_OUT = 35 * MiB;
constexpr size_t WS_AB = 37 * MiB;
constexpr size_t WS_HB = 40 * MiB;
constexpr size_t WS_PROJ0 = 104 * MiB;
constexpr size_t WS_LRUH = 216 * MiB, WS_LRUP = 280 * MiB;
constexpr size_t WS_YMIX = 344 * MiB;
constexpr size_t W1_IN = 408 * MiB;
constexpr size_t WS_ACT0 = 104 * MiB;
constexpr size_t WS_QKV = 104 * MiB;
constexpr size_t WS_GATE = 296 * MiB;
constexpr size_t WS_UT = 360 * MiB;
constexpr size_t WS_AQK = 424 * MiB;
constexpr size_t WS_WMD = 456 * MiB;
constexpr size_t WS_ON = 104 * MiB;
constexpr size_t WS_XG = 168 * MiB;
constexpr size_t WS_ACT = 300 * MiB;
constexpr size_t WS_PART = 426 * MiB;
constexpr size_t WS_END = 512 * MiB;
static_assert(W0_DN + (size_t)D * FF0 * 2 <= W1_OUT && MS_AB <= WS_W0 && WS_HALO + (size_t)NB * NCH * 3 * 3072 * 2 <= W1_OUT, "ws map");
static_assert(WS_XG + (size_t)MAXTILES * 256 * 1024 * 2 <= WS_ACT && WS_ACT + (size_t)(PASS_TILES + 8) * 256 * FFE * 2 <= WS_PART && WS_PART + (size_t)7 * 2048 * 1024 * 2 <= WS_WMD && WS_WMD + (size_t)NE * D * FFE * 2 <= WS_END, "ws map (MoE)");
constexpr int CW_TMO = 0, CW_BAR = 4096, CW_SCANQ = 8192, CW_SCANP = 12288;

constexpr int RING_BYTES = 131072;
constexpr int LDSCTL_OFF = 161024, MISC_OFF = LDSCTL_OFF + 320;
constexpr int LDS_BYTES = 162048;

#define GAS __attribute__((address_space(1)))
#define LAS __attribute__((address_space(3)))
#define DI __device__ __forceinline__
typedef unsigned short bf16;
typedef unsigned v4u __attribute__((ext_vector_type(4)));
typedef unsigned v2u __attribute__((ext_vector_type(2)));
typedef float f32x4 __attribute__((ext_vector_type(4)));
typedef float f32x2 __attribute__((ext_vector_type(2)));
typedef short bf16x8 __attribute__((ext_vector_type(8)));
typedef short bf16x4 __attribute__((ext_vector_type(4)));
typedef GAS unsigned gu32;
#define LDS_WAIT() asm volatile("s_waitcnt lgkmcnt(0)" ::: "memory")
#define VM_WAIT() asm volatile("s_waitcnt vmcnt(0)" ::: "memory")
#define MFMA16(a, b, c) __builtin_amdgcn_mfma_f32_16x16x32_bf16((a), (b), (c), 0, 0, 0)
typedef __bf16 bf16v2_t __attribute__((ext_vector_type(2)));
DI unsigned pk2(float lo, float hi) { const f32x2 v = {lo, hi}; return __builtin_bit_cast(unsigned, __builtin_convertvector(v, bf16v2_t)); }
DI unsigned f2bf(float f) { return pk2(f, 0.f) & 0xffffu; }
DI float bflo(unsigned w) { return __builtin_bit_cast(float, w << 16); }
DI float bfhi(unsigned w) { return __builtin_bit_cast(float, w & 0xffff0000u); }
DI float bf2f(bf16 v) { return __builtin_bit_cast(float, (unsigned)v << 16); }
DI float sigmoid_f(float x) { return __builtin_amdgcn_rcpf(1.0f + __expf(-x)); }
DI float silu_f(float x) { return x * sigmoid_f(x); }
DI float wave_sum(float v) {
#pragma unroll
    for (int o = 1; o < 64; o <<= 1) v += __shfl_xor(v, o);
    return v;
}
DI size_t qkv_off(int unit, int part, int row, int ch) { return ((size_t)(unit * 3 + part) * 64 + row) * 128 + ch; }
DI bf16x8 mk8(v2u lo, v2u hi) { v4u w; w.x = lo.x; w.y = lo.y; w.z = hi.x; w.w = hi.y; return __builtin_bit_cast(bf16x8, w); }
DI bf16x8 pack_acc2(const f32x4 a, const f32x4 b) { v4u w; w.x = pk2(a[0], a[1]); w.y = pk2(a[2], a[3]); w.z = pk2(b[0], b[1]); w.w = pk2(b[2], b[3]); return __builtin_bit_cast(bf16x8, w); }
#define XB_TMO      128
#define XB_XCNT(j)  (256  + 64 * (j))
#define XB_XSUB(j)  (1280 + 64 * (j))
#define XB_XGEN(j)  (2304 + 64 * (j))
#define XB_TOP      3328
#define XB_TOPGEN   3392
#define XCD_BAR_WORDS 3456
#define XB_SPIN_CAP (1u << 18)

__device__ __forceinline__ unsigned xb_ld(unsigned* p)              { return __hip_atomic_load(p, __ATOMIC_RELAXED, __HIP_MEMORY_SCOPE_AGENT); }
__device__ __forceinline__ unsigned xb_add(unsigned* p, unsigned v) { return __hip_atomic_fetch_add(p, v, __ATOMIC_RELAXED, __HIP_MEMORY_SCOPE_AGENT); }
__device__ __forceinline__ unsigned xb_xcc_id() { return (unsigned)__builtin_amdgcn_s_getreg((3 << 11) | 20) & 0xFu; }
#define XB_SPIN(cond, bar) do { unsigned _sp = 0; while (cond) { __builtin_amdgcn_s_sleep(1); \
    if ((++_sp & 255u) == 0u) { if (xb_ld(&(bar)[XB_TMO])) break; if (_sp > XB_SPIN_CAP) { atomicAdd(&(bar)[XB_TMO], 1u); break; } } } } while (0)

struct XcdBarrier {
    unsigned* bar; unsigned x;
    volatile LAS unsigned* st;
};

__device__ __forceinline__ XcdBarrier xcd_barrier_post(unsigned* bar, volatile LAS unsigned* st) {
    XcdBarrier b; b.bar = bar; b.x = xb_xcc_id(); b.st = st;
    if (threadIdx.x == 0) (void)xb_add(&bar[XB_XCNT(b.x)], 1u);
    return b;
}
__device__ __forceinline__ void xcd_barrier_complete(unsigned* bar, unsigned x, unsigned& nloc, unsigned& nx) {
    const unsigned G = gridDim.x * gridDim.y * gridDim.z;
    unsigned sum, cnt, mine, sp = 0u;
    for (;;) {
        sum = 0u; cnt = 0u; mine = 0u;
#pragma unroll
        for (unsigned j = 0; j < 16; ++j) { const unsigned c = xb_ld(&bar[XB_XCNT(j)]); sum += c; cnt += (c > 0u) ? 1u : 0u; mine = (j == x) ? c : mine; }
        if (sum == G) break;
        __builtin_amdgcn_s_sleep(1);
        if ((++sp & 255u) == 0u) { if (xb_ld(&bar[XB_TMO])) break; if (sp > XB_SPIN_CAP) { atomicAdd(&bar[XB_TMO], 1u); break; } }
    }
    nloc = mine > 0u ? mine : 1u; nx = cnt > 0u ? cnt : 1u;
}

__device__ __forceinline__ void xcd_barrier(const XcdBarrier& b) {
    asm volatile("s_waitcnt vmcnt(0)" ::: "memory");
    __syncthreads();
    if (threadIdx.x == 0) {
        unsigned* bar = b.bar;
        __builtin_amdgcn_s_waitcnt(0);
        unsigned nloc = b.st[0], nx = b.st[1];
        if (nloc == 0u) { xcd_barrier_complete(bar, b.x, nloc, nx); b.st[0] = nloc; b.st[1] = nx; }
        const unsigned old = xb_add(&bar[XB_XSUB(b.x)], 1u);
        const unsigned gen = old / nloc;
        if (old + 1u == (gen + 1u) * nloc) {
            __builtin_amdgcn_fence(__ATOMIC_RELEASE, "agent");
            asm volatile("s_waitcnt vmcnt(0)" ::: "memory");
            const unsigned og = xb_add(&bar[XB_TOP], 1u);
            const unsigned tg = og / nx;
            if (og + 1u == (tg + 1u) * nx) xb_add(&bar[XB_TOPGEN], 1u);
            else XB_SPIN(xb_ld(&bar[XB_TOPGEN]) == tg, bar);
            __builtin_amdgcn_fence(__ATOMIC_ACQUIRE, "agent");
            xb_add(&bar[XB_XGEN(b.x)], 1u);
            asm volatile("s_waitcnt vmcnt(0)" ::: "memory");
        } else {
            XB_SPIN(xb_ld(&bar[XB_XGEN(b.x)]) == gen, bar);
            __builtin_amdgcn_fence(__ATOMIC_ACQUIRE, "agent");
            asm volatile("s_waitcnt vmcnt(0)" ::: "memory");
        }
    }
    __syncthreads();
}
struct CvtJob { const float* src; const float* gain; bf16* dst; int ldw, K; };
DI CvtJob cvt_job(const float* W, int ldw, int K, const float* gain, bf16* WT, int drow0, int k0, int n0, int lane) {
    const int kg = lane >> 3, c = lane & 7; CvtJob j; j.src = W + (size_t)(k0 + 8 * kg) * ldw + n0 + 4 * c; j.gain = gain ? gain + k0 + 8 * kg : nullptr; j.dst = WT + (size_t)(drow0 + 4 * c) * K + k0 + 8 * kg; j.ldw = ldw; j.K = K; return j;
}
struct CvtRegs { f32x4 v[8]; };
DI void cvt_ld(const CvtJob& j, CvtRegs& r) {
#pragma unroll
    for (int i = 0; i < 8; ++i) r.v[i] = *(const f32x4*)(j.src + (size_t)i * j.ldw);
}
DI void cvt_st(const CvtJob& j, CvtRegs& r) {
    if (j.gain) { const f32x4 g0 = *(const f32x4*)j.gain, g1 = *(const f32x4*)(j.gain + 4);
#pragma unroll
        for (int i = 0; i < 4; ++i) { r.v[i] = r.v[i] * g0[i]; r.v[4 + i] = r.v[4 + i] * g1[i]; } }
#pragma unroll
    for (int q = 0; q < 4; ++q) { v4u o; o.x = pk2(r.v[0][q], r.v[1][q]); o.y = pk2(r.v[2][q], r.v[3][q]); o.z = pk2(r.v[4][q], r.v[5][q]); o.w = pk2(r.v[6][q], r.v[7][q]); *(v4u*)(j.dst + (size_t)q * j.K) = o; }
}
DI void cvt_item(const float* W, int ldw, int K, const float* gain, bf16* WT, int drow0, int k0, int n0, LAS float* scr, int lane) {
    (void)scr; const CvtJob j = cvt_job(W, ldw, K, gain, WT, drow0, k0, n0, lane); CvtRegs r; cvt_ld(j, r); cvt_st(j, r);
}
DI void cvt_plain(const float* W, int ldw, int K, int N, const float* gain, bf16* WT, int it, LAS float* scr, int lane) {
    const int nblk = N / 32, kb = it / nblk, nb = it % nblk; cvt_item(W, ldw, K, gain, WT, 32 * nb, 64 * kb, 32 * nb, scr, lane);
}
DI void cvt_gu(const float* W, int K, int N, const float* gain, bf16* WT, int up, int it, LAS float* scr, int lane) {
    const int nblk = N / 32, kb = it / nblk, nb = it % nblk, n0 = 32 * nb; cvt_item(W, N, K, gain, WT, (n0 >> 7) * 256 + up * 128 + (n0 & 127), 64 * kb, n0, scr, lane);
}
struct Args { const float* in[28]; float* out; unsigned char* ws; int ph_lo, ph_hi; };
enum { I_X = 0, I_LNMIX, I_LNFFN, I_EWIN, I_CONVW, I_CONVB, I_WA, I_BA, I_WI, I_BI, I_LAM, I_QN, I_KN, I_SINK, I_EWOUT, I_FG, I_FU, I_FD,
       I_OWIN, I_OCONV, I_ALOG, I_DTB, I_ONORM, I_OWOUT, I_ROUT, I_MG, I_MU, I_MD };

DI void phase_prologue(const Args& a, LAS unsigned char* lds, int gw, int NGW, int wave, int lane) {
    unsigned char* ws = a.ws;
    LAS float* scr = (LAS float*)(lds + wave * 16384);
    constexpr int I1 = 16 * 56;
    for (int it = gw; it < I1; it += NGW) cvt_plain(a.in[I_EWIN], E_IN, D, E_IN, a.in[I_LNMIX], (bf16*)(ws + W0_IN), it, scr, lane);
    const int gt = gw * 64 + lane, NGT = NGW * 64;
    for (int i = gt; i < 16 * D; i += NGT) { const int c = i >> 10, k = i & 1023; ((bf16*)(ws + MS_WSK))[i] = (bf16)f2bf(a.in[I_OWIN][(size_t)k * O_IN + 4096 + c] * a.in[I_LNMIX][D + k]); }
    for (int i = gt; i < 8 * D; i += NGT) { const int k = i >> 3; ((float*)(ws + MS_ROUT))[i] = a.in[I_ROUT][i] * a.in[I_LNFFN][D + k]; }
    for (int i = gt; i < SEQ * 32; i += NGT) { const int pos = i >> 5, f = i & 31;
        const float inv = powf(10000.0f, -(float)f * (1.0f / 32.0f)); const float ang = (float)pos * inv;
        const double tt = (double)ang * 0.15915494309189535; const float fr = (float)(tt - rint(tt));
        f32x2 cs; cs.x = __builtin_amdgcn_cosf(fr); cs.y = __builtin_amdgcn_sinf(fr); ((f32x2*)(ws + WS_ROPE))[i] = cs; }
    for (int m0 = gw; m0 < T; m0 += 4 * NGW) { f32x4 v[4][4];
#pragma unroll
        for (int r = 0; r < 4; ++r) { const int m = m0 + r * NGW < T ? m0 + r * NGW : m0; const f32x4* xr = (const f32x4*)(a.in[I_X] + (size_t)m * D) + lane;
#pragma unroll
            for (int j = 0; j < 4; ++j) v[r][j] = xr[64 * j]; }
#pragma unroll
        for (int r = 0; r < 4; ++r) { const int m = m0 + r * NGW; if (m >= T) break; float s = 0.f;
#pragma unroll
            for (int j = 0; j < 4; ++j) s += (v[r][j].x * v[r][j].x + v[r][j].y * v[r][j].y) + (v[r][j].z * v[r][j].z + v[r][j].w * v[r][j].w);
            s = wave_sum(s);
            v2u* o8 = (v2u*)((bf16*)(ws + WS_HB) + (size_t)m * D) + lane;
#pragma unroll
            for (int j = 0; j < 4; ++j) { v2u w; w.x = pk2(v[r][j].x, v[r][j].y); w.y = pk2(v[r][j].z, v[r][j].w); o8[64 * j] = w; }
            if (lane < 16) ((float*)(ws + WS_STA))[(size_t)m * 16 + lane] = lane == 0 ? s : 0.f; }
    }
}
DI void weights_late(const Args& a, int first, int stride, int lane) {
    unsigned char* ws = a.ws; LAS float* scr = nullptr;
    constexpr int I2 = 16 * 32, I3 = 16 * 88, I5 = 44 * 32, I6 = 16 * 128, I7 = 16 * 32, NIT = I2 + 2 * I3 + I5 + I6 + I7;
    for (int it = first; it < NIT; it += stride) {
        int r = it;
        if (r < I2) { cvt_plain(a.in[I_EWOUT], D, D, D, nullptr, (bf16*)(ws + W0_OUT), r, scr, lane); continue; } r -= I2;
        if (r < I3) { cvt_gu(a.in[I_FG], D, FF0, a.in[I_LNFFN], (bf16*)(ws + W0_GU), 0, r, scr, lane); continue; } r -= I3;
        if (r < I3) { cvt_gu(a.in[I_FU], D, FF0, a.in[I_LNFFN], (bf16*)(ws + W0_GU), 1, r, scr, lane); continue; } r -= I3;
        if (r < I5) { cvt_plain(a.in[I_FD], D, FF0, D, nullptr, (bf16*)(ws + W0_DN), r, scr, lane); continue; } r -= I5;
        if (r < I6) { cvt_plain(a.in[I_OWIN], O_IN, D, 4096, a.in[I_LNMIX] + D, (bf16*)(ws + W1_IN), r, scr, lane); continue; } r -= I6;
        cvt_plain(a.in[I_OWOUT], D, D, D, nullptr, (bf16*)(ws + W1_OUT), r, scr, lane);
    }
}
constexpr int MOE_D_ITEMS = NE * 56 * 32, MOE_GU_ITEMS = NE * 2 * 16 * 112;
DI CvtJob moe_job(const Args& a, int it, int lane) {
    if (it < MOE_D_ITEMS) { const int e = it / (56 * 32), r = it % (56 * 32), kb = r / 32, nb = r % 32;
        return cvt_job(a.in[I_MD] + (size_t)e * FFE * D, D, FFE, nullptr, (bf16*)(a.ws + WS_WMD) + (size_t)e * D * FFE, 32 * nb, 64 * kb, 32 * nb, lane); }
    const int i2 = it - MOE_D_ITEMS, e = i2 / (2 * 16 * 112), r0 = i2 % (2 * 16 * 112), up = r0 / (16 * 112), r = r0 % (16 * 112), kb = r / 112, nb = r % 112, n0 = 32 * nb;
    return cvt_job((up ? a.in[I_MU] : a.in[I_MG]) + (size_t)e * D * FFE, FFE, D, a.in[I_LNFFN] + D, (bf16*)a.out + (size_t)e * 2 * FFE * D, (n0 >> 7) * 256 + up * 128 + (n0 & 127), 64 * kb, n0, lane);
}
DI void moe_convert(const Args& a, int first, int stride, int lane) {
    constexpr int N = MOE_D_ITEMS + MOE_GU_ITEMS;
    for (int it = first; it < N; it += 4 * stride) {
        CvtJob j0 = moe_job(a, it, lane); CvtRegs r0, r1, r2, r3; cvt_ld(j0, r0);
        const bool h1 = it + stride < N, h2 = it + 2 * stride < N, h3 = it + 3 * stride < N;
        CvtJob j1 = moe_job(a, h1 ? it + stride : it, lane), j2 = moe_job(a, h2 ? it + 2 * stride : it, lane), j3 = moe_job(a, h3 ? it + 3 * stride : it, lane);
        cvt_ld(j1, r1); cvt_ld(j2, r2); cvt_ld(j3, r3);
        cvt_st(j0, r0); if (h1) cvt_st(j1, r1); if (h2) cvt_st(j2, r2); if (h3) cvt_st(j3, r3);
    }
}

struct LruFrags { bf16x8 wa[4][2], wi[4][2]; };
DI void lru_frags(const Args& a, LAS unsigned char* lds, LruFrags& F, int wave, int lane) {
    const int g = lane >> 4, c16 = lane & 15;
    LAS float* scr = (LAS float*)(lds + wave * 16384);
#pragma unroll
    for (int gate = 0; gate < 2; ++gate) {
        const f32x4* W = (const f32x4*)((gate ? a.in[I_WI] : a.in[I_WA]) + wave * 4096);
#pragma unroll
        for (int q = 0; q < 16; ++q) ((LAS f32x4*)scr)[q * 64 + lane] = W[q * 64 + lane];
        LDS_WAIT();
        const LAS float* sp = scr + (8 * g) * 64 + c16;
#pragma unroll
        for (int jt = 0; jt < 4; ++jt)
#pragma unroll
            for (int ks = 0; ks < 2; ++ks) { float t[8];
#pragma unroll
                for (int e = 0; e < 8; ++e) t[e] = sp[(32 * ks + e) * 64 + 16 * jt];
                v4u p; p.x = pk2(t[0], t[1]); p.y = pk2(t[2], t[3]); p.z = pk2(t[4], t[5]); p.w = pk2(t[6], t[7]);
                if (gate) F.wi[jt][ks] = __builtin_bit_cast(bf16x8, p); else F.wa[jt][ks] = __builtin_bit_cast(bf16x8, p); }
        LDS_WAIT();
    }
}
DI void lru_unit(const Args& a, LAS unsigned char* lds, const LruFrags& F, int unit, int wave, int lane) {
    unsigned char* ws = a.ws;
    const int b = unit >> 7, chk = unit & 127, t0 = chk * 128, g = lane >> 4, c16 = lane & 15;
    const size_t rowb = (size_t)b * SEQ;
    const bf16* proj0 = (const bf16*)(ws + WS_PROJ0);
    unsigned* hp = (unsigned*)(ws + WS_LRUH);
    const int c = wave * 64 + lane;
    const float w0 = a.in[I_CONVW][c], w1 = a.in[I_CONVW][512 + c], w2 = a.in[I_CONVW][1024 + c], w3 = a.in[I_CONVW][1536 + c], cb = a.in[I_CONVB][c];
    const float ba = a.in[I_BA][c], bi = a.in[I_BI][c], lam = a.in[I_LAM][c];
    const float sp8 = 8.0f * (lam < -20.f ? -lam : log1pf(expf(-lam)));
    LAS bf16* XC = (LAS bf16*)(lds + wave * 11264);
    LAS float* GA = (LAS float*)(lds + wave * 11264 + 2304);
    LAS float* GI = GA + 16 * 68;
    float x1 = 0.f, x2 = 0.f, x3 = 0.f;
    if (t0 > 0) { x1 = bf2f(proj0[(rowb + t0 - 1) * E_IN + c]); x2 = bf2f(proj0[(rowb + t0 - 2) * E_IN + c]); x3 = bf2f(proj0[(rowb + t0 - 3) * E_IN + c]); }
    float h = 0.f, P = 1.f;
    bf16 xr[16];
#pragma unroll
    for (int tt = 0; tt < 16; ++tt) xr[tt] = proj0[(rowb + t0 + tt) * E_IN + c];
#pragma unroll 1
    for (int st = 0; st < 8; ++st) {
        float xc[16]; bf16 xcur[16];
#pragma unroll
        for (int tt = 0; tt < 16; ++tt) xcur[tt] = xr[tt];
        if (st < 7) {
#pragma unroll
            for (int tt = 0; tt < 16; ++tt) xr[tt] = proj0[(rowb + t0 + 16 * (st + 1) + tt) * E_IN + c]; }
#pragma unroll
        for (int tt = 0; tt < 16; ++tt) { const float xn = bf2f(xcur[tt]);
            xc[tt] = w0 * x3 + w1 * x2 + w2 * x1 + w3 * xn + cb; x3 = x2; x2 = x1; x1 = xn; XC[tt * 72 + lane] = (bf16)f2bf(xc[tt]); }
        LDS_WAIT();
        bf16x8 bx[2];
#pragma unroll
        for (int ks = 0; ks < 2; ++ks) bx[ks] = *(const LAS bf16x8*)(XC + c16 * 72 + 32 * ks + 8 * g);
#pragma unroll
        for (int jt = 0; jt < 4; ++jt) { f32x4 ca = {0.f, 0.f, 0.f, 0.f}, ci = {0.f, 0.f, 0.f, 0.f};
#pragma unroll
            for (int ks = 0; ks < 2; ++ks) { ca = MFMA16(F.wa[jt][ks], bx[ks], ca); ci = MFMA16(F.wi[jt][ks], bx[ks], ci); }
            *(LAS f32x4*)(GA + c16 * 68 + 16 * jt + 4 * g) = ca; *(LAS f32x4*)(GI + c16 * 68 + 16 * jt + 4 * g) = ci; }
        LDS_WAIT();
#pragma unroll
        for (int tt = 0; tt < 16; ++tt) {
            const float r = sigmoid_f(GA[tt * 68 + lane] + ba), gi = sigmoid_f(GI[tt * 68 + lane] + bi);
            const float la = -sp8 * r, av = __expf(la), mult = sqrtf(fmaxf(1.0f - av * av, 0.f));
            h = av * h + mult * gi * xc[tt]; P *= av;
            const size_t o = (rowb + t0 + 16 * st + tt) * LRU_W + c; hp[o] = pk2(h, P); }
        LDS_WAIT();
    }
    ((float*)(ws + MS_LRU_A))[(size_t)unit * 512 + c] = P; ((float*)(ws + MS_LRU_H))[(size_t)unit * 512 + c] = h;
}

DI void attn_unit(const Args& a, LAS unsigned char* lds, int unit, int tid, int wave, int lane) {
    unsigned char* ws = a.ws;
    const int kvh = unit & 1, blk = (unit >> 1) & 127, b = unit >> 8, t0 = blk * 128, g = lane >> 4, c = lane & 15;
    const size_t rowb = (size_t)b * SEQ;
    const bf16* proj0 = (const bf16*)(ws + WS_PROJ0); const f32x2* rope = (const f32x2*)(ws + WS_ROPE);
    LAS bf16* Ks = (LAS bf16*)lds;
    LAS bf16* Vt = (LAS bf16*)(lds + 36864);
    {
        const int key = tid >> 1, p = tid & 1, pos = t0 - 128 + key;
        if (pos >= 0) {
            const bf16* src = proj0 + (rowb + pos) * E_IN + 1536 + kvh * 64;
            const v4u q0 = *(const v4u*)(src + 16 * p), q1 = *(const v4u*)(src + 16 * p + 8), q2 = *(const v4u*)(src + 32 + 16 * p), q3 = *(const v4u*)(src + 32 + 16 * p + 8);
            float xa[16], xb[16];
            xa[0] = bflo(q0.x); xa[1] = bfhi(q0.x); xa[2] = bflo(q0.y); xa[3] = bfhi(q0.y); xa[4] = bflo(q0.z); xa[5] = bfhi(q0.z); xa[6] = bflo(q0.w); xa[7] = bfhi(q0.w);
            xa[8] = bflo(q1.x); xa[9] = bfhi(q1.x); xa[10] = bflo(q1.y); xa[11] = bfhi(q1.y); xa[12] = bflo(q1.z); xa[13] = bfhi(q1.z); xa[14] = bflo(q1.w); xa[15] = bfhi(q1.w);
            xb[0] = bflo(q2.x); xb[1] = bfhi(q2.x); xb[2] = bflo(q2.y); xb[3] = bfhi(q2.y); xb[4] = bflo(q2.z); xb[5] = bfhi(q2.z); xb[6] = bflo(q2.w); xb[7] = bfhi(q2.w);
            xb[8] = bflo(q3.x); xb[9] = bfhi(q3.x); xb[10] = bflo(q3.y); xb[11] = bfhi(q3.y); xb[12] = bflo(q3.z); xb[13] = bfhi(q3.z); xb[14] = bflo(q3.w); xb[15] = bfhi(q3.w);
            float ss = 0.f;
#pragma unroll
            for (int e = 0; e < 16; ++e) ss += xa[e] * xa[e] + xb[e] * xb[e];
            ss += __shfl_xor(ss, 1);
            const float rn = __builtin_amdgcn_rsqf(ss * (1.0f / 64.0f) + EPS);
            unsigned oa[8], ob[8];
#pragma unroll
            for (int e = 0; e < 16; e += 2) { float r1[2], r2[2];
#pragma unroll
                for (int k = 0; k < 2; ++k) { const int d = 16 * p + e + k; const f32x2 cs = rope[(size_t)pos * 32 + d];
                    const float y1 = xa[e + k] * rn * a.in[I_KN][d], y2 = xb[e + k] * rn * a.in[I_KN][32 + d]; r1[k] = y1 * cs.x - y2 * cs.y; r2[k] = y2 * cs.x + y1 * cs.y; }
                oa[e >> 1] = pk2(r1[0], r1[1]); ob[e >> 1] = pk2(r2[0], r2[1]); }
            v4u w; w.x = oa[0]; w.y = oa[1]; w.z = oa[2]; w.w = oa[3]; *(LAS v4u*)(Ks + key * 72 + 16 * p) = w;
            w.x = oa[4]; w.y = oa[5]; w.z = oa[6]; w.w = oa[7]; *(LAS v4u*)(Ks + key * 72 + 16 * p + 8) = w;
            w.x = ob[0]; w.y = ob[1]; w.z = ob[2]; w.w = ob[3]; *(LAS v4u*)(Ks + key * 72 + 32 + 16 * p) = w;
            w.x = ob[4]; w.y = ob[5]; w.z = ob[6]; w.w = ob[7]; *(LAS v4u*)(Ks + key * 72 + 32 + 16 * p + 8) = w;
            const bf16* vs = proj0 + (rowb + pos) * E_IN + 1664 + kvh * 64 + 32 * p;
#pragma unroll
            for (int q = 0; q < 4; ++q) { const v4u vv = *(const v4u*)(vs + 8 * q); const unsigned vw[4] = {vv.x, vv.y, vv.z, vv.w};
#pragma unroll
                for (int e = 0; e < 4; ++e) { Vt[(32 * p + 8 * q + 2 * e) * 264 + key] = (bf16)(vw[e] & 0xffffu); Vt[(32 * p + 8 * q + 2 * e + 1) * 264 + key] = (bf16)(vw[e] >> 16); } }
        } else {
            const v4u z = {0u, 0u, 0u, 0u};
            *(LAS v4u*)(Ks + key * 72 + 16 * p) = z; *(LAS v4u*)(Ks + key * 72 + 16 * p + 8) = z; *(LAS v4u*)(Ks + key * 72 + 32 + 16 * p) = z; *(LAS v4u*)(Ks + key * 72 + 32 + 16 * p + 8) = z;
#pragma unroll
            for (int e = 0; e < 32; ++e) Vt[(32 * p + e) * 264 + key] = (bf16)0;
        }
    }
    __syncthreads();
    const int hq = kvh * 4 + (wave >> 1), qh = wave & 1; const float sink = a.in[I_SINK][hq];
    bf16* ymix = (bf16*)(ws + WS_YMIX);
    v4u qr0[4], qr1[4];
#pragma unroll
    for (int qt = 0; qt < 4; ++qt) { const bf16* src = proj0 + (rowb + t0 + 64 * qh + 16 * qt + c) * E_IN + 1024 + hq * 64; qr0[qt] = *(const v4u*)(src + 8 * g); qr1[qt] = *(const v4u*)(src + 32 + 8 * g); }
#pragma unroll
    for (int qt = 0; qt < 4; ++qt) {
        const int q0 = 64 * qh + 16 * qt, kt0 = 4 * qh + qt; const int tok = t0 + q0 + c;
        bf16x8 bq[2];
        {   const v4u r0 = qr0[qt], r1 = qr1[qt];
            const unsigned u0[4] = {r0.x, r0.y, r0.z, r0.w}, u1[4] = {r1.x, r1.y, r1.z, r1.w}; float xa[8], xb[8]; float ss = 0.f;
#pragma unroll
            for (int e = 0; e < 4; ++e) { xa[2 * e] = bflo(u0[e]); xa[2 * e + 1] = bfhi(u0[e]); xb[2 * e] = bflo(u1[e]); xb[2 * e + 1] = bfhi(u1[e]); }
#pragma unroll
            for (int e = 0; e < 8; ++e) ss += xa[e] * xa[e] + xb[e] * xb[e];
            ss += __shfl_xor(ss, 16); ss += __shfl_xor(ss, 32);
            const float rn = __builtin_amdgcn_rsqf(ss * (1.0f / 64.0f) + EPS) * 0.125f;
            float o1[8], o2[8];
#pragma unroll
            for (int e = 0; e < 8; ++e) { const int d = 8 * g + e; const f32x2 cs = rope[(size_t)tok * 32 + d];
                const float y1 = xa[e] * rn * a.in[I_QN][d], y2 = xb[e] * rn * a.in[I_QN][32 + d]; o1[e] = y1 * cs.x - y2 * cs.y; o2[e] = y2 * cs.x + y1 * cs.y; }
            v4u w; w.x = pk2(o1[0], o1[1]); w.y = pk2(o1[2], o1[3]); w.z = pk2(o1[4], o1[5]); w.w = pk2(o1[6], o1[7]); bq[0] = __builtin_bit_cast(bf16x8, w);
            w.x = pk2(o2[0], o2[1]); w.y = pk2(o2[2], o2[3]); w.z = pk2(o2[4], o2[5]); w.w = pk2(o2[6], o2[7]); bq[1] = __builtin_bit_cast(bf16x8, w);
        }
        f32x4 s[9]; float mx = -1e30f;
        const int qi = 128 + q0 + c;
#pragma unroll
        for (int kt = 0; kt < 9; ++kt) {
            const LAS bf16* kp = Ks + (16 * (kt0 + kt) + c) * 72 + 8 * g;
            f32x4 acc = {0.f, 0.f, 0.f, 0.f};
            acc = MFMA16(*(const LAS bf16x8*)kp, bq[0], acc); acc = MFMA16(*(const LAS bf16x8*)(kp + 32), bq[1], acc);
#pragma unroll
            for (int r = 0; r < 4; ++r) { const int kj = 16 * (kt0 + kt) + 4 * g + r; const bool ok = (kj <= qi) && (qi - kj < 128) && (blk > 0 || kj >= 128);
                acc[r] = ok ? acc[r] : -1e30f; mx = fmaxf(mx, acc[r]); }
            s[kt] = acc;
        }
        mx = fmaxf(mx, __shfl_xor(mx, 16)); mx = fmaxf(mx, __shfl_xor(mx, 32)); mx = fmaxf(mx, sink);
        float sum = 0.f;
#pragma unroll
        for (int kt = 0; kt < 9; ++kt)
#pragma unroll
            for (int r = 0; r < 4; ++r) { const float p = (s[kt][r] > -1e29f) ? __expf(s[kt][r] - mx) : 0.f; s[kt][r] = p; sum += p; }
        sum += __shfl_xor(sum, 16); sum += __shfl_xor(sum, 32); sum += __expf(sink - mx);
        const float inv = __builtin_amdgcn_rcpf(sum);
        bf16x8 bp[5];
#pragma unroll
        for (int pp = 0; pp < 4; ++pp) bp[pp] = pack_acc2(s[2 * pp] * inv, s[2 * pp + 1] * inv);
        { const f32x4 z = {0.f, 0.f, 0.f, 0.f}; bp[4] = pack_acc2(s[8] * inv, z); }
#pragma unroll
        for (int dt = 0; dt < 4; ++dt) { f32x4 o = {0.f, 0.f, 0.f, 0.f};
#pragma unroll
            for (int pp = 0; pp < 5; ++pp) { const LAS bf16* vp = Vt + (16 * dt + c) * 264 + 16 * (kt0 + 2 * pp) + 4 * g;
                const v2u lo = *(const LAS v2u*)vp, hi = *(const LAS v2u*)(vp + (pp < 4 ? 16 : 0)); o = MFMA16(mk8(lo, hi), bp[pp], o); }
            v2u w; w.x = pk2(o[0], o[1]); w.y = pk2(o[2], o[3]); *(v2u*)(ymix + (rowb + tok) * D + 512 + hq * 64 + 16 * dt + 4 * g) = w; }
    }
    __syncthreads();
}

DI void lrufix_unit(const Args& a, int unit, int tid) {
    unsigned char* ws = a.ws;
    const int b = unit >> 7, chk = unit & 127, c = tid;
    const float* At = (const float*)(ws + MS_LRU_A); const float* Ht = (const float*)(ws + MS_LRU_H);
    float hin = 0.f;
    for (int c0 = 0; c0 < chk; c0 += 8) { float av[8], hv[8];
#pragma unroll
        for (int e = 0; e < 8; ++e) { const int cc = c0 + e < chk ? c0 + e : chk - 1; const size_t o = (size_t)(b * 128 + cc) * 512 + c; av[e] = At[o]; hv[e] = Ht[o]; }
#pragma unroll
        for (int e = 0; e < 8; ++e) if (c0 + e < chk) hin = av[e] * hin + hv[e]; }
    const unsigned* hp = (const unsigned*)(ws + WS_LRUH);
    const bf16* proj0 = (const bf16*)(ws + WS_PROJ0); bf16* ymix = (bf16*)(ws + WS_YMIX);
    for (int t0 = 0; t0 < 128; t0 += 8) { float hl[8], pc[8], xg[8];
#pragma unroll
        for (int e = 0; e < 8; ++e) { const size_t row = (size_t)b * SEQ + chk * 128 + t0 + e; const unsigned w = hp[row * LRU_W + c]; hl[e] = bflo(w); pc[e] = bfhi(w); xg[e] = bf2f(proj0[row * E_IN + 512 + c]); }
#pragma unroll
        for (int e = 0; e < 8; ++e) { const size_t row = (size_t)b * SEQ + chk * 128 + t0 + e; const float h = hl[e] + pc[e] * hin, x = xg[e];
            const float z = 0.7978845608028654f * (x + 0.044715f * x * x * x); const float th = 1.0f - 2.0f * __builtin_amdgcn_rcpf(1.0f + __expf(2.0f * z));
            ymix[row * D + c] = (bf16)f2bf(h * 0.5f * x * (1.0f + th)); } }
}
DI void skinny_tile(const Args& a, int tile, int lane) {
    unsigned char* ws = a.ws; const int g = lane >> 4, c = lane & 15;
    const bf16* wsk = (const bf16*)(ws + MS_WSK) + c * D + 8 * g; const bf16* hb = (const bf16*)(ws + WS_HB) + (size_t)(tile * 16 + c) * D + 8 * g;
    f32x4 acc = {0.f, 0.f, 0.f, 0.f};
#pragma unroll 8
    for (int ks = 0; ks < 32; ++ks) acc = MFMA16(*(const bf16x8*)(wsk + 32 * ks), *(const bf16x8*)(hb + 32 * ks), acc);
    const int row = tile * 16 + c; const float rs = pg8::rstd16((const float*)(ws + WS_STA), row);
    f32x4 o;
#pragma unroll
    for (int r = 0; r < 4; ++r) { const int cc = 4 * g + r; const float pre = acc[r] * rs;
        if (cc < 8) { const float xin = pre + a.in[I_DTB][cc]; const float sp = xin > 20.f ? xin : log1pf(expf(xin)); o[r] = -expf(a.in[I_ALOG][cc]) * sp; }
        else o[r] = 1.0f / (1.0f + expf(-pre)); }
    *(f32x4*)((float*)(ws + WS_AB) + (size_t)row * 16 + 4 * g) = o;
}

DI void conv_unit(const Args& a, int unit, int tid) {
    if (tid >= 384) return;
    unsigned char* ws = a.ws; const int b = unit >> 8, ck = unit & 255, col = 8 * tid;
    bf16* p = (bf16*)(ws + WS_QKV) + qkv_off((b * 8 + ((col >> 7) & 7)) * 256 + ck, col >> 10, 0, col & 127);
    float w[4][8];
#pragma unroll
    for (int j = 0; j < 4; ++j) { const f32x4 w0 = *(const f32x4*)(a.in[I_OCONV] + j * 3072 + col), w1 = *(const f32x4*)(a.in[I_OCONV] + j * 3072 + col + 4);
#pragma unroll
        for (int e = 0; e < 4; ++e) { w[j][e] = w0[e]; w[j][4 + e] = w1[e]; } }
    float x1[8], x2[8], x3[8];
    if (ck > 0) { const bf16* hp = (const bf16*)(ws + WS_HALO) + (size_t)(b * NCH + ck - 1) * 3 * 3072 + col; const v4u h3 = *(const v4u*)hp, h2 = *(const v4u*)(hp + 3072), h1 = *(const v4u*)(hp + 6144);
        const unsigned u3[4] = {h3.x, h3.y, h3.z, h3.w}, u2[4] = {h2.x, h2.y, h2.z, h2.w}, u1[4] = {h1.x, h1.y, h1.z, h1.w};
#pragma unroll
        for (int e = 0; e < 4; ++e) { x3[2 * e] = bflo(u3[e]); x3[2 * e + 1] = bfhi(u3[e]); x2[2 * e] = bflo(u2[e]); x2[2 * e + 1] = bfhi(u2[e]); x1[2 * e] = bflo(u1[e]); x1[2 * e + 1] = bfhi(u1[e]); } }
    else {
#pragma unroll
        for (int e = 0; e < 8; ++e) { x1[e] = 0.f; x2[e] = 0.f; x3[e] = 0.f; } }
    for (int j0 = 0; j0 < 64; j0 += 8) { v4u raw[8];
#pragma unroll
        for (int t = 0; t < 8; ++t) raw[t] = *(const v4u*)(p + (size_t)(j0 + t) * 128);
#pragma unroll
        for (int t = 0; t < 8; ++t) { const unsigned uw[4] = {raw[t].x, raw[t].y, raw[t].z, raw[t].w}; float y[8];
#pragma unroll
            for (int e = 0; e < 8; ++e) { const float xn = (e & 1) ? bfhi(uw[e >> 1]) : bflo(uw[e >> 1]); const float v = w[0][e] * x3[e] + w[1][e] * x2[e] + w[2][e] * x1[e] + w[3][e] * xn; x3[e] = x2[e]; x2[e] = x1[e]; x1[e] = xn; y[e] = silu_f(v); }
            v4u o; o.x = pk2(y[0], y[1]); o.y = pk2(y[2], y[3]); o.z = pk2(y[4], y[5]); o.w = pk2(y[6], y[7]); *(v4u*)(p + (size_t)(j0 + t) * 128) = o; }
    }
}

constexpr int PR_XQ = 0, PR_XK = 17408;
constexpr int PR_KT = 36448, PR_VT = 54880;
constexpr int PR_SLOT = 73728, PR_SLOTB = 9216, PR_VEC = 147456, PR_VECB = 1536;
DI int lrow_off(int i) { const int m = (i - 1) >> 2; return i <= 0 ? 0 : 8 * m * (m + 1) + (i - 1 - 4 * m) * 4 * (m + 1); }
struct PrepRegs { v4u a[2], b[2]; float ab0, ab1; };
DI void prep_load(const unsigned char* ws, PrepRegs& r, int unit, int colA, int colB, int tid_, bool want_ab) {
    int tid = tid_; asm volatile("" : "+v"(tid));
    const int ck = unit & 255, h = (unit >> 8) & 7, b = unit >> 11; const size_t R0 = (size_t)b * SEQ + (size_t)ck * 64;
    const bf16* qkv = (const bf16*)(ws + WS_QKV);
#pragma unroll
    for (int k = 0; k < 2; ++k) { const int idx = tid + 512 * k, row = idx >> 4, c16 = idx & 15; r.a[k] = *(const v4u*)(qkv + qkv_off(unit, colA >> 10, row, 8 * c16)); r.b[k] = *(const v4u*)(qkv + qkv_off(unit, colB >> 10, row, 8 * c16)); }
    if (want_ab && tid >= 448) { const float* ab = (const float*)(ws + WS_AB) + (R0 + (tid - 448)) * 16; r.ab0 = ab[h]; r.ab1 = ab[8 + h]; }
}
DI void prep_stage(LAS unsigned char* lds, const PrepRegs& r, int tid_) {
    int tid = tid_; asm volatile("" : "+v"(tid));
#pragma unroll
    for (int k = 0; k < 2; ++k) { const int idx = tid + 512 * k, row = idx >> 4, c16 = idx & 15;
        *(LAS v4u*)((LAS bf16*)(lds + PR_XQ) + row * 136 + 8 * c16) = r.a[k]; *(LAS v4u*)((LAS bf16*)(lds + PR_XK) + row * 136 + 8 * c16) = r.b[k]; }
}
DI void prep_front_a(const Args& a, LAS unsigned char* lds, int unit, int slot, const PrepRegs& R, int tid, int wave, int lane, const bool dry) {
    unsigned char* ws = a.ws;
    const int ck = unit & 255, h = (unit >> 8) & 7, b = unit >> 11, g = lane >> 4, c = lane & 15;
    const size_t R0 = (size_t)b * SEQ + (size_t)ck * 64;
    bf16* qkv = (bf16*)(ws + WS_QKV);
    LAS bf16* XQ = (LAS bf16*)(lds + PR_XQ); LAS bf16* XK = (LAS bf16*)(lds + PR_XK);
    LAS float* Ls = (LAS float*)(lds + PR_SLOT + slot * PR_SLOTB);
    LAS float* Gs = (LAS float*)(lds + PR_VEC + slot * PR_VECB); LAS float* Bs = Gs + 64; LAS float* Rq = Gs + 128; LAS float* Rk = Gs + 192; LAS float* SK = Gs + 256; LAS float* SD = Gs + 320;
    prep_stage(lds, R, tid);
    if (wave == 7) {
        float G = R.ab0;
#pragma unroll
        for (int o = 1; o < 64; o <<= 1) { const float v = __shfl_up(G, o); if (lane >= o) G += v; }
        Gs[lane] = G; Bs[lane] = R.ab1;
        if (lane == 63 && !dry) ((float*)(ws + MS_GLAST))[unit] = __expf(G);
    }
}
DI void prep_front_b(const Args& a, LAS unsigned char* lds, int unit, int slot, int tid_, int wave, int lane_, const bool dry) {
    unsigned char* ws = a.ws; int tid = tid_; asm volatile("" : "+v"(tid)); const int lane = tid & 63; (void)lane_;
    const int ck = unit & 255, h = (unit >> 8) & 7, b = unit >> 11, g = lane >> 4, c = lane & 15;
    const size_t R0 = (size_t)b * SEQ + (size_t)ck * 64;
    bf16* qkv = (bf16*)(ws + WS_QKV);
    LAS bf16* XQ = (LAS bf16*)(lds + PR_XQ); LAS bf16* XK = (LAS bf16*)(lds + PR_XK);
    LAS float* Ls = (LAS float*)(lds + PR_SLOT + slot * PR_SLOTB);
    LAS float* Gs = (LAS float*)(lds + PR_VEC + slot * PR_VECB); LAS float* Bs = Gs + 64; LAS float* Rq = Gs + 128; LAS float* Rk = Gs + 192; LAS float* SK = Gs + 256; LAS float* SD = Gs + 320;
    __syncthreads();
    { const int row = tid >> 2, qtr = tid & 3; const LAS bf16* s = (row < 64 ? XQ + row * 136 : XK + (row - 64) * 136) + 32 * qtr; float ss = 0.f;
#pragma unroll
      for (int q = 0; q < 4; ++q) { const v4u v = *(const LAS v4u*)(s + 8 * q); const unsigned vw[4] = {v.x, v.y, v.z, v.w};
#pragma unroll
          for (int e = 0; e < 4; ++e) { const float l = bflo(vw[e]), hh = bfhi(vw[e]); ss += l * l + hh * hh; } }
      ss += __shfl_xor(ss, 1); ss += __shfl_xor(ss, 2);
      const float rn = __builtin_amdgcn_rsqf(ss + EPS);
      if (qtr == 0) { if (row < 64) Rq[row] = rn * 0.08838834764831845f; else { const int j = row - 64; Rk[j] = rn; const float Gj = Gs[j]; SK[j] = -Bs[j] * rn * __expf(Gj); SD[j] = rn * __expf(Gs[63] - Gj); } } }
    __syncthreads();
    bf16* aq = (bf16*)(ws + WS_AQK) + (size_t)unit * 4096;
    for (int job = wave; job < 26; job += 8) {
        int it, jt; const bool isk = job < 10;
        if (isk) { it = job >= 6 ? 3 : (job >= 3 ? 2 : (job >= 1 ? 1 : 0)); jt = job - it * (it + 1) / 2; } else { it = (job - 10) >> 2; jt = (job - 10) & 3; }
        const int i = 16 * it + c, j0 = 16 * jt + 4 * g;
        bf16* aqf = aq + ((it * 2 + (jt >> 1)) * 64 + lane) * 8 + (jt & 1) * 4;
        if (it < jt) { const v2u z = {0u, 0u}; if (!dry && !isk) *(v2u*)aqf = z; continue; }
        const LAS bf16* ap = XK + (16 * jt + c) * 136 + 8 * g; const LAS bf16* bp = (isk ? XK : XQ) + (16 * it + c) * 136 + 8 * g;
        f32x4 acc = {0.f, 0.f, 0.f, 0.f};
#pragma unroll
        for (int ks = 0; ks < 4; ++ks) acc = MFMA16(*(const LAS bf16x8*)(ap + 32 * ks), *(const LAS bf16x8*)(bp + 32 * ks), acc);
        const float Gi = Gs[i], ri = isk ? Bs[i] * Rk[i] : Rq[i]; f32x4 o;
#pragma unroll
        for (int r = 0; r < 4; ++r) { const int j = j0 + r; const bool ok = isk ? (i > j) : (i >= j); const float dcy = __expf(fminf(Gi - Gs[j], 0.f)); o[r] = ok ? acc[r] * ri * Rk[j] * dcy : 0.f; }
        if (isk) { LAS float* lp = Ls + lrow_off(i) + j0;
#pragma unroll
            for (int r = 0; r < 4; ++r) if (j0 + r < i) lp[r] = o[r]; }
        else { v2u w; w.x = pk2(o[0], o[1]); w.y = pk2(o[2], o[3]); if (!dry) *(v2u*)aqf = w; }
    }
#pragma unroll
    for (int k = 0; k < 2; ++k) { const int task = tid + 512 * k, i = task >> 4, dc = task & 15; const float sc = Rq[i] * __expf(Gs[i]);
        const v4u v = *(const LAS v4u*)(XQ + i * 136 + 8 * dc); v4u o;
        o.x = pk2(bflo(v.x) * sc, bfhi(v.x) * sc); o.y = pk2(bflo(v.y) * sc, bfhi(v.y) * sc); o.z = pk2(bflo(v.z) * sc, bfhi(v.z) * sc); o.w = pk2(bflo(v.w) * sc, bfhi(v.w) * sc);
        if (!dry) *(v4u*)(qkv + qkv_off(unit, 0, i, 8 * dc)) = o; }
    __syncthreads();
}
DI void prep_invert(LAS unsigned char* lds, int slot, int lane) {
    LAS float* Ls = (LAS float*)(lds + PR_SLOT + slot * PR_SLOTB);
    float t[64]; int ln = lane; asm volatile("" : "+v"(ln));
#pragma unroll
    for (int i = 0; i < 64; ++i) { float a0 = (i == ln) ? 1.f : 0.f, a1 = 0.f, a2 = 0.f, a3 = 0.f;
#pragma unroll
        for (int k4 = 0; k4 < (i + 3) / 4; ++k4) { const f32x4 l = *(const LAS f32x4*)(Ls + lrow_off(i) + 4 * k4);
            if (4 * k4 + 0 < i) a0 -= l[0] * t[4 * k4 + 0]; if (4 * k4 + 1 < i) a1 -= l[1] * t[4 * k4 + 1]; if (4 * k4 + 2 < i) a2 -= l[2] * t[4 * k4 + 2]; if (4 * k4 + 3 < i) a3 -= l[3] * t[4 * k4 + 3];
            if ((k4 & 3) == 3) asm volatile("" ::: "memory"); }
        t[i] = (a0 + a1) + (a2 + a3); asm volatile("" ::: "memory"); }
    LDS_WAIT();
    LAS bf16* Tb = (LAS bf16*)Ls;
#pragma unroll
    for (int i = 0; i < 64; ++i) Tb[i * 72 + lane] = (bf16)f2bf(t[i]);
}
DI void prep_back(const Args& a, LAS unsigned char* lds, int unit, int slot, int tid_, int wave, int lane_, const bool dry) {
    unsigned char* ws = a.ws; int tid = tid_; asm volatile("" : "+v"(tid)); const int lane = tid & 63; (void)lane_;
    const int ck = unit & 255, h = (unit >> 8) & 7, b = unit >> 11, g = lane >> 4, c = lane & 15;
    const size_t R0 = (size_t)b * SEQ + (size_t)ck * 64;
    bf16* qkv = (bf16*)(ws + WS_QKV);
    LAS bf16* KT = (LAS bf16*)(lds + PR_KT); LAS bf16* VT = (LAS bf16*)(lds + PR_VT); const LAS bf16* Tb = (const LAS bf16*)(lds + PR_SLOT + slot * PR_SLOTB);
    const LAS float* Gs = (const LAS float*)(lds + PR_VEC + slot * PR_VECB); const LAS float* Bs = Gs + 64; const LAS float* SK = Gs + 256; const LAS float* SD = Gs + 320;
    __syncthreads();
    {   const int part = tid >> 8, half = (tid >> 7) & 1, ch = tid & 127;
        const LAS bf16* rw = (const LAS bf16*)(lds + (part ? PR_XK : PR_XQ)) + (32 * half) * 136 + ch; LAS bf16* to = (part ? VT : KT) + ch * 72 + 32 * half;
        const LAS float* s0 = (part ? Bs : SK) + 32 * half; const LAS float* s1 = SD + 32 * half;
        bf16* kd = qkv + qkv_off(unit, 2, ch >> 1, (ch & 1) * 64 + 32 * half);
#pragma unroll
        for (int j8 = 0; j8 < 4; ++j8) { float x[8];
#pragma unroll
            for (int e = 0; e < 8; ++e) x[e] = bf2f(rw[(8 * j8 + e) * 136]);
            const f32x4 sa = *(const LAS f32x4*)(s0 + 8 * j8), sb = *(const LAS f32x4*)(s0 + 8 * j8 + 4);
            v4u w; w.x = pk2(x[0] * sa[0], x[1] * sa[1]); w.y = pk2(x[2] * sa[2], x[3] * sa[3]); w.z = pk2(x[4] * sb[0], x[5] * sb[1]); w.w = pk2(x[6] * sb[2], x[7] * sb[3]); *(LAS v4u*)(to + 8 * j8) = w;
            if (part == 0) { const f32x4 da = *(const LAS f32x4*)(s1 + 8 * j8), db = *(const LAS f32x4*)(s1 + 8 * j8 + 4);
                v4u o; o.x = pk2(x[0] * da[0], x[1] * da[1]); o.y = pk2(x[2] * da[2], x[3] * da[3]); o.z = pk2(x[4] * db[0], x[5] * db[1]); o.w = pk2(x[6] * db[2], x[7] * db[3]); if (!dry) *(v4u*)(kd + 8 * j8) = o; } }
    }
    __syncthreads();
    bf16* uT = (bf16*)(ws + WS_UT) + (size_t)unit * 8192;
    for (int job = wave; job < 64; job += 8) {
        f32x4 acc = {0.f, 0.f, 0.f, 0.f};
        if (job < 32) { const int it = job >> 3, et = job & 7; const LAS bf16* ap = Tb + (16 * it + c) * 72 + 8 * g; const LAS bf16* bp = VT + (16 * et + c) * 72 + 8 * g;
#pragma unroll
            for (int ks = 0; ks < 2; ++ks) acc = MFMA16(*(const LAS bf16x8*)(ap + 32 * ks), *(const LAS bf16x8*)(bp + 32 * ks), acc);
            v2u w; w.x = pk2(acc[0], acc[1]); w.y = pk2(acc[2], acc[3]); if (!dry) *(v2u*)(uT + (16 * et + c) * 64 + 16 * it + 4 * g) = w;
        } else { const int dt = (job - 32) >> 2, it = (job - 32) & 3; const LAS bf16* ap = KT + (16 * dt + c) * 72 + 8 * g; const LAS bf16* bp = Tb + (16 * it + c) * 72 + 8 * g;
#pragma unroll
            for (int ks = 0; ks < 2; ++ks) acc = MFMA16(*(const LAS bf16x8*)(ap + 32 * ks), *(const LAS bf16x8*)(bp + 32 * ks), acc);
            v2u w; w.x = pk2(acc[0], acc[1]); w.y = pk2(acc[2], acc[3]); if (!dry) *(v2u*)(qkv + qkv_off(unit, 1, 16 * it + c, 16 * dt + 4 * g)) = w; }
    }
}
#ifndef MK_SUBSTAMP
#define MK_SUBSTAMP 0
#endif
DI void prep_phase(const Args& a, LAS unsigned char* lds, int first, int stride, int n, int tid, int wave, int lane, const bool dry, unsigned long long& st_acc) {
    const unsigned char* ws = a.ws; unsigned long long t0 = 0ull; (void)t0;
#define PSB(i) do { if (MK_SUBSTAMP == (i)) t0 = __builtin_amdgcn_s_memrealtime(); } while (0)
#define PSE(i) do { if (MK_SUBSTAMP == (i)) st_acc += __builtin_amdgcn_s_memrealtime() - t0; } while (0)
    for (int b0 = 0; b0 < n; b0 += 8) {
        const int nb = (n - b0) < 8 ? (n - b0) : 8;
        PrepRegs R;
        PSB(3);
        prep_load(ws, R, first + b0 * stride, 0, 1024, tid, true);
        for (int s = 0; s < nb; ++s) {
            const int unit = first + (b0 + s) * stride;
            prep_front_a(a, lds, unit, s, R, tid, wave, lane, dry);
            if (s + 1 < nb) prep_load(ws, R, unit + stride, 0, 1024, tid, true);
            prep_front_b(a, lds, unit, s, tid, wave, lane, dry);
        }
        PSE(3); PSB(4);
#ifndef NO_INV
        if (wave < nb) prep_invert(lds, wave, lane);
#endif
        prep_load(ws, R, first + b0 * stride, 1024, 2048, tid, false);
        __syncthreads();
        PSE(4); PSB(5);
        for (int s = 0; s < nb; ++s) {
            const int unit = first + (b0 + s) * stride;
            prep_stage(lds, R, tid);
            if (s + 1 < nb) prep_load(ws, R, unit + stride, 1024, 2048, tid, false);
            prep_back(a, lds, unit, s, tid, wave, lane, dry);
        }
        __syncthreads();
        PSE(5);
    }
#undef PSB
#undef PSE
}

#ifndef MK_SUBSTAMP
#define MK_SUBSTAMP 0
#endif
constexpr int SC_SLOT = 51200, SC_W = 0, SC_K = 16384, SC_U = 32768, SC_Q = 34816;
constexpr int SC_DUMP = 3 * SC_SLOT, SC_XS = SC_DUMP + 1024, SC_XV = SC_XS + 4096, SC_FLAG = SC_XV + 2048;
static_assert(SC_FLAG + 128 <= LDSCTL_OFF, "scan LDS map");
DI const LAS v2u* sw256(const LAS unsigned char* base, int row, int j, int half) { return (const LAS v2u*)(base + row * 256 + ((j ^ (row & 15)) << 4) + half * 8); }
DI const LAS v2u* sw128(const LAS unsigned char* base, int row, int j, int half) { return (const LAS v2u*)(base + row * 128 + ((j ^ ((row >> 1) & 7)) << 4) + half * 8); }
#define SCAN_BAR() do { asm volatile("s_waitcnt lgkmcnt(0)" ::: "memory"); __builtin_amdgcn_s_barrier(); asm volatile("" ::: "memory"); } while (0)
struct AFrag { v4u v[8]; };
DI void af_load(AFrag& f, const unsigned char* ws, unsigned off) {
#pragma unroll
    for (int k = 0; k < 8; ++k) asm volatile("global_load_dwordx4 %0, %1, %2" : "=v"(f.v[k]) : "v"(off + (unsigned)k * 1024u), "s"(ws) : "memory");
}
#define AF_WAIT(N, f) asm volatile("s_waitcnt vmcnt(" #N ")" : "+v"(f.v[0]), "+v"(f.v[1]), "+v"(f.v[2]), "+v"(f.v[3]), "+v"(f.v[4]), "+v"(f.v[5]), "+v"(f.v[6]), "+v"(f.v[7]) :: "memory")
template <int w> DI void scan_crit(const unsigned char* ws, LAS unsigned char* lds, int b, int h, int lane) {
    const int g = lane >> 4, c = lane & 15, gh = g >> 1, gl1 = g & 1;
    LAS v4u* XS = (LAS v4u*)(lds + SC_XS); LAS v4u* XV = (LAS v4u*)(lds + SC_XV);
        const float* glast = (const float*)(ws + MS_GLAST) + (b * GH + h) * NCH;
        { const v4u z = {0u, 0u, 0u, 0u}; XS[(2 * w) * 64 + lane] = z; XS[(2 * w + 1) * 64 + lane] = z; }
        SCAN_BAR();
        f32x4 S[4]; bf16x8 Sb[4];
#pragma unroll
        for (int i = 0; i < 4; ++i) { S[i] = (f32x4){0.f, 0.f, 0.f, 0.f}; Sb[i] = (bf16x8){0, 0, 0, 0, 0, 0, 0, 0}; }
        int slot = 0;
        const unsigned lw = (unsigned)((32 * w + c) * 256 + gl1 * 8), lk = (unsigned)((64 * w + c) * 128 + gl1 * 8), lu = (unsigned)(c * 128 + gl1 * 8), kx = (unsigned)((c >> 1) & 7);
        unsigned xw[4][2], xk[2][2], xu[2];
#pragma unroll
        for (int s = 0; s < 4; ++s)
#pragma unroll
            for (int t = 0; t < 2; ++t) xw[s][t] = (unsigned)(((4 * s + 2 * t + gh) ^ c) << 4);
#pragma unroll
        for (int s = 0; s < 2; ++s)
#pragma unroll
            for (int t = 0; t < 2; ++t) xk[s][t] = (((unsigned)(4 * s + 2 * t + gh)) ^ kx) << 4;
#pragma unroll
        for (int j = 0; j < 2; ++j) xu[j] = (((unsigned)(2 * (2 * w + j) + gh)) ^ kx) << 4;
        for (int ck = 0; ck < NCH; ++ck) {
            const LAS unsigned char* cur = lds + slot * SC_SLOT; slot = slot == 2 ? 0 : slot + 1;
            const float gl = glast[ck]; f32x4 vn[2]; bf16x8 wf[2][4], kf[4][2]; v2u uf[2];
#pragma unroll
            for (int s = 0; s < 4; ++s) { const LAS unsigned char* p0 = cur + SC_W + lw + xw[s][0]; const LAS unsigned char* p1 = cur + SC_W + lw + xw[s][1];
#pragma unroll
                for (int j = 0; j < 2; ++j) wf[j][s] = mk8(*(const LAS v2u*)(p0 + j * 4096), *(const LAS v2u*)(p1 + j * 4096)); }
#pragma unroll
            for (int j = 0; j < 2; ++j) uf[j] = *(const LAS v2u*)(cur + SC_U + lu + xu[j]);
#pragma unroll
            for (int s = 0; s < 2; ++s) { const LAS unsigned char* p0 = cur + SC_K + lk + xk[s][0]; const LAS unsigned char* p1 = cur + SC_K + lk + xk[s][1];
#pragma unroll
                for (int d = 0; d < 4; ++d) kf[d][s] = mk8(*(const LAS v2u*)(p0 + d * 2048), *(const LAS v2u*)(p1 + d * 2048)); }
            if (ck > 0) { Sb[2 - 2 * w] = __builtin_bit_cast(bf16x8, XS[(2 - 2 * w) * 64 + lane]); Sb[3 - 2 * w] = __builtin_bit_cast(bf16x8, XS[(3 - 2 * w) * 64 + lane]); }
#pragma unroll
            for (int j = 0; j < 2; ++j) { f32x4 acc = {bflo(uf[j].x), bfhi(uf[j].x), bflo(uf[j].y), bfhi(uf[j].y)};
#pragma unroll
                for (int s = 0; s < 4; ++s) acc = MFMA16(wf[j][s], Sb[s], acc);
                vn[j] = acc; }
            bf16x8 vb[2]; vb[w] = pack_acc2(vn[0], vn[1]);
            XV[w * 64 + lane] = __builtin_bit_cast(v4u, vb[w]);
            SCAN_BAR();
            vb[1 - w] = __builtin_bit_cast(bf16x8, XV[(1 - w) * 64 + lane]);
#pragma unroll
            for (int d = 0; d < 4; ++d) { f32x4 acc = S[d] * gl;
#pragma unroll
                for (int s = 0; s < 2; ++s) acc = MFMA16(kf[d][s], vb[s], acc);
                S[d] = acc; }
            Sb[2 * w] = pack_acc2(S[0], S[1]); Sb[2 * w + 1] = pack_acc2(S[2], S[3]);
            XS[(2 * w) * 64 + lane] = __builtin_bit_cast(v4u, Sb[2 * w]); XS[(2 * w + 1) * 64 + lane] = __builtin_bit_cast(v4u, Sb[2 * w + 1]);
            SCAN_BAR();
        }
}
DI void scan_chain(const Args& a, LAS unsigned char* lds, int chain, int tid, int wave, int lane, const bool dry, unsigned long long& st_acc) {
    unsigned char* ws = a.ws; (void)st_acc;
    const int es = chain & 7, h = (chain >> 3) & 7, b = chain >> 6, g = lane >> 4, c = lane & 15, gh = g >> 1, gl1 = g & 1;
    LAS v4u* XS = (LAS v4u*)(lds + SC_XS); LAS v4u* XV = (LAS v4u*)(lds + SC_XV);
    __syncthreads();
    if (wave == 0) scan_crit<0>(ws, lds, b, h, lane); else if (wave == 1) scan_crit<1>(ws, lds, b, h, lane);
    else if (wave == 2) {
        const int unit0 = (b * GH + h) * NCH;
        bf16* oT = (bf16*)(ws + WS_UT) + (size_t)unit0 * 8192 + (16 * es + c) * 64 + 4 * g;
        const unsigned aoff = (unsigned)(WS_AQK + ((size_t)unit0 * 4096 + lane * 8) * 2);
        AFrag F0, F1, F2;
        const unsigned lw = (unsigned)(c * 256 + gl1 * 8); unsigned xw[4][2];
#pragma unroll
        for (int s = 0; s < 4; ++s)
#pragma unroll
            for (int t = 0; t < 2; ++t) xw[s][t] = (unsigned)(((4 * s + 2 * t + gh) ^ c) << 4);
        af_load(F0, ws, aoff); af_load(F1, ws, aoff + 8192u);
        unsigned anext = aoff + 2u * 8192u; bf16* onext = oT;
        SCAN_BAR();
#define OUT_STEP(ck, FX, FZ) do { \
            const LAS unsigned char* cur = lds + ((ck) % 3) * SC_SLOT; \
            if ((ck) + 2 < NCH) { af_load(FZ, ws, anext); anext += 8192u; } \
            bf16x8 So[4], qf[4][4]; f32x4 acc[4]; \
            _Pragma("unroll") for (int s = 0; s < 4; ++s) So[s] = __builtin_bit_cast(bf16x8, XS[s * 64 + lane]); \
            _Pragma("unroll") for (int s = 0; s < 4; ++s) { const LAS unsigned char* p0 = cur + SC_Q + lw + xw[s][0]; const LAS unsigned char* p1 = cur + SC_Q + lw + xw[s][1]; \
                _Pragma("unroll") for (int jt = 0; jt < 4; ++jt) qf[jt][s] = mk8(*(const LAS v2u*)(p0 + jt * 4096), *(const LAS v2u*)(p1 + jt * 4096)); } \
            _Pragma("unroll") for (int jt = 0; jt < 4; ++jt) { acc[jt] = (f32x4){0.f, 0.f, 0.f, 0.f}; \
                _Pragma("unroll") for (int s = 0; s < 4; ++s) acc[jt] = MFMA16(qf[jt][s], So[s], acc[jt]); } \
            SCAN_BAR(); \
            bf16x8 vb[2]; vb[0] = __builtin_bit_cast(bf16x8, XV[lane]); vb[1] = __builtin_bit_cast(bf16x8, XV[64 + lane]); \
            if ((ck) + 2 >= NCH) AF_WAIT(0, FX); else if ((ck) == 0) AF_WAIT(16, FX); else if ((ck) == 1) AF_WAIT(20, FX); else AF_WAIT(24, FX); \
            _Pragma("unroll") for (int jt = 0; jt < 4; ++jt) { \
                _Pragma("unroll") for (int s = 0; s < 2; ++s) acc[jt] = MFMA16(__builtin_bit_cast(bf16x8, FX.v[jt * 2 + s]), vb[s], acc[jt]); \
                v2u w; w.x = pk2(acc[jt][0], acc[jt][1]); w.y = pk2(acc[jt][2], acc[jt][3]); \
                if (!dry) asm volatile("global_store_dwordx2 %0, %1, off" :: "v"(onext + 16 * jt), "v"(w) : "memory"); } \
            onext += 8192; \
            SCAN_BAR(); } while (0)
        for (int c0 = 0; c0 < NCH; c0 += 3) {
            OUT_STEP(c0, F0, F2);
            if (c0 + 1 < NCH) OUT_STEP(c0 + 1, F1, F0);
            if (c0 + 2 < NCH) OUT_STEP(c0 + 2, F2, F1);
        }
#undef OUT_STEP
        asm volatile("s_waitcnt vmcnt(0)" ::: "memory");
    } else if (wave == 6) {
        SCAN_BAR();
        for (int ck = 0; ck < NCH; ++ck) { SCAN_BAR(); SCAN_BAR(); }
    } else {
        const size_t R0 = (size_t)b * SEQ; const int unit0 = (b * GH + h) * NCH, lw = wave == 7 ? 3 : wave - 3;
        unsigned gc[13], ic[13], lc[13];
#pragma unroll
        for (int k = 0; k < 13; ++k) { int r = lw + 4 * k; const bool pad = r >= 50; if (pad) r = lw; size_t gg; unsigned gi, ll;
            if (r < 16) { const int row = 4 * r + (lane >> 4), j = (lane & 15) ^ (row & 15); gg = WS_QKV + qkv_off(unit0, 1, row, 8 * j) * 2; gi = 3u * 16384u; ll = SC_W + r * 1024; }
            else if (r < 32) { const int d = 8 * (r - 16) + (lane >> 3), j = (lane & 7) ^ ((d >> 1) & 7); gg = WS_QKV + qkv_off(unit0, 2, d >> 1, (d & 1) * 64 + 8 * j) * 2; gi = 3u * 16384u; ll = SC_K + (r - 16) * 1024; }
            else if (r < 34) { const int e = 8 * (r - 32) + (lane >> 3), j = (lane & 7) ^ ((e >> 1) & 7); gg = WS_UT + ((size_t)unit0 * 8192 + (16 * es + e) * 64 + 8 * j) * 2; gi = 16384u; ll = SC_U + (r - 32) * 1024; }
            else { const int row = 4 * (r - 34) + (lane >> 4), j = (lane & 15) ^ (row & 15); gg = WS_QKV + qkv_off(unit0, 0, row, 8 * j) * 2; gi = 3u * 16384u; ll = SC_Q + (r - 34) * 1024; }
            gc[k] = (unsigned)gg; ic[k] = gi; lc[k] = pad ? 0xffffffffu : ll; }
#define DMA_C(slot) do { _Pragma("unroll") for (int k = 0; k < 13; ++k) { \
            __builtin_amdgcn_global_load_lds((const unsigned*)(ws + gc[k]), (LAS unsigned*)(lds + (lc[k] == 0xffffffffu ? (unsigned)SC_DUMP : (unsigned)(slot) * SC_SLOT + lc[k])), 16, 0, 0); gc[k] += ic[k]; } } while (0)
        DMA_C(0); DMA_C(1);
        asm volatile("s_waitcnt vmcnt(0)" ::: "memory");
        SCAN_BAR();
        int s2 = 2;
        for (int ck = 0; ck < NCH; ++ck) {
            if (ck + 2 < NCH) DMA_C(s2);
            s2 = s2 == 2 ? 0 : s2 + 1;
            SCAN_BAR();
            if (ck + 2 < NCH) asm volatile("s_waitcnt vmcnt(13)" ::: "memory"); else asm volatile("s_waitcnt vmcnt(0)" ::: "memory");
            SCAN_BAR();
        }
#undef DMA_C
    }
    __syncthreads();
}

DI void onorm_unit(const Args& a, LAS float* red  , int unit, int it, int wave, int lane) {
    unsigned char* ws = a.ws;
    const int ck = unit & 255, h = (unit >> 8) & 7, b = unit >> 11; const size_t row = (size_t)b * SEQ + (size_t)ck * 64 + lane;
    const bf16* oT = (const bf16*)(ws + WS_UT) + (size_t)unit * 8192 + (16 * wave) * 64 + lane;
    float v[16]; float ss = 0.f;
#pragma unroll
    for (int k = 0; k < 16; ++k) { v[k] = bf2f(oT[k * 64]); ss += v[k] * v[k]; }
    LAS float* rb = red + (it & 1) * 512; rb[wave * 64 + lane] = ss;
    const bf16* gp = (const bf16*)(ws + WS_GATE) + row * D + h * 128 + 16 * wave; const v4u g0 = *(const v4u*)gp, g1 = *(const v4u*)(gp + 8);
    __syncthreads();
    float tot = 0.f;
#pragma unroll
    for (int w = 0; w < 8; ++w) tot += rb[w * 64 + lane];
    const float rs = __builtin_amdgcn_rsqf(tot * (1.0f / 128.0f) + EPS);
    const unsigned gw[8] = {g0.x, g0.y, g0.z, g0.w, g1.x, g1.y, g1.z, g1.w}; unsigned o[8];
    const float* on = a.in[I_ONORM] + 16 * wave;
#pragma unroll
    for (int k = 0; k < 8; ++k) { const float ga = bflo(gw[k]), gb = bfhi(gw[k]); o[k] = pk2(v[2 * k] * rs * on[2 * k] * silu_f(ga), v[2 * k + 1] * rs * on[2 * k + 1] * silu_f(gb)); }
    bf16* op = (bf16*)(ws + WS_ON) + row * D + h * 128 + 16 * wave;
    v4u w0, w1; w0.x = o[0]; w0.y = o[1]; w0.z = o[2]; w0.w = o[3]; w1.x = o[4]; w1.y = o[5]; w1.z = o[6]; w1.w = o[7]; *(v4u*)op = w0; *(v4u*)(op + 8) = w1;
}

DI void route_unit(const Args& a, LAS int* esel, int unit, int wave, int lane) {
    unsigned char* ws = a.ws;
    const float* rt = (const float*)(ws + MS_ROUT);
    f32x4 rr[4][4][2];
#pragma unroll
    for (int j = 0; j < 4; ++j)
#pragma unroll
        for (int i = 0; i < 4; ++i) { const f32x4* p = (const f32x4*)(rt + (size_t)(4 * (64 * j + lane) + i) * 8); rr[j][i][0] = p[0]; rr[j][i][1] = p[1]; }
    for (int tl = 16 * wave; tl < 16 * wave + 16; ++tl) {
        const int tok = unit * 128 + tl;
        const v2u* xr = (const v2u*)((const bf16*)(ws + WS_HB) + (size_t)tok * D) + lane;
        float acc[8] = {0.f, 0.f, 0.f, 0.f, 0.f, 0.f, 0.f, 0.f};
#pragma unroll
        for (int j = 0; j < 4; ++j) { const v2u xw = xr[64 * j]; const f32x4 x = {bflo(xw.x), bfhi(xw.x), bflo(xw.y), bfhi(xw.y)};
#pragma unroll
            for (int i = 0; i < 4; ++i)
#pragma unroll
                for (int e = 0; e < 8; ++e) acc[e] += x[i] * rr[j][i][e >> 2][e & 3]; }
#pragma unroll
        for (int e = 0; e < 8; ++e) acc[e] = wave_sum(acc[e]);
        const float rs = pg8::rstd16((const float*)(ws + WS_STB), tok);
        int e1 = 0; float l1 = acc[0];
#pragma unroll
        for (int e = 1; e < 8; ++e) if (acc[e] > l1) { l1 = acc[e]; e1 = e; }
        int e2 = -1; float l2 = -3.0e38f;
#pragma unroll
        for (int e = 0; e < 8; ++e) if (e != e1 && acc[e] > l2) { l2 = acc[e]; e2 = e; }
        const float w1 = __builtin_amdgcn_rcpf(1.0f + __expf((l2 - l1) * rs));
        if (lane == 0) { ((int*)(ws + MS_TOKE))[tok] = e1 | (e2 << 8); ((float*)(ws + MS_TOKW))[2 * tok] = w1; ((float*)(ws + MS_TOKW))[2 * tok + 1] = 1.0f - w1; esel[2 * tl] = e1; esel[2 * tl + 1] = e2; }
    }
    __syncthreads();
    { int base = 0;
      for (int i = 0; i < 4; ++i) { const bool m = esel[64 * i + lane] == wave; const unsigned long long mask = __ballot(m);
          if (m) ((int*)(ws + MS_RANK))[unit * 256 + 64 * i + lane] = base + __popcll(mask & ((1ull << lane) - 1ull)); base += __popcll(mask); }
      if (lane == 0) ((int*)(ws + MS_CNT))[unit * 8 + wave] = base; }
    __syncthreads();
}

DI void gather_unit(const Args& a, LAS int* sm  , int unit, int tid, int wave, int lane) {
    unsigned char* ws = a.ws;
    const int* cnt = (const int*)(ws + MS_CNT);
    if (tid < 8) { int tot = 0, off = 0; for (int u = 0; u < 256; ++u) { const int v = cnt[u * 8 + tid]; tot += v; if (u < unit) off += v; } sm[tid] = tot; sm[8 + tid] = off; }
    __syncthreads();
    if (tid == 0) { int s = 0; for (int e = 0; e < 8; ++e) { sm[16 + e] = s; s += ((sm[e] + 255) >> 8) << 8; } sm[24] = s;
        if (unit == 0) { int* te = (int*)(ws + MS_TILEE); for (int e = 0; e < 8; ++e) for (int t = sm[16 + e] >> 8; t < (sm[16 + e + 1] >> 8); ++t) te[t] = e; te[MAXTILES] = s >> 8; } }
    __syncthreads();
    const bf16* hb3 = (const bf16*)(ws + WS_HB); bf16* xg = (bf16*)(ws + WS_XG); float* rg = (float*)(ws + MS_RG);
    for (int s0 = 32 * wave; s0 < 32 * wave + 32; s0 += 4) { int dest[4]; v4u r0[4], r1[4];
#pragma unroll
        for (int q = 0; q < 4; ++q) { const int s = s0 + q, tok = unit * 128 + (s >> 1), k = s & 1; const int e = (((const int*)(ws + MS_TOKE))[tok] >> (8 * k)) & 0xff;
            dest[q] = sm[16 + e] + sm[8 + e] + ((const int*)(ws + MS_RANK))[unit * 256 + s];
            const v4u* src = (const v4u*)(hb3 + (size_t)tok * D) + lane; r0[q] = src[0]; r1[q] = src[64]; }
#pragma unroll
        for (int q = 0; q < 4; ++q) { const int s = s0 + q, tok = unit * 128 + (s >> 1), k = s & 1; const float rs = pg8::rstd16((const float*)(ws + WS_STB), tok);
            if (lane == 0) ((int*)(ws + MS_DEST))[2 * tok + k] = dest[q];
            v4u a0 = r0[q], a1 = r1[q];
            a0.x = pk2(bflo(a0.x) * rs, bfhi(a0.x) * rs); a0.y = pk2(bflo(a0.y) * rs, bfhi(a0.y) * rs); a0.z = pk2(bflo(a0.z) * rs, bfhi(a0.z) * rs); a0.w = pk2(bflo(a0.w) * rs, bfhi(a0.w) * rs);
            a1.x = pk2(bflo(a1.x) * rs, bfhi(a1.x) * rs); a1.y = pk2(bflo(a1.y) * rs, bfhi(a1.y) * rs); a1.z = pk2(bflo(a1.z) * rs, bfhi(a1.z) * rs); a1.w = pk2(bflo(a1.w) * rs, bfhi(a1.w) * rs);
            v4u* dst = (v4u*)(xg + (size_t)dest[q] * D) + lane; dst[0] = a0; dst[64] = a1; }
    }
    if (unit < 8) {
        const int e = unit, r0 = sm[16 + e] + sm[e], r1 = sm[16 + e + 1]; const v4u z = {0u, 0u, 0u, 0u};
        for (int r = r0 + wave; r < r1; r += 8) { v4u* dst = (v4u*)(xg + (size_t)r * D) + lane; dst[0] = z; dst[64] = z; }
    }
    __syncthreads();
}

DI void combine_row(const Args& a, int tok, int lane) {
    unsigned char* ws = a.ws;
    const int d1 = ((const int*)(ws + MS_DEST))[2 * tok], d2 = ((const int*)(ws + MS_DEST))[2 * tok + 1];
    const float w1 = ((const float*)(ws + MS_TOKW))[2 * tok], w2 = ((const float*)(ws + MS_TOKW))[2 * tok + 1];
    const bf16* y = (const bf16*)(ws + WS_XG);
    f32x4* o = (f32x4*)(a.out + (size_t)tok * D) + 4 * lane;
    const v4u* y1 = (const v4u*)(y + (size_t)d1 * D) + 2 * lane; const v4u* y2 = (const v4u*)(y + (size_t)d2 * D) + 2 * lane; const v4u* hh = (const v4u*)((const bf16*)(ws + WS_HB) + (size_t)tok * D) + 2 * lane;
#pragma unroll
    for (int q = 0; q < 2; ++q) { const v4u p1 = y1[q], p2 = y2[q], p0 = hh[q]; const unsigned a1[4] = {p1.x, p1.y, p1.z, p1.w}, a2[4] = {p2.x, p2.y, p2.z, p2.w}, a0[4] = {p0.x, p0.y, p0.z, p0.w};
#pragma unroll
        for (int e = 0; e < 2; ++e) { f32x4 v;
            v[0] = bflo(a0[2 * e]) + w1 * bflo(a1[2 * e]) + w2 * bflo(a2[2 * e]); v[1] = bfhi(a0[2 * e]) + w1 * bfhi(a1[2 * e]) + w2 * bfhi(a2[2 * e]);
            v[2] = bflo(a0[2 * e + 1]) + w1 * bflo(a1[2 * e + 1]) + w2 * bflo(a2[2 * e + 1]); v[3] = bfhi(a0[2 * e + 1]) + w1 * bfhi(a1[2 * e + 1]) + w2 * bfhi(a2[2 * e + 1]); o[2 * q + e] = v; } }
}

DI void combine_rows4(const Args& a, int tok0, int stride, int lane) {
    unsigned char* ws = a.ws; const bf16* y = (const bf16*)(ws + WS_XG);
    int d1[4], d2[4]; float w1[4], w2[4]; v4u p0[4][2], p1[4][2], p2[4][2];
#pragma unroll
    for (int r = 0; r < 4; ++r) { const int tok = tok0 + r * stride < T ? tok0 + r * stride : tok0;
        d1[r] = ((const int*)(ws + MS_DEST))[2 * tok]; d2[r] = ((const int*)(ws + MS_DEST))[2 * tok + 1]; w1[r] = ((const float*)(ws + MS_TOKW))[2 * tok]; w2[r] = ((const float*)(ws + MS_TOKW))[2 * tok + 1];
        const v4u* hh = (const v4u*)((const bf16*)(ws + WS_HB) + (size_t)tok * D) + 2 * lane; p0[r][0] = hh[0]; p0[r][1] = hh[1]; }
    const int ntl = ((const int*)(ws + MS_TILEE))[MAXTILES], trows = (ntl - 4 * PASS_TILES) * 256; const bf16* part = (const bf16*)(ws + WS_PART);
#pragma unroll
    for (int r = 0; r < 4; ++r) {
#pragma unroll
        for (int k = 0; k < 2; ++k) { const int d = k ? d2[r] : d1[r]; v4u q0, q1;
            if (d < 4 * PASS_TILES * 256) { const v4u* yy = (const v4u*)(y + (size_t)d * D) + 2 * lane; q0 = yy[0]; q1 = yy[1]; }
            else { float s[16];
#pragma unroll
                for (int e = 0; e < 16; ++e) s[e] = 0.f;
                for (int ks = 0; ks < 7; ++ks) { const v4u* pp = (const v4u*)(part + ((size_t)ks * trows + (d - 4 * PASS_TILES * 256)) * D) + 2 * lane; const v4u a0 = pp[0], a1 = pp[1]; const unsigned w[8] = {a0.x, a0.y, a0.z, a0.w, a1.x, a1.y, a1.z, a1.w};
#pragma unroll
                    for (int e = 0; e < 8; ++e) { s[2 * e] += bflo(w[e]); s[2 * e + 1] += bfhi(w[e]); } }
                q0.x = pk2(s[0], s[1]); q0.y = pk2(s[2], s[3]); q0.z = pk2(s[4], s[5]); q0.w = pk2(s[6], s[7]); q1.x = pk2(s[8], s[9]); q1.y = pk2(s[10], s[11]); q1.z = pk2(s[12], s[13]); q1.w = pk2(s[14], s[15]); }
            if (k) { p2[r][0] = q0; p2[r][1] = q1; } else { p1[r][0] = q0; p1[r][1] = q1; } } }
#pragma unroll
    for (int r = 0; r < 4; ++r) { const int tok = tok0 + r * stride; if (tok >= T) break;
        f32x4* o = (f32x4*)(a.out + (size_t)tok * D) + 4 * lane;
#pragma unroll
        for (int q = 0; q < 2; ++q) { const unsigned a0[4] = {p0[r][q].x, p0[r][q].y, p0[r][q].z, p0[r][q].w}, a1[4] = {p1[r][q].x, p1[r][q].y, p1[r][q].z, p1[r][q].w}, a2[4] = {p2[r][q].x, p2[r][q].y, p2[r][q].z, p2[r][q].w};
#pragma unroll
            for (int e = 0; e < 2; ++e) { f32x4 v;
                v[0] = bflo(a0[2 * e]) + w1[r] * bflo(a1[2 * e]) + w2[r] * bflo(a2[2 * e]); v[1] = bfhi(a0[2 * e]) + w1[r] * bfhi(a1[2 * e]) + w2[r] * bfhi(a2[2 * e]);
                v[2] = bflo(a0[2 * e + 1]) + w1[r] * bflo(a1[2 * e + 1]) + w2[r] * bflo(a2[2 * e + 1]); v[3] = bfhi(a0[2 * e + 1]) + w1[r] * bfhi(a1[2 * e + 1]) + w2[r] * bfhi(a2[2 * e + 1]); o[2 * q + e] = v; } } }
}
constexpr int NPHASE = 23;
#ifndef MK_SUB
#define MK_SUB 3
#endif
#ifndef MK_ONE_LAUNCH
#define MK_ONE_LAUNCH 1
#endif
template <int P> DI void moe_pass(const Args& args, LAS unsigned char* lds, int G, int which  ) {
    unsigned char* ws = args.ws;
    const int* te = (const int*)(ws + MS_TILEE); const int ntiles = te[MAXTILES];
    const int lo = PASS_TILES * P, hi = (P == 3) ? ntiles : (ntiles < PASS_TILES * (P + 1) ? ntiles : PASS_TILES * (P + 1));
    if (lo >= hi) return;
    if (which == 0) {
        pg8::Gemm g{(const bf16*)(ws + WS_XG), (const bf16*)args.out, MAXTILES * 256, 2 * FFE, D, D};
        pg8::MoeOrder S{lo, hi, 2 * FFE / 256, G, (int)blockIdx.x, te};
        pg8::EpiSwiGLU<true> E{(bf16*)(ws + WS_ACT), FFE, nullptr, 2 * FFE / 256, lo};
        pg8::gemm_phase<pg8::EpiSwiGLU<true>, pg8::MoeOrder, true, true>(lds, g, S, E);
    } else {
        const int hr = (P == 3 && hi > 4 * PASS_TILES) ? 4 * PASS_TILES : hi;
        pg8::Gemm g{(const bf16*)(ws + WS_ACT) - (size_t)lo * 256 * FFE, (const bf16*)(ws + WS_WMD), MAXTILES * 256, D, FFE, FFE};
        pg8::MoeOrder S{lo, hr, D / 256, G, (int)blockIdx.x, te};
        pg8::EpiPlain E{(bf16*)(ws + WS_XG)};
        pg8::gemm_phase<pg8::EpiPlain, pg8::MoeOrder, true, true>(lds, g, S, E);
        if (P == 3 && hi > hr) {
            pg8::Gemm g2{(const bf16*)(ws + WS_ACT) - (size_t)lo * 256 * FFE, (const bf16*)(ws + WS_WMD), MAXTILES * 256, D, FFE, 512};
            pg8::TailOrder S2{hr, hi, G, (int)blockIdx.x, te};
            pg8::EpiPart E2{(bf16*)(ws + WS_PART), hr, (hi - hr) * 256};
            pg8::gemm_phase<pg8::EpiPart, pg8::TailOrder, true, true>(lds, g2, S2, E2);
        }
    }
}

__global__ void __launch_bounds__(NTHREADS, 2) fwd(Args args) {
    extern __shared__ __attribute__((aligned(16))) unsigned char lds_raw[];
    LAS unsigned char* lds = (LAS unsigned char*)lds_raw;
    volatile LAS unsigned* MISC = (volatile LAS unsigned*)(lds + MISC_OFF);
    const int tid = threadIdx.x, lane = tid & 63, wave = __builtin_amdgcn_readfirstlane(tid >> 6);
    const int G = gridDim.x, bx = blockIdx.x;
    const int vcu = (G % 8 == 0) ? (bx % 8) * (G / 8) + bx / 8 : bx;
    const int gw = vcu * NWAVES + wave, NGW = G * NWAVES;
    unsigned char* ws = args.ws;
    gu32* ctl = (gu32*)(ws + WS_CTL);
    for (int u = tid; u < (LDS_BYTES - LDSCTL_OFF) / 4; u += NTHREADS) ((LAS unsigned*)(lds + LDSCTL_OFF))[u] = 0u;
    __syncthreads();
    const int lo = args.ph_lo, hi = args.ph_hi;
    XcdBarrier bar; bar.bar = (unsigned*)(ctl + CW_BAR); bar.x = 0; bar.st = nullptr;
    if (hi - lo > 1) bar = xcd_barrier_post((unsigned*)(ctl + CW_BAR), MISC + 8);
#ifndef MK_PHMASK
#define MK_PHMASK 0x7fffffu
#endif
#define IN(k) ((((MK_PHMASK) >> (k)) & 1u) && lo <= (k) && (k) < hi)
#ifndef MK_STAMPMASK
#define MK_STAMPMASK 0u
#endif
    unsigned long long st_acc = 0ull, st_t0 = 0ull;
#ifndef MK_SUBSTAMP
#define MK_SUBSTAMP 0
#endif
#define SUBSTAMP_BEGIN(i) do { if (MK_SUBSTAMP == (i)) st_t0 = __builtin_amdgcn_s_memrealtime(); } while (0)
#define SUBSTAMP_END(i) do { if (MK_SUBSTAMP == (i)) st_acc += __builtin_amdgcn_s_memrealtime() - st_t0; } while (0)
#define STAMPED(k) ((((MK_STAMPMASK) >> (k)) & 1u) != 0u)
#define SEAM(k) do { if (IN(k) && IN((k) + 1)) xcd_barrier(bar); if (STAMPED(k)) st_acc += __builtin_amdgcn_s_memrealtime() - st_t0; } while (0)
#ifndef MK_DUP
#define MK_DUP -1
#endif
#define PH(k, ...) if (STAMPED(k)) st_t0 = __builtin_amdgcn_s_memrealtime(); if (IN(k)) { if (MK_DUP == (k)) { int o_tid = tid; asm volatile("" : "+v"(o_tid)); unsigned long long o_ws = (unsigned long long)ws; asm volatile("" : "+s"(o_ws)); \
        { const int tid = o_tid, lane = tid & 63, wave = __builtin_amdgcn_readfirstlane(tid >> 6); unsigned char* const ws = (unsigned char*)o_ws; const int gw = vcu * NWAVES + wave; (void)lane; (void)gw; (void)ws; \
          const bool dry = (args.ph_hi > 0); (void)dry; __VA_ARGS__ } xcd_barrier(bar); } \
        { int p_tid = threadIdx.x; asm volatile("" : "+v"(p_tid)); const int tid = p_tid, lane = tid & 63, wave = __builtin_amdgcn_readfirstlane(tid >> 6), gw = vcu * NWAVES + wave; (void)lane; (void)gw; \
          const bool dry = false; (void)dry; __VA_ARGS__ } } SEAM(k);

    PH(0,  phase_prologue(args, lds, gw, NGW, wave, lane); __syncthreads(); )

    PH(1,
        pg8::Gemm g{(const bf16*)(ws + WS_HB), (const bf16*)(ws + W0_IN), T, E_IN, D, D}; pg8::StaticOrder S; S.init(T, E_IN, G, bx);
        pg8::rstd_prepass(S, (const float*)(ws + WS_STA), (float*)(ws + MS_RC));
        pg8::EpiProj<0> E{(bf16*)(ws + WS_PROJ0), E_IN, (const float*)(ws + MS_RC), nullptr, nullptr};
        pg8::gemm_phase<pg8::EpiProj<0>, pg8::StaticOrder, true, true>(lds, g, S, E);
        if (G == 256) { if (bx >= 128) weights_late(args, (bx - 128) * NWAVES + wave, 128 * NWAVES, lane); } else weights_late(args, gw, NGW, lane);
    )

    PH(2,
        if (MK_SUB & 1) { LruFrags LF; lru_frags(args, lds, LF, wave, lane); __syncthreads(); for (int u = vcu; u < NB * 128; u += G) lru_unit(args, lds, LF, u, wave, lane); }
        __syncthreads();
        if (MK_SUB & 2) for (int u = vcu; u < NB * 128 * 2; u += G) attn_unit(args, lds, u, tid, wave, lane);
    )

    PH(3,  for (int u = vcu; u < NB * 128; u += G) lrufix_unit(args, u, tid); )

    PH(4,
        pg8::Gemm g{(const bf16*)(ws + WS_YMIX), (const bf16*)(ws + W0_OUT), T, D, D, D}; pg8::StaticOrder S; S.init(T, D, G, bx);
        pg8::EpiResid E{(bf16*)(ws + WS_HB), (float*)(ws + WS_STB)};
        pg8::gemm_phase<pg8::EpiResid, pg8::StaticOrder, true, true>(lds, g, S, E);
    )

    PH(5,
        pg8::Gemm g{(const bf16*)(ws + WS_HB), (const bf16*)(ws + W0_GU), T, 2 * FF0, D, D}; pg8::StaticOrder S; S.init(T, 2 * FF0, G, bx);
        pg8::rstd_prepass(S, (const float*)(ws + WS_STB), (float*)(ws + MS_RC));
        pg8::EpiSwiGLU<false> E{(bf16*)(ws + WS_ACT0), FF0, (const float*)(ws + MS_RC), 0, 0};
        pg8::gemm_phase<pg8::EpiSwiGLU<false>, pg8::StaticOrder, true, true>(lds, g, S, E);
    )

    PH(6,
        pg8::Gemm g{(const bf16*)(ws + WS_ACT0), (const bf16*)(ws + W0_DN), T, D, FF0, FF0}; pg8::StaticOrder S; S.init(T, D, G, bx);
        pg8::EpiResid E{(bf16*)(ws + WS_HB), (float*)(ws + WS_STA)};
        pg8::gemm_phase<pg8::EpiResid, pg8::StaticOrder, true, true>(lds, g, S, E);
    )

    PH(7,
        pg8::Gemm g{(const bf16*)(ws + WS_HB), (const bf16*)(ws + W1_IN), T, 4096, D, D}; pg8::StaticOrder S; S.init(T, 4096, G, bx);
        pg8::rstd_prepass(S, (const float*)(ws + WS_STA), (float*)(ws + MS_RC));
        pg8::EpiProj<1> E{(bf16*)(ws + WS_QKV), 3072, (const float*)(ws + MS_RC), (bf16*)(ws + WS_GATE), (bf16*)(ws + WS_HALO)};
        pg8::gemm_phase<pg8::EpiProj<1>, pg8::StaticOrder, true, true>(lds, g, S, E);
        for (int t = gw; t < T / 16; t += NGW) skinny_tile(args, t, lane);
    )

    PH(8,  SUBSTAMP_BEGIN(1); for (int u = vcu; u < NB * NCH; u += G) conv_unit(args, u, tid);
        if (hi - lo > 1) xcd_barrier(bar); SUBSTAMP_END(1);
        SUBSTAMP_BEGIN(2); prep_phase(args, lds, vcu, G, (NUNIT - vcu + G - 1) / G, tid, wave, lane, dry, st_acc); SUBSTAMP_END(2); )

    PH(9,
        volatile LAS int* sq = (volatile LAS int*)(lds + LDSCTL_OFF + 64);
        if (tid == 0) { const unsigned x = xb_xcc_id() & 7u; const unsigned t = __hip_atomic_fetch_add((unsigned*)(ctl + CW_SCANQ + 64 * x), 1u, __ATOMIC_RELAXED, __HIP_MEMORY_SCOPE_AGENT);
            unsigned n[8]; unsigned tot = 0;
            for (int j = 0; j < 8; ++j) { n[j] = __hip_atomic_load((unsigned*)(ctl + CW_BAR) + XB_XCNT(j), __ATOMIC_RELAXED, __HIP_MEMORY_SCOPE_AGENT); tot += n[j]; }
            int chain = -1, wrank = 0, nwork = 0;
            if (tot != (unsigned)G || hi - lo <= 1) { chain = vcu < 128 ? vcu : -1; wrank = vcu - 128; nwork = G - 128; }
            else if (t < 16u) chain = (int)((2u * x + (t >> 3)) * 8u + (t & 7u));
            else { unsigned w = t - 16u, nl = 0, nw = 0;
                for (int j = 0; j < 8; ++j) { if ((unsigned)j < x && n[j] > 16u) w += n[j] - 16u; nl += n[j] < 16u ? 16u - n[j] : 0u; nw += n[j] > 16u ? n[j] - 16u : 0u; }
                if (w < nl) { unsigned r = w;
                    for (int j = 0; j < 8; ++j) { const unsigned lj = n[j] < 16u ? 16u - n[j] : 0u; if (chain < 0) { if (r < lj) { const unsigned tt = n[j] + r; chain = (int)((2u * j + (tt >> 3)) * 8u + (tt & 7u)); } else r -= lj; } } }
                else { wrank = (int)(w - nl); nwork = (int)(nw - nl); } }
            sq[0] = chain; sq[1] = wrank; sq[2] = nwork; }
        __syncthreads();
        const int chain = sq[0]; const int wrank = sq[1]; const int nwork = sq[2];
        __syncthreads();
        SUBSTAMP_BEGIN(6); if (chain >= 0) scan_chain(args, lds, chain, tid, wave, lane, dry, st_acc); SUBSTAMP_END(6);
        SUBSTAMP_BEGIN(7); if (chain < 0 && nwork > 0) { moe_convert(args, wrank * NWAVES + wave, nwork * NWAVES, lane); } SUBSTAMP_END(7);
        if (G < 128 + 1) { moe_convert(args, gw, NGW, lane); }
    )

    PH(10,
        LAS float* red = (LAS float*)lds; int it = 0;
        for (int u = vcu; u < NUNIT; u += G, ++it) onorm_unit(args, red, u, it, wave, lane);
        __syncthreads();
    )

    PH(11,
        pg8::Gemm g{(const bf16*)(ws + WS_ON), (const bf16*)(ws + W1_OUT), T, D, D, D}; pg8::StaticOrder S; S.init(T, D, G, bx);
        pg8::EpiResid E{(bf16*)(ws + WS_HB), (float*)(ws + WS_STB)};
        pg8::gemm_phase<pg8::EpiResid, pg8::StaticOrder, true, true>(lds, g, S, E);
    )

    PH(12,  for (int u = vcu; u < 256; u += G) route_unit(args, (LAS int*)lds, u, wave, lane); )
    PH(13,  for (int u = vcu; u < 256; u += G) gather_unit(args, (LAS int*)lds, u, tid, wave, lane); )

    PH(14, moe_pass<0>(args, lds, G, 0);)
    PH(15, moe_pass<0>(args, lds, G, 1);)
    PH(16, moe_pass<1>(args, lds, G, 0);)
    PH(17, moe_pass<1>(args, lds, G, 1);)
    PH(18, moe_pass<2>(args, lds, G, 0);)
    PH(19, moe_pass<2>(args, lds, G, 1);)
    PH(20, moe_pass<3>(args, lds, G, 0);)
    PH(21, moe_pass<3>(args, lds, G, 1);)

    PH(22, for (int t = gw; t < T; t += 4 * NGW) combine_rows4(args, t, NGW, lane); )
    if ((MK_STAMPMASK != 0u || MK_SUBSTAMP != 0) && blockIdx.x == 0 && tid == 0) { const unsigned long long t1 = __builtin_amdgcn_s_memrealtime(); while (__builtin_amdgcn_s_memrealtime() - t1 < st_acc) __builtin_amdgcn_s_sleep(8); }
#undef IN
#undef SEAM
#undef PH
}

extern "C" void kernel_launch(void* const* d_in, const int* in_sizes, int n_in, void* d_out, int out_size, void* d_ws, size_t ws_size, hipStream_t stream) {
    static int grid = 0;
    if (grid == 0) {
        if (n_in != 28 || out_size != T * D || ws_size < WS_END) { fprintf(stderr, "kernel_launch: unexpected problem (n_in %d, out %d, ws %zu)\n", n_in, out_size, ws_size); grid = -1; return; }
        int dev = 0, cus = 0, per_cu = 0;
        if (hipGetDevice(&dev) != hipSuccess || hipDeviceGetAttribute(&cus, hipDeviceAttributeMultiprocessorCount, dev) != hipSuccess) { grid = -1; return; }
        if (hipFuncSetAttribute((const void*)fwd, hipFuncAttributeMaxDynamicSharedMemorySize, LDS_BYTES) != hipSuccess) { fprintf(stderr, "kernel_launch: hipFuncSetAttribute failed\n"); grid = -1; return; }
        if (hipOccupancyMaxActiveBlocksPerMultiprocessor(&per_cu, (const void*)fwd, NTHREADS, LDS_BYTES) != hipSuccess || per_cu < 1) fprintf(stderr, "kernel_launch: occupancy query says %d\n", per_cu);
        (void)hipGetLastError();
        grid = cus;
    }
    if (grid < 0) return;
    if (hipMemsetAsync((char*)d_ws + WS_CTL, 0, CTL_ZERO_BYTES, stream) != hipSuccess) return;
    Args a{};
    for (int i = 0; i < 28; ++i) a.in[i] = (const float*)d_in[i];
    a.out = (float*)d_out; a.ws = (unsigned char*)d_ws;
#if MK_ONE_LAUNCH
    a.ph_lo = 0; a.ph_hi = NPHASE;
    hipLaunchKernelGGL(fwd, dim3(grid), dim3(NTHREADS), LDS_BYTES, stream, a);
#else
    for (int p = 0; p < NPHASE; ++p) { a.ph_lo = p; a.ph_hi = p + 1; hipLaunchKernelGGL(fwd, dim3(grid), dim3(NTHREADS), LDS_BYTES, stream, a); }
#endif
}
```
